# Optimizing an MI355X kernel written in HIP

```python
import jax
import jax.numpy as jnp
from jax import lax

D_MODEL = 2048
BATCH = 2
SEQ = 4096
DEPTH = 2

CTX_LEN = 256
GRID_W = 64
RMS_EPS = 1e-6

GLA_HEADS = 4
GLA_DK = D_MODEL // 2 // GLA_HEADS
GLA_DV = D_MODEL // GLA_HEADS
GLA_RANK = 16
GLA_TAU = 16.0
GLA_CHUNK = 64

ATT_HD = 64
ATT_HQ = D_MODEL // ATT_HD
ATT_HKV = ATT_HQ // 8
ATT_WINDOW = 128
ATT_BLOCK = 128
ROPE_BASE = 10000.0

D_FF = 5632
N_EXPERTS = 8
TOP_K = 2
N_DENSE = (DEPTH + 1) // 2
N_MOE = DEPTH // 2

IN_WIDTHS = (
    GLA_HEADS * GLA_DK,
    GLA_HEADS * GLA_DK,
    GLA_HEADS * GLA_DV,
    GLA_HEADS * GLA_DV,
    GLA_RANK,
    GLA_RANK,
    ATT_HQ * ATT_HD,
    ATT_HKV * ATT_HD,
    ATT_HKV * ATT_HD,
    D_MODEL,
    D_MODEL,
)
D_IN = sum(IN_WIDTHS)

kernel_name = 'hybrid_gla_swa_moe_diffusion_block'


def _in_split_points():
    pts, acc = [], 0
    for w in IN_WIDTHS[:-1]:
        acc += w
        pts.append(acc)
    return pts


def _rmsnorm(x, g):
    xf = x.astype(jnp.float32)
    y = xf * lax.rsqrt(jnp.mean(xf * xf, axis=-1, keepdims=True) + RMS_EPS)
    return (y * g.astype(jnp.float32)).astype(x.dtype)


def _heads(t, n):
    return t.reshape(t.shape[:-1] + (n, t.shape[-1] // n))


def _rope_tables(rows):
    row = jnp.repeat(jnp.arange(rows), GRID_W)
    col = jnp.tile(jnp.arange(GRID_W), rows)
    half = ATT_HD // 2
    inv = ROPE_BASE ** (-jnp.arange(0, half, 2, dtype=jnp.float32) / half)

    def angles(p):
        a = p.astype(jnp.float32)[:, None] * inv[None, :]
        return jnp.concatenate([a, a], axis=-1)

    ang = jnp.concatenate([angles(row), angles(col)], axis=-1)
    return jnp.cos(ang), jnp.sin(ang)


def _rot_half(x):
    a, b = jnp.split(x, 2, axis=-1)
    return jnp.concatenate([-b, a], axis=-1)


def _apply_rope2d(x, cos, sin):
    half = ATT_HD // 2
    rot = jnp.concatenate([_rot_half(x[..., :half]), _rot_half(x[..., half:])], axis=-1)
    c = cos[None, :, None, :]
    s = sin[None, :, None, :]
    return (x.astype(jnp.float32) * c + rot.astype(jnp.float32) * s).astype(x.dtype)


def _gla_scan(q, k, v, log_a, s0):
    B, L, H, _ = q.shape
    DV = v.shape[-1]
    C = GLA_CHUNK
    N = L // C

    def chunks(t):
        return jnp.moveaxis(t.astype(jnp.float32).reshape(B, N, C, H, t.shape[-1]), 1, 0)

    q, k, v, log_a = chunks(q), chunks(k), chunks(v), chunks(log_a)
    b = jnp.cumsum(log_a, axis=2)
    b_last = b[:, :, -1:]
    q_in = q * jnp.exp(b)
    k_in = k * jnp.exp(-b)
    k_out = k * jnp.exp(b_last - b)
    mask = jnp.tril(jnp.ones((C, C), dtype=bool))
    a_intra = jnp.where(mask, jnp.einsum('nbihd,nbjhd->nbhij', q_in, k_in), 0.0)
    o_intra = jnp.einsum('nbhij,nbjhv->nbihv', a_intra, v)
    decay = jnp.exp(b_last[:, :, 0])

    def step(s, inp):
        q_n, k_n, v_n, d_n = inp
        o_n = jnp.einsum('bihd,bhdv->bihv', q_n, s)
        s = d_n[..., None] * s + jnp.einsum('bjhd,bjhv->bhdv', k_n, v_n)
        return s, o_n

    s_fin, o_inter = lax.scan(step, s0, (q_in, k_out, v, decay))
    o = jnp.moveaxis(o_intra + o_inter, 0, 1).reshape(B, L, H, DV)
    return o, s_fin


def _gla_readout(o, r, g_gla):
    on = _rmsnorm(o, g_gla)
    B, L = r.shape[:2]
    return on.reshape(B, L, GLA_HEADS * GLA_DV).astype(r.dtype) * jax.nn.silu(r)


def _window_attention(q, k, v, kc, vc, sink):
    B, L = q.shape[:2]
    G = ATT_HQ // ATT_HKV
    nb = L // ATT_BLOCK
    span = ATT_BLOCK + 2 * ATT_WINDOW
    n_ctx = kc.shape[1]
    pad = ((0, 0), (ATT_WINDOW, ATT_WINDOW), (0, 0), (0, 0))
    kp = jnp.pad(k, pad)
    vp = jnp.pad(v, pad)
    qb = jnp.moveaxis(q.reshape(B, nb, ATT_BLOCK, ATT_HKV, G, ATT_HD), 1, 0)
    sink_l = sink.astype(jnp.float32).reshape(1, ATT_HKV, G, 1, 1)

    def one_block(args):
        i, q_i = args
        start = i * ATT_BLOCK
        k_i = lax.dynamic_slice_in_dim(kp, start, span, axis=1)
        v_i = lax.dynamic_slice_in_dim(vp, start, span, axis=1)
        tq = start + jnp.arange(ATT_BLOCK)
        tk = start - ATT_WINDOW + jnp.arange(span)
        ok = (jnp.abs(tq[:, None] - tk[None, :]) <= ATT_WINDOW) & ((tk >= 0) & (tk < L))[None, :]
        s_loc = jnp.einsum('bqhgd,bkhd->bhgqk', q_i, k_i).astype(jnp.float32)
        s_loc = jnp.where(ok, s_loc, -jnp.inf)
        s_ctx = jnp.einsum('bqhgd,bkhd->bhgqk', q_i, kc).astype(jnp.float32)
        s_snk = jnp.broadcast_to(sink_l, s_loc.shape[:-1] + (1,))
        p = jax.nn.softmax(jnp.concatenate([s_loc, s_ctx, s_snk], axis=-1), axis=-1).astype(v.dtype)
        o = jnp.einsum('bhgqk,bkhd->bqhgd', p[..., :span], v_i)
        o = o + jnp.einsum('bhgqk,bkhd->bqhgd', p[..., span:span + n_ctx], vc)
        return o

    ob = lax.map(one_block, (jnp.arange(nb), qb))
    return jnp.moveaxis(ob, 0, 1).reshape(B, L, ATT_HQ * ATT_HD)


def _ctx_attention(qc, kc, vc, sink):
    B, Lc = qc.shape[:2]
    G = ATT_HQ // ATT_HKV
    q = qc.reshape(B, Lc, ATT_HKV, G, ATT_HD)
    s = jnp.einsum('bqhgd,bkhd->bhgqk', q, kc).astype(jnp.float32)
    snk = jnp.broadcast_to(sink.astype(jnp.float32).reshape(1, ATT_HKV, G, 1, 1), s.shape[:-1] + (1,))
    p = jax.nn.softmax(jnp.concatenate([s, snk], axis=-1), axis=-1)[..., :-1].astype(vc.dtype)
    o = jnp.einsum('bhgqk,bkhd->bqhgd', p, vc)
    return o.reshape(B, Lc, ATT_HQ * ATT_HD)


def _token_mixer(hx, hc, w_in, w_lr_f, b_lr_f, w_lr_b, b_lr_b, g_gla, att_sink,
                 w_br_gla, w_br_att, w_out, cos, sin, with_ctx_out):
    pts = _in_split_points()
    px = jnp.split(hx @ w_in, pts, axis=-1)
    pc = jnp.split(hc @ w_in, pts, axis=-1)

    def gla_in(p):
        q = _heads(p[0], GLA_HEADS) * GLA_DK ** -0.5
        k = _heads(p[1], GLA_HEADS)
        v = _heads(p[2], GLA_HEADS)
        la_f = _heads(jax.nn.log_sigmoid((p[4] @ w_lr_f + b_lr_f).astype(jnp.float32)) / GLA_TAU, GLA_HEADS)
        la_b = _heads(jax.nn.log_sigmoid((p[5] @ w_lr_b + b_lr_b).astype(jnp.float32)) / GLA_TAU, GLA_HEADS)
        return q, k, v, la_f, la_b

    def flip(t):
        return jnp.flip(t, axis=1)

    qx, kx, vx, lfx, lbx = gla_in(px)
    qc, kc, vc, lfc, lbc = gla_in(pc)
    s0 = jnp.zeros((hx.shape[0], GLA_HEADS, GLA_DK, GLA_DV), jnp.float32)
    oc_f, sc_f = _gla_scan(qc, kc, vc, lfc, s0)
    oc_b, sc_b = _gla_scan(flip(qc), flip(kc), flip(vc), flip(lbc), s0)
    ox_f, _ = _gla_scan(qx, kx, vx, lfx, sc_f)
    ox_b, _ = _gla_scan(flip(qx), flip(kx), flip(vx), flip(lbx), sc_b)
    gla_x = _gla_readout(ox_f + flip(ox_b), px[3], g_gla)

    qa = _apply_rope2d(_heads(px[6], ATT_HQ), cos, sin) * ATT_HD ** -0.5
    ka = _apply_rope2d(_heads(px[7], ATT_HKV), cos, sin)
    va = _heads(px[8], ATT_HKV)
    qca = _heads(pc[6], ATT_HQ) * ATT_HD ** -0.5
    kca = _heads(pc[7], ATT_HKV)
    vca = _heads(pc[8], ATT_HKV)
    att_x = _window_attention(qa, ka, va, kca, vca, att_sink)

    def merge(p, gla_o, att_o):
        return (jax.nn.sigmoid(p[9]) * (gla_o @ w_br_gla)
                + jax.nn.sigmoid(p[10]) * (att_o @ w_br_att)) @ w_out

    y_x = merge(px, gla_x, att_x)
    if not with_ctx_out:
        return y_x, None
    gla_c = _gla_readout(oc_f + flip(oc_b), pc[3], g_gla)
    att_c = _ctx_attention(qca, kca, vca, att_sink)
    return y_x, merge(pc, gla_c, att_c)


def _swiglu(h, wg, wu, wd):
    return (jax.nn.silu(h @ wg) * (h @ wu)) @ wd


def _moe(h, w_router, b_router, wg, wu, wd):
    logits = (h @ w_router).astype(jnp.float32) + b_router.astype(jnp.float32)
    top_v, top_i = lax.top_k(logits, TOP_K)
    top_w = jax.nn.softmax(top_v, axis=-1)
    comb = jnp.sum(jax.nn.one_hot(top_i, N_EXPERTS, dtype=jnp.float32) * top_w[..., None], axis=-2)
    comb = comb.astype(h.dtype)
    out = jnp.zeros_like(h)
    for e in range(N_EXPERTS):
        out = out + comb[..., e:e + 1] * _swiglu(h, wg[e], wu[e], wd[e])
    return out


def _channel_mixer(layer, h, w_ffn_gate, w_ffn_up, w_ffn_down, w_router, b_router,
                   w_exp_gate, w_exp_up, w_exp_down):
    i = layer // 2
    if layer % 2 == 0:
        return _swiglu(h, w_ffn_gate[i], w_ffn_up[i], w_ffn_down[i])
    return _moe(h, w_router[i], b_router[i], w_exp_gate[i], w_exp_up[i], w_exp_down[i])


def setup_inputs(seed: int = 0) -> dict:
    key = jax.random.key(seed)
    ks = iter(jax.random.split(key, 32))
    f32 = jnp.float32

    def nrm(shape, scale):
        return jax.random.normal(next(ks), shape, f32) * scale

    D = D_MODEL
    GV = GLA_HEADS * GLA_DV
    AW = ATT_HQ * ATT_HD
    GK = GLA_HEADS * GLA_DK
    return {
        'x': nrm((BATCH, SEQ, D), 1.0),
        'c': nrm((BATCH, D), 1.0),
        'ctx': nrm((BATCH, CTX_LEN, D), 1.0),
        'c_ctx': nrm((D,), 1.0),
        'w_mod': nrm((DEPTH, D, 6 * D), D ** -0.5),
        'b_mod': nrm((DEPTH, 6 * D), 0.02),
        'g_pre_mix': 1.0 + nrm((DEPTH, D), 0.05),
        'g_post_mix': 1.0 + nrm((DEPTH, D), 0.05),
        'g_pre_ffn': 1.0 + nrm((DEPTH, D), 0.05),
        'g_post_ffn': 1.0 + nrm((DEPTH, D), 0.05),
        'w_in': nrm((DEPTH, D, D_IN), D ** -0.5),
        'w_lr_f': nrm((DEPTH, GLA_RANK, GK), GLA_RANK ** -0.5),
        'b_lr_f': nrm((DEPTH, GK), 0.1),
        'w_lr_b': nrm((DEPTH, GLA_RANK, GK), GLA_RANK ** -0.5),
        'b_lr_b': nrm((DEPTH, GK), 0.1),
        'g_gla': 1.0 + nrm((DEPTH, GLA_DV), 0.05),
        'att_sink': nrm((DEPTH, ATT_HQ), 0.5),
        'w_br_gla': nrm((DEPTH, GV, D), GV ** -0.5),
        'w_br_att': nrm((DEPTH, AW, D), AW ** -0.5),
        'w_out': nrm((DEPTH, D, D), D ** -0.5),
        'w_ffn_gate': nrm((N_DENSE, D, D_FF), D ** -0.5),
        'w_ffn_up': nrm((N_DENSE, D, D_FF), D ** -0.5),
        'w_ffn_down': nrm((N_DENSE, D_FF, D), D_FF ** -0.5),
        'w_router': nrm((N_MOE, D, N_EXPERTS), D ** -0.5),
        'b_router': nrm((N_MOE, N_EXPERTS), 0.01),
        'w_exp_gate': nrm((N_MOE, N_EXPERTS, D, D_FF), D ** -0.5),
        'w_exp_up': nrm((N_MOE, N_EXPERTS, D, D_FF), D ** -0.5),
        'w_exp_down': nrm((N_MOE, N_EXPERTS, D_FF, D), D_FF ** -0.5),
    }


def reference(x, c, ctx, c_ctx, w_mod, b_mod, g_pre_mix, g_post_mix, g_pre_ffn, g_post_ffn,
              w_in, w_lr_f, b_lr_f, w_lr_b, b_lr_b, g_gla, att_sink, w_br_gla, w_br_att, w_out,
              w_ffn_gate, w_ffn_up, w_ffn_down, w_router, b_router, w_exp_gate, w_exp_up, w_exp_down):
    L = x.shape[1]
    ROWS = L // GRID_W
    cos, sin = _rope_tables(ROWS)
    for l in range(DEPTH):
        last = l == DEPTH - 1
        mod_x = jax.nn.silu(c) @ w_mod[l] + b_mod[l]
        mod_c = jax.nn.silu(c_ctx) @ w_mod[l] + b_mod[l]
        sh1, sc1, gt1, sh2, sc2, gt2 = jnp.split(mod_x[:, None, :], 6, axis=-1)
        ch1, cs1, cg1, ch2, cs2, cg2 = jnp.split(mod_c, 6, axis=-1)

        hx = _rmsnorm(x, g_pre_mix[l]) * (1.0 + sc1) + sh1
        hc = _rmsnorm(ctx, g_pre_mix[l]) * (1.0 + cs1) + ch1
        yx, yc = _token_mixer(hx, hc, w_in[l], w_lr_f[l], b_lr_f[l], w_lr_b[l], b_lr_b[l],
                              g_gla[l], att_sink[l], w_br_gla[l], w_br_att[l], w_out[l],
                              cos, sin, not last)
        x = x + gt1 * _rmsnorm(yx, g_post_mix[l])
        if not last:
            ctx = ctx + cg1 * _rmsnorm(yc, g_post_mix[l])

        hx = _rmsnorm(x, g_pre_ffn[l]) * (1.0 + sc2) + sh2
        fx = _channel_mixer(l, hx, w_ffn_gate, w_ffn_up, w_ffn_down, w_router, b_router,
                            w_exp_gate, w_exp_up, w_exp_down)
        x = x + gt2 * _rmsnorm(fx, g_post_ffn[l])
        if not last:
            hc = _rmsnorm(ctx, g_pre_ffn[l]) * (1.0 + cs2) + ch2
            fc = _channel_mixer(l, hc, w_ffn_gate, w_ffn_up, w_ffn_down, w_router, b_router,
                                w_exp_gate, w_exp_up, w_exp_down)
            ctx = ctx + cg2 * _rmsnorm(fc, g_post_ffn[l])
    return x
```

```cpp
#include <hip/hip_runtime.h>
#include <cstdio>
#include <cstdint>

#ifndef FAST_MIX
#define FAST_MIX 1
#endif
#ifndef MIXCHECK
#define MIXCHECK 0
#endif
#ifndef MIXCHECK_TOL
#define MIXCHECK_TOL 1e-3f
#endif
#ifndef PROBE_PARTS
#define PROBE_PARTS 3
#endif
#ifndef PROBE_MASK
#define PROBE_MASK 0u
#endif
#ifndef MOE_FP8
#define MOE_FP8 1
#endif
#ifndef DENSE_FP8
#define DENSE_FP8 2
#endif
#ifndef CTX_SPLIT
#define CTX_SPLIT 1
#endif
#ifndef MK_N_LAUNCHES
#define MK_N_LAUNCHES 1
#endif

#define LAS __attribute__((address_space(3)))
#define GAS __attribute__((address_space(1)))
typedef unsigned short bf16;
typedef short bf16x8 __attribute__((ext_vector_type(8)));
typedef float f32x4 __attribute__((ext_vector_type(4)));
typedef float f32x2 __attribute__((ext_vector_type(2)));
typedef unsigned u32x4 __attribute__((ext_vector_type(4)));
typedef unsigned u32x2 __attribute__((ext_vector_type(2)));
typedef int v4i_t __attribute__((ext_vector_type(4)));
typedef int v8i_t __attribute__((ext_vector_type(8)));

constexpr int D = 2048, NB = 2, SEQ = 4096, CTXL = 256, ML = NB * SEQ, MC = NB * CTXL, MT = ML + MC;
constexpr int DIN = 12832, NP = 13056;
constexpr int OQ = 0, OKK = 1024, OV = 2048, ORG = 4096, OAQ = 6144, OAK = 8192, OAV = 8448, OG9 = 8704, OG10 = 10752, OLR = 12800;
constexpr int DFF = 5632, NE = 8, NGU = 2 * DFF;
constexpr int GH = 4, GDK = 256, GDV = 512;
constexpr int AHQ = 32, AHKV = 4, AHD = 64, AWIN = 128;
constexpr float RMS_EPS = 1e-6f;
constexpr float W8_SCALE = 64.0f, X8_SCALE = 16.0f, H8_SCALE = 8.0f; constexpr int W8_E = 127 - 6, X8_E = 127 - 4, H8_E = 127 - 3;
constexpr int MOE_CAP = 8192;
constexpr int MOE_ROWS = 2 * ML + NE * 256;

constexpr size_t MiB = 1u << 20;
constexpr size_t WS_CTL = 0, CTL_ZERO_BYTES = 1 * MiB;
constexpr size_t WS_MOD = 1 * MiB;
constexpr size_t SZ_WIN = (size_t)NP * D * 2, SZ_WSQ = (size_t)D * D * 2, SZ_GU = (size_t)NGU * D * 2, SZ_DN = (size_t)D * DFF * 2;
constexpr size_t WS_WIN = 2 * MiB;
constexpr size_t WS_WBG = WS_WIN + 2 * SZ_WIN, WS_WBA = WS_WBG + 2 * SZ_WSQ, WS_WO = WS_WBA + 2 * SZ_WSQ;
constexpr size_t WS_FGU = WS_WO + 2 * SZ_WSQ, WS_FDN = WS_FGU + SZ_GU;
constexpr size_t WS_EGU = WS_FDN + SZ_DN, WS_EDN = WS_EGU + NE * SZ_GU;
constexpr size_t WS_WEND = WS_EDN + NE * SZ_DN;
constexpr size_t alignup(size_t x) { return (x + MiB - 1) / MiB * MiB; }
constexpr size_t WS_XS = alignup(WS_WEND);
constexpr size_t WS_HX = WS_XS + alignup((size_t)MT * D * 4);
constexpr size_t WS_P = WS_HX + alignup((size_t)MT * D * 2);
constexpr size_t SZ_P = alignup((size_t)MT * NP * 2);
static_assert((size_t)MOE_ROWS * DFF * 2 <= SZ_P, "H_moe overlays P");
constexpr size_t WS_LAF = WS_P + SZ_P;
constexpr size_t WS_LAB = WS_LAF + alignup((size_t)MT * 1024 * 4);
constexpr size_t WS_OF = WS_LAB + alignup((size_t)MT * 1024 * 4);
constexpr size_t WS_OB = WS_OF + alignup((size_t)MT * D * 4);
constexpr size_t WS_QR = WS_OB + alignup((size_t)MT * D * 4);
static_assert((size_t)MOE_ROWS * D * 4 <= WS_QR - WS_LAF, "YM overlays LA/OF/OB");
constexpr size_t WS_KR = WS_QR + alignup((size_t)MT * D * 2);
constexpr size_t WS_GX = WS_KR + alignup((size_t)MT * 256 * 2);
constexpr size_t WS_AX = WS_GX + alignup((size_t)MT * D * 2);
constexpr size_t WS_O1 = WS_AX + alignup((size_t)MT * D * 2);
constexpr size_t WS_Y = WS_O1 + alignup((size_t)MT * D * 2);
constexpr size_t WS_YP = WS_OF;
constexpr int YP_S3 = 8, YP_S5 = 11;
static_assert((size_t)YP_S5 * MC * D * 4 <= 2 * ((size_t)MT * D * 4), "YP fits OF|OB");
constexpr size_t WS_HX8 = WS_O1;
constexpr size_t WS_LIST = WS_Y + alignup((size_t)MT * D * 4);
constexpr size_t WS_TINFO = WS_LIST + (size_t)NE * MOE_CAP * 4;
constexpr int NIT = NB * GH * 68;
constexpr size_t WS_QIN = alignup(WS_TINFO + (size_t)ML * 8 * 4);
constexpr size_t SZ_QIN = (size_t)MT * 1024 * 2;
constexpr size_t WS_KTO = WS_QIN + alignup(2 * SZ_QIN);
constexpr size_t SZ_KTO = (size_t)NIT * 256 * 64 * 2;
constexpr size_t WS_AIN = WS_KTO + alignup(2 * SZ_KTO);
constexpr size_t SZ_AIN = (size_t)NIT * 64 * 64 * 2;
constexpr size_t WS_DEC = WS_AIN + alignup(2 * SZ_AIN);
constexpr size_t SZ_DEC = (size_t)NIT * 256 * 4;
constexpr size_t WS_VT = WS_DEC + alignup(2 * SZ_DEC);
constexpr size_t WS_VAT = WS_VT + alignup((size_t)NIT * 512 * 64 * 2);
constexpr size_t WS_CHK = WS_VAT + alignup((size_t)(MT / 64) * 4 * 64 * 64 * 2);
constexpr size_t WS_LRB = WS_CHK;
constexpr size_t SZ_LRB = (size_t)MT * 256 * 2;
constexpr size_t WS_END = WS_LRB + alignup(2 * SZ_LRB);
constexpr size_t WS_OF2 = WS_Y, WS_OB2 = WS_Y + alignup((size_t)MT * D * 2), WS_AX2 = WS_O1;
constexpr int CW_CNT = 64;
constexpr int CW_ROPE = 96;
constexpr int CW_CHK = 128;
constexpr int CW_BAR = 4096;

constexpr int RING_BYTES = 131072;
constexpr int MISC_OFF = 147456;
constexpr int LDS_BYTES = 151552;

__device__ __forceinline__ unsigned cvt_pk_bf16(float lo, float hi) { unsigned r; asm volatile("v_cvt_pk_bf16_f32 %0, %1, %2" : "=v"(r) : "v"(lo), "v"(hi)); return r; }
__device__ __forceinline__ bf16 f2bf(float f) { return (bf16)(cvt_pk_bf16(f, 0.f) & 0xffffu); }
__device__ __forceinline__ float bf2f(bf16 b) { return __uint_as_float(((unsigned)b) << 16); }
__device__ __forceinline__ float bflo(unsigned w) { return __uint_as_float(w << 16); }
__device__ __forceinline__ float bfhi(unsigned w) { return __uint_as_float(w & 0xffff0000u); }
__device__ __forceinline__ float wave_sum(float v) {
    v += __builtin_bit_cast(float, __builtin_amdgcn_update_dpp(0, __builtin_bit_cast(int, v), 0xB1, 0xF, 0xF, true));
    v += __builtin_bit_cast(float, __builtin_amdgcn_update_dpp(0, __builtin_bit_cast(int, v), 0x4E, 0xF, 0xF, true));
    v += __builtin_bit_cast(float, __builtin_amdgcn_update_dpp(0, __builtin_bit_cast(int, v), 0x124, 0xF, 0xF, true));
    v += __builtin_bit_cast(float, __builtin_amdgcn_update_dpp(0, __builtin_bit_cast(int, v), 0x128, 0xF, 0xF, true));
    auto a = __builtin_amdgcn_permlane16_swap(__float_as_uint(v), __float_as_uint(v), false, false); v = __uint_as_float(a[0]) + __uint_as_float(a[1]);
    auto b = __builtin_amdgcn_permlane32_swap(__float_as_uint(v), __float_as_uint(v), false, false); return __uint_as_float(b[0]) + __uint_as_float(b[1]);
}
__device__ __forceinline__ float sigmoidf_(float x) { return 1.0f / (1.0f + __expf(-x)); }
__device__ __forceinline__ float siluf_(float x) { return x / (1.0f + __expf(-x)); }
__device__ __forceinline__ float logsigf_(float z) { return fminf(z, 0.f) - log1pf(__expf(-fabsf(z))); }
__device__ __forceinline__ unsigned pk4_fp8(float a, float b, float c, float d) {
    a = __builtin_amdgcn_fmed3f(a, -448.f, 448.f); b = __builtin_amdgcn_fmed3f(b, -448.f, 448.f); c = __builtin_amdgcn_fmed3f(c, -448.f, 448.f); d = __builtin_amdgcn_fmed3f(d, -448.f, 448.f);
    int w = 0; w = __builtin_amdgcn_cvt_pk_fp8_f32(a, b, w, false); w = __builtin_amdgcn_cvt_pk_fp8_f32(c, d, w, true); return (unsigned)w; }
#define LDS_WAIT() asm volatile("s_waitcnt lgkmcnt(0)" ::: "memory")
#define VM_WAIT() asm volatile("s_waitcnt vmcnt(0)" ::: "memory")

namespace pg {
constexpr int BM = 256, BK = 64, HALF = 128, HTB = HALF * BK * 2, STAGE_BYTES = 8 * HTB, NXCD = 8, WGM = 8;
__host__ __device__ __forceinline__ int lds_byte(int r, int c) { const int st = (r >> 4) * 2 + (c >> 5), rr = r & 15, cc = c & 31, ob = rr * 64 + cc * 2; return st * 1024 + (ob ^ (((ob >> 9) & 1) << 5)); }
__host__ __device__ __forceinline__ void stage_rc(int b, int& R, int& C) { const int st = b / 1024, sb = b % 1024, swz = sb ^ (((sb >> 9) & 1) << 5); R = (st >> 1) * 16 + swz / 64; C = (st & 1) * 32 + (swz % 64) / 2; }
__host__ __device__ __forceinline__ int perm32(int rho) { const int n = rho >> 4, i = rho & 15; return 8 * (i >> 2) + 4 * n + (i & 3); }

struct Unit { int pm, pn, e, pl; };

__device__ __forceinline__ void tile_of(int L, int nM, int nN, int& pm, int& pn) {
    const int nwg = nM * nN; int wgid = L;
    { const int q = nwg / NXCD, r = nwg % NXCD, xcd = wgid % NXCD, off = wgid / NXCD; wgid = (xcd < r ? xcd * (q + 1) : r * (q + 1) + (xcd - r) * q) + off; }
    const int nig = WGM * nN, gid = wgid / nig, fm = gid * WGM, gsz = (nM - fm) < WGM ? (nM - fm) : WGM;
    pm = fm + ((wgid % nig) % gsz); pn = (wgid % nig) / gsz;
}
struct SchedDense {
    static constexpr bool GATHER = false;
    const char* A; const char* Bt; int K, nM, nN, nwg, G, c, nex, sa = 127, sb = 127;
    __device__ __forceinline__ void init(const void* A_, const void* Bt_, int M, int N, int K_, int G_, int c_, int nex_) { A = (const char*)A_; Bt = (const char*)Bt_; K = K_; nM = M / BM; nN = N / BM; nwg = nM * nN; G = G_; c = c_; nex = nex_; }
    __device__ __forceinline__ bool next(int i, Unit& u) const {
        const int L = i * G + c; u.e = 0; u.pl = 0;
        if (L < nwg) { tile_of(L, nM, nN, u.pm, u.pn); return true; }
        if (L < nwg + nex) { const int j = L - nwg, t = j % 15; u.pm = 32 + j / 15; u.pn = t < 12 ? 4 + t : (t < 14 ? 32 + (t - 12) : 50); return true; }
        return false;
    }
    __device__ __forceinline__ const char* a_base(const Unit& u) const { return A + (size_t)u.pm * BM * K * 2; }
    __device__ __forceinline__ const char* b_base(const Unit& u) const { return Bt + (size_t)u.pn * BM * K * 2; }
    __device__ __forceinline__ void a_offs(const Unit&, const int (&)[2], const int (&)[2], unsigned (&)[2][2]) const {}
    __device__ __forceinline__ int nt_of(const Unit&, int nt) const { return nt; }
};
struct SchedCtxSplit {
    static constexpr bool GATHER = false;
    const char* A; const char* Bt; int K, nN, G, c, S, nts, sa = 127, sb = 127;
    __device__ __forceinline__ void init(const void* A_, const void* Bt_, int N, int K_, int G_, int c_, int S_) { A = (const char*)A_; Bt = (const char*)Bt_; K = K_; nN = N / BM; G = G_; c = c_; S = S_; nts = K_ / BK / S_; }
    __device__ __forceinline__ bool next(int i, Unit& u) const {
        const int L = i * G + c, nlat = (ML / BM) * nN; u.pl = 0;
        if (L < nlat) { tile_of(L, ML / BM, nN, u.pm, u.pn); u.e = 0; return true; }
        const int j = L - nlat; if (j >= 2 * nN * S) return false;
        const int jt = j % (2 * nN); u.pm = ML / BM + jt / nN; u.pn = jt % nN; u.e = 1 + j / (2 * nN); return true;
    }
    __device__ __forceinline__ const char* a_base(const Unit& u) const { return A + (size_t)u.pm * BM * K * 2 + (u.e ? (size_t)(u.e - 1) * nts * BK * 2 : 0); }
    __device__ __forceinline__ const char* b_base(const Unit& u) const { return Bt + (size_t)u.pn * BM * K * 2 + (u.e ? (size_t)(u.e - 1) * nts * BK * 2 : 0); }
    __device__ __forceinline__ void a_offs(const Unit&, const int (&)[2], const int (&)[2], unsigned (&)[2][2]) const {}
    __device__ __forceinline__ int nt_of(const Unit& u, int nt) const { return u.e ? nts : nt; }
};
struct SchedBranch {
    static constexpr bool GATHER = false;
    const char *A0, *A1, *B0, *B1; int K, nM, nN, nwg, G, c; static constexpr int sa = 127, sb = 127;
    __device__ __forceinline__ void init(const void* a0, const void* a1, const void* b0, const void* b1, int M, int N, int K_, int G_, int c_) { A0 = (const char*)a0; A1 = (const char*)a1; B0 = (const char*)b0; B1 = (const char*)b1; K = K_; nM = M / BM; nN = N / BM; nwg = nM * nN; G = G_; c = c_; }
    __device__ __forceinline__ bool next(int i, Unit& u) const {
        const int L = (i >> 1) * G + c; if (L >= nwg) return false;
        tile_of(L, nM, nN, u.pm, u.pn); u.e = i & 1; u.pl = 0; return true;
    }
    __device__ __forceinline__ const char* a_base(const Unit& u) const { return (u.e ? A1 : A0) + (size_t)u.pm * BM * K * 2; }
    __device__ __forceinline__ const char* b_base(const Unit& u) const { return (u.e ? B1 : B0) + (size_t)u.pn * BM * K * 2; }
    __device__ __forceinline__ void a_offs(const Unit&, const int (&)[2], const int (&)[2], unsigned (&)[2][2]) const {}
    __device__ __forceinline__ int nt_of(const Unit&, int nt) const { return nt; }
};
template <bool GATHER_> struct SchedMoe {
    static constexpr bool GATHER = GATHER_;
    const char* A; const char* Bt; size_t bstride; const int* list; int K, nN, G, c, sa, sb;
    int cnt[NE], ub[NE + 1], pb[NE + 1];
    __device__ __forceinline__ void init(const void* A_, const void* Bt_, size_t bstride_, const unsigned* cntw, const int* list_, int N, int K_, int G_, int c_) {
        A = (const char*)A_; Bt = (const char*)Bt_; bstride = bstride_; list = list_; K = K_; nN = N / BM; G = G_; c = c_; ub[0] = 0; pb[0] = 0; sa = 127; sb = 127;
#pragma unroll
        for (int e = 0; e < NE; ++e) { int v = __builtin_amdgcn_readfirstlane((int)cntw[e]); v = v > MOE_CAP ? MOE_CAP : v; cnt[e] = v; const int np = (v + 255) >> 8; pb[e + 1] = pb[e] + np; ub[e + 1] = ub[e] + np * nN; }
    }
    __device__ __forceinline__ bool next(int i, Unit& u) const {
        const int L = i * G + c; if (L >= ub[NE]) return false;
        int e = 0, base = 0, pbase = 0, np = 1;
#pragma unroll
        for (int j = 0; j < NE; ++j) if (L >= ub[j] && L < ub[j + 1]) { e = j; base = ub[j]; pbase = pb[j]; np = pb[j + 1] - pb[j]; }
        const int r = L - base; u.e = e; u.pn = r / np; u.pl = r % np; u.pm = pbase + u.pl; return true;
    }
    __device__ __forceinline__ const char* a_base(const Unit& u) const { return GATHER ? A : A + (size_t)u.pm * BM * K * 2; }
    __device__ __forceinline__ const char* b_base(const Unit& u) const { return Bt + (size_t)u.e * bstride + (size_t)u.pn * BM * K * 2; }
    __device__ __forceinline__ int nt_of(const Unit&, int nt) const { return nt; }
    __device__ __forceinline__ void a_offs(const Unit& u, const int (&R)[2], const int (&C)[2], unsigned (&off)[2][2]) const {
        int n = 0;
#pragma unroll
        for (int j = 0; j < NE; ++j) if (u.e == j) n = cnt[j];
#pragma unroll
        for (int h = 0; h < 2; ++h)
#pragma unroll
            for (int i = 0; i < 2; ++i) { const int slot = u.pl * 256 + h * HALF + R[i]; const int tok = slot < n ? list[u.e * MOE_CAP + slot] : 0; off[h][i] = (unsigned)(tok * K + C[i]) * 2u; }
    }
};

struct EpiBf16 {
    static constexpr bool PERM = true;
    bf16* O; int ldc; int skip = 0;
    bf16* O2 = nullptr; int pn2 = -1;
    __device__ __forceinline__ bool keep(const Unit&) const { return false; }
    __device__ __forceinline__ void operator()(f32x4 (&acc)[2][2][4][2], const Unit& u, int wr, int wc, int fr, int fq) const {
        if (skip) { if (skip == 2 && acc[0][0][0][0][0] == 12345.678f) O[0] = 1; return; }
        const int row0 = u.pm * BM + wr * 64 + fr; int col0 = u.pn * BM + wc * 32 + 8 * fq;
        bf16* Ob = O; int ld = ldc;
        if (u.pn == pn2) { Ob = O2; ld = BM; col0 -= pn2 * BM; }
#pragma unroll
        for (int ai = 0; ai < 2; ++ai)
#pragma unroll
            for (int m = 0; m < 4; ++m) { bf16* rowp = Ob + (size_t)(row0 + ai * HALF + m * 16) * ld + col0;
#pragma unroll
                for (int bj = 0; bj < 2; ++bj) { const f32x4 v0 = acc[ai][bj][m][0], v1 = acc[ai][bj][m][1];
                    u32x4 w; w.x = cvt_pk_bf16(v0[0], v0[1]); w.y = cvt_pk_bf16(v0[2], v0[3]); w.z = cvt_pk_bf16(v1[0], v1[1]); w.w = cvt_pk_bf16(v1[2], v1[3]);
                    *(u32x4*)(rowp + bj * HALF) = w; } }
    }
};
struct EpiBf16Ctx {
    static constexpr bool PERM = true;
    bf16* O; float* YP; int ldc;
    __device__ __forceinline__ bool keep(const Unit&) const { return false; }
    __device__ __forceinline__ void operator()(f32x4 (&acc)[2][2][4][2], const Unit& u, int wr, int wc, int fr, int fq) const {
        const int row0 = u.pm * BM + wr * 64 + fr, col0 = u.pn * BM + wc * 32 + 8 * fq;
        if (u.e == 0) {
#pragma unroll
            for (int ai = 0; ai < 2; ++ai)
#pragma unroll
                for (int m = 0; m < 4; ++m) { bf16* rowp = O + (size_t)(row0 + ai * HALF + m * 16) * ldc + col0;
#pragma unroll
                    for (int bj = 0; bj < 2; ++bj) { const f32x4 v0 = acc[ai][bj][m][0], v1 = acc[ai][bj][m][1];
                        u32x4 w; w.x = cvt_pk_bf16(v0[0], v0[1]); w.y = cvt_pk_bf16(v0[2], v0[3]); w.z = cvt_pk_bf16(v1[0], v1[1]); w.w = cvt_pk_bf16(v1[2], v1[3]);
                        *(u32x4*)(rowp + bj * HALF) = w; } }
        } else {
            float* base = YP + (size_t)(u.e - 1) * MC * ldc;
#pragma unroll
            for (int ai = 0; ai < 2; ++ai)
#pragma unroll
                for (int m = 0; m < 4; ++m) { float* rowp = base + (size_t)(row0 - ML + ai * HALF + m * 16) * ldc + col0;
#pragma unroll
                    for (int bj = 0; bj < 2; ++bj) { *(f32x4*)(rowp + bj * HALF) = acc[ai][bj][m][0]; *(f32x4*)(rowp + bj * HALF + 4) = acc[ai][bj][m][1]; } }
        }
    }
};
struct EpiF32 {
    static constexpr bool PERM = false;
    float* Cp; int ldc;
    __device__ __forceinline__ bool keep(const Unit&) const { return false; }
    __device__ __forceinline__ void operator()(f32x4 (&acc)[2][2][4][2], const Unit& u, int wr, int wc, int fr, int fq) const {
        const int row0 = u.pm * BM + wr * 64 + fr, col0 = u.pn * BM + wc * 32 + 4 * fq;
#pragma unroll
        for (int ai = 0; ai < 2; ++ai)
#pragma unroll
            for (int m = 0; m < 4; ++m) { float* rowp = Cp + (size_t)(row0 + ai * HALF + m * 16) * ldc + col0;
#pragma unroll
                for (int bj = 0; bj < 2; ++bj)
#pragma unroll
                    for (int n = 0; n < 2; ++n) *(f32x4*)(rowp + bj * HALF + n * 16) = acc[ai][bj][m][n]; }
    }
};
struct EpiSwiGLU {
    static constexpr bool PERM = true;
    bf16* H; int ldh;
    __device__ __forceinline__ bool keep(const Unit&) const { return false; }
    __device__ __forceinline__ void operator()(f32x4 (&acc)[2][2][4][2], const Unit& u, int wr, int wc, int fr, int fq) const {
        const int row0 = u.pm * BM + wr * 64 + fr, col0 = u.pn * HALF + wc * 32 + 8 * fq;
#pragma unroll
        for (int ai = 0; ai < 2; ++ai)
#pragma unroll
            for (int m = 0; m < 4; ++m) { bf16* rowp = H + (size_t)(row0 + ai * HALF + m * 16) * ldh + col0;
                float o[8];
#pragma unroll
                for (int n = 0; n < 2; ++n)
#pragma unroll
                    for (int j = 0; j < 4; ++j) { const float g = acc[ai][0][m][n][j], up = acc[ai][1][m][n][j]; o[n * 4 + j] = g * __builtin_amdgcn_rcpf(1.0f + __expf(-g)) * up; }
                u32x4 w; w.x = cvt_pk_bf16(o[0], o[1]); w.y = cvt_pk_bf16(o[2], o[3]); w.z = cvt_pk_bf16(o[4], o[5]); w.w = cvt_pk_bf16(o[6], o[7]);
                *(u32x4*)rowp = w; }
    }
};
struct EpiSwiGLU8 {
    static constexpr bool PERM = true;
    unsigned char* H; int ldh; float oscale;
    __device__ __forceinline__ bool keep(const Unit&) const { return false; }
    __device__ __forceinline__ void operator()(f32x4 (&acc)[2][2][4][2], const Unit& u, int wr, int wc, int fr, int fq) const {
        const int row0 = u.pm * BM + wr * 64 + fr, col0 = u.pn * HALF + wc * 32 + 8 * fq;
#pragma unroll
        for (int ai = 0; ai < 2; ++ai)
#pragma unroll
            for (int m = 0; m < 4; ++m) { unsigned char* rowp = H + (size_t)(row0 + ai * HALF + m * 16) * ldh + col0;
                float o[8];
#pragma unroll
                for (int n = 0; n < 2; ++n)
#pragma unroll
                    for (int j = 0; j < 4; ++j) { const float g = acc[ai][0][m][n][j], up = acc[ai][1][m][n][j]; o[n * 4 + j] = g * __builtin_amdgcn_rcpf(1.0f + __expf(-g)) * up * oscale; }
                u32x2 w; w.x = pk4_fp8(o[0], o[1], o[2], o[3]); w.y = pk4_fp8(o[4], o[5], o[6], o[7]);
                *(u32x2*)rowp = w; }
    }
};
struct EpiBranch {
    static constexpr bool PERM = true;
    const bf16* P; bf16* O; int ldc;
    __device__ __forceinline__ bool keep(const Unit& u) const { return u.e == 0; }
    __device__ __forceinline__ void operator()(f32x4 (&acc)[2][2][4][2], const Unit& u, int wr, int wc, int fr, int fq) const {
        const int row0 = u.pm * BM + wr * 64 + fr, col0 = u.pn * BM + wc * 32 + 8 * fq;
#pragma unroll
        for (int ai = 0; ai < 2; ++ai)
#pragma unroll
            for (int m = 0; m < 4; ++m) { const size_t row = (size_t)(row0 + ai * HALF + m * 16);
#pragma unroll
                for (int bj = 0; bj < 2; ++bj) {
                    const u32x4 g10 = *(const u32x4*)(P + row * NP + OG10 + col0 + bj * HALF);
                    float s[8]; s[0] = bflo(g10.x); s[1] = bfhi(g10.x); s[2] = bflo(g10.y); s[3] = bfhi(g10.y); s[4] = bflo(g10.z); s[5] = bfhi(g10.z); s[6] = bflo(g10.w); s[7] = bfhi(g10.w);
                    if (u.e == 0) {
                        const u32x4 g9 = *(const u32x4*)(P + row * NP + OG9 + col0 + bj * HALF);
                        float t[8]; t[0] = bflo(g9.x); t[1] = bfhi(g9.x); t[2] = bflo(g9.y); t[3] = bfhi(g9.y); t[4] = bflo(g9.z); t[5] = bfhi(g9.z); t[6] = bflo(g9.w); t[7] = bfhi(g9.w);
#pragma unroll
                        for (int j = 0; j < 8; ++j) { const float f = (1.0f + __expf(-s[j])) / (1.0f + __expf(-t[j])); acc[ai][bj][m][j >> 2][j & 3] *= f; }
                    } else {
                        float o[8];
#pragma unroll
                        for (int j = 0; j < 8; ++j) o[j] = acc[ai][bj][m][j >> 2][j & 3] / (1.0f + __expf(-s[j]));
                        u32x4 w; w.x = cvt_pk_bf16(o[0], o[1]); w.y = cvt_pk_bf16(o[2], o[3]); w.z = cvt_pk_bf16(o[4], o[5]); w.w = cvt_pk_bf16(o[6], o[7]);
                        *(u32x4*)(O + row * ldc + col0 + bj * HALF) = w;
                    } } }
    }
};

template <class Epi, class Sched, bool ALIGN_EPI, bool FP8 = false, int KC = 0>
__device__ __forceinline__ void gemm_phase(LAS unsigned char* lds, const int tid, const Sched& S, const Epi& E) {
    const int wid = __builtin_amdgcn_readfirstlane(tid >> 6), lane = tid & 63, wr = wid >> 2, wc = wid & 3, fr = lane & 15, fq = lane >> 4;
    const int K = KC ? KC : S.K, nt = K / BK;
    int Rr[2], Cc[2]; unsigned voffA[2], voffB[2];
#pragma unroll
    for (int i = 0; i < 2; ++i) { stage_rc(tid * 16 + i * 8192, Rr[i], Cc[i]); const int Rb = Epi::PERM ? ((Rr[i] & ~31) + perm32(Rr[i] & 31)) : Rr[i];
        voffA[i] = (unsigned)(Rr[i] * K + Cc[i]) * 2u; voffB[i] = (unsigned)(Rb * K + Cc[i]) * 2u; }
    const size_t kstep = (size_t)(BK * 2);
    const size_t hstep = (size_t)HALF * K * 2;
    const unsigned ldsw = (unsigned)wid * 1024u;
    const int aoff = lds_byte(wr * 64 + fr, fq * 8), boff = lds_byte(wc * 32 + fr, fq * 8);
    unsigned gA[2][2] = {{0u, 0u}, {0u, 0u}}, gN[2][2] = {{0u, 0u}, {0u, 0u}};
#define PG_SA(b, h) (((b) * 2 + (h)) * HTB)
#define PG_SB(b, h) ((4 + (b) * 2 + (h)) * HTB)
#define PG_STAGE_B(bufoff, gbase) do { _Pragma("unroll") for (int _i = 0; _i < 2; ++_i) \
        __builtin_amdgcn_global_load_lds((const unsigned*)((const char*)(gbase) + voffB[_i]), (LAS unsigned*)(lds + (bufoff) + ldsw + _i * 8192), 16, 0, 0); } while (0)
#define PG_STAGE_A(bufoff, kptr, h, usenext) do { _Pragma("unroll") for (int _i = 0; _i < 2; ++_i) { \
        const char* _p; if constexpr (Sched::GATHER) _p = (const char*)(kptr) + ((usenext) ? gN[h][_i] : gA[h][_i]); else _p = (const char*)(kptr) + (h) * hstep + voffA[_i]; \
        __builtin_amdgcn_global_load_lds((const unsigned*)_p, (LAS unsigned*)(lds + (bufoff) + ldsw + _i * 8192), 16, 0, 0); } } while (0)
#define PG_LDA(dst, b, h) do { if constexpr (FP8) { _Pragma("unroll") for (int m = 0; m < 4; ++m) { const v4i_t lo_ = *(const LAS v4i_t*)(lds + PG_SA(b, h) + aoff + m * 2048), hi_ = *(const LAS v4i_t*)(lds + PG_SA(b, h) + aoff + m * 2048 + 1024); \
            dst##8[m] = __builtin_shufflevector(lo_, hi_, 0, 1, 2, 3, 4, 5, 6, 7); } } \
        else { _Pragma("unroll") for (int m = 0; m < 4; ++m) _Pragma("unroll") for (int k = 0; k < 2; ++k) dst[m][k] = *(const LAS bf16x8*)(lds + PG_SA(b, h) + aoff + m * 2048 + k * 1024); } } while (0)
#define PG_LDB(dst, b, h) do { if constexpr (FP8) { _Pragma("unroll") for (int n = 0; n < 2; ++n) { const v4i_t lo_ = *(const LAS v4i_t*)(lds + PG_SB(b, h) + boff + n * 2048), hi_ = *(const LAS v4i_t*)(lds + PG_SB(b, h) + boff + n * 2048 + 1024); \
            dst##8[n] = __builtin_shufflevector(lo_, hi_, 0, 1, 2, 3, 4, 5, 6, 7); } } \
        else { _Pragma("unroll") for (int n = 0; n < 2; ++n) _Pragma("unroll") for (int k = 0; k < 2; ++k) dst[n][k] = *(const LAS bf16x8*)(lds + PG_SB(b, h) + boff + n * 2048 + k * 1024); } } while (0)
#define PG_MMA(ai, bj, At, Bt) do { __builtin_amdgcn_s_setprio(1); _Pragma("unroll") for (int m = 0; m < 4; ++m) _Pragma("unroll") for (int n = 0; n < 2; ++n) { \
        if constexpr (FP8) { asm volatile("v_mfma_scale_f32_16x16x128_f8f6f4 %0, %1, %2, %0, %3, %4 op_sel_hi:[0,0,0]" : "+v"(acc[ai][bj][m][n]) : "v"(Bt##8[n]), "v"(At##8[m]), "v"(vsb), "v"(vsa)); } \
        else { _Pragma("unroll") for (int k = 0; k < 2; ++k) acc[ai][bj][m][n] = __builtin_amdgcn_mfma_f32_16x16x32_bf16(Bt[n][k], At[m][k], acc[ai][bj][m][n], 0, 0, 0); } } \
        __builtin_amdgcn_s_setprio(0); } while (0)
#define PG_WAIT_V(n) asm volatile("s_waitcnt vmcnt(" #n ")" ::: "memory")
#define PG_WAIT_L(n) asm volatile("s_waitcnt lgkmcnt(" #n ")" ::: "memory")
#define PG_BAR __builtin_amdgcn_s_barrier()
#define PG_SCHED __builtin_amdgcn_sched_barrier(0)
    Unit cur, nxt; int ui = 0;
    if (!S.next(0, cur)) return;
    f32x4 acc[2][2][4][2];
#pragma unroll
    for (int a = 0; a < 2; ++a)
#pragma unroll
        for (int b = 0; b < 2; ++b)
#pragma unroll
            for (int m = 0; m < 4; ++m)
#pragma unroll
                for (int n = 0; n < 2; ++n) acc[a][b][m][n] = (f32x4){0.f, 0.f, 0.f, 0.f};
    bf16x8 At[4][2], B0[2][2], B1[2][2]; v8i_t At8[4], B08[2], B18[2];
    const int vsa = S.sa, vsb = S.sb; (void)vsa; (void)vsb;
    const char* cA = S.a_base(cur); const char* cB = S.b_base(cur);
    if constexpr (Sched::GATHER) S.a_offs(cur, Rr, Cc, gA);
    PG_STAGE_B(PG_SB(0, 0), cB); PG_STAGE_B(PG_SB(0, 1), cB + hstep); PG_STAGE_A(PG_SA(0, 0), cA, 0, false); PG_STAGE_A(PG_SA(0, 1), cA, 1, false);
    if (wr == 1) PG_BAR;
    PG_WAIT_V(2); PG_BAR;
    PG_STAGE_B(PG_SB(1, 0), cB + kstep); PG_STAGE_A(PG_SA(1, 0), cA + kstep, 0, false); PG_STAGE_B(PG_SB(1, 1), cB + hstep + kstep);
    PG_WAIT_V(6); PG_BAR;
    for (;;) {
        const bool has_next = S.next(ui + 1, nxt);
        const char* nA = has_next ? S.a_base(nxt) : cA; const char* nB = has_next ? S.b_base(nxt) : cB;
        if constexpr (Sched::GATHER) { if (has_next) S.a_offs(nxt, Rr, Cc, gN); else { gN[0][0] = gA[0][0]; gN[0][1] = gA[0][1]; gN[1][0] = gA[1][0]; gN[1][1] = gA[1][1]; } }
        const int ntc = S.nt_of(cur, nt);
        for (int t = 0; t < ntc; t += 2) {
            const bool last = (t == ntc - 2);
            const char* a1 = cA + (size_t)(t + 1) * kstep;
            const char* a2 = last ? nA : cA + (size_t)(t + 2) * kstep; const char* b2 = last ? nB : cB + (size_t)(t + 2) * kstep;
            const char* a3 = a2 + kstep; const char* b3 = b2 + kstep;
            PG_LDB(B0, 0, 0); PG_LDB(B1, 0, 1); PG_SCHED; PG_LDA(At, 0, 0); PG_STAGE_A(PG_SA(1, 1), a1, 1, false);
            PG_WAIT_V(8); PG_WAIT_L(0); PG_BAR; PG_MMA(0, 0, At, B0); PG_MMA(0, 1, At, B1); PG_BAR; PG_SCHED;
            PG_LDA(At, 0, 1); PG_STAGE_B(PG_SB(0, 0), b2); PG_STAGE_B(PG_SB(0, 1), b2 + hstep); PG_STAGE_A(PG_SA(0, 0), a2, 0, last);
            PG_WAIT_V(8); PG_WAIT_L(0); PG_BAR; PG_MMA(1, 0, At, B0); PG_MMA(1, 1, At, B1); PG_BAR; PG_SCHED;
            PG_LDB(B0, 1, 0); PG_LDB(B1, 1, 1); PG_SCHED; PG_LDA(At, 1, 0); PG_STAGE_A(PG_SA(0, 1), a2, 1, last);
            PG_WAIT_V(8); PG_WAIT_L(0); PG_BAR; PG_MMA(0, 0, At, B0); PG_MMA(0, 1, At, B1); PG_BAR; PG_SCHED;
            PG_LDA(At, 1, 1); PG_STAGE_B(PG_SB(1, 0), b3); PG_STAGE_B(PG_SB(1, 1), b3 + hstep); PG_STAGE_A(PG_SA(1, 0), a3, 0, last);
            PG_WAIT_V(8); PG_WAIT_L(0); PG_BAR; PG_MMA(1, 0, At, B0); PG_MMA(1, 1, At, B1); PG_BAR; PG_SCHED;
        }
        if constexpr (ALIGN_EPI) { if (wr == 0) PG_BAR; }
        if constexpr (FP8) asm volatile("s_nop 15\n\ts_nop 15\n\ts_nop 15\n\ts_nop 15" ::: "memory");
        E(acc, cur, wr, wc, fr, fq);
        if (!has_next) break;
        if (!E.keep(cur)) {
#pragma unroll
            for (int a = 0; a < 2; ++a)
#pragma unroll
                for (int b = 0; b < 2; ++b)
#pragma unroll
                    for (int m = 0; m < 4; ++m)
#pragma unroll
                        for (int n = 0; n < 2; ++n) acc[a][b][m][n] = (f32x4){0.f, 0.f, 0.f, 0.f};
        }
        cur = nxt; cA = nA; cB = nB; ++ui;
        if constexpr (Sched::GATHER) { gA[0][0] = gN[0][0]; gA[0][1] = gN[0][1]; gA[1][0] = gN[1][0]; gA[1][1] = gN[1][1]; }
        if constexpr (ALIGN_EPI) { if (wr == 1) PG_BAR; }
    }
    PG_WAIT_V(0);
    if constexpr (!ALIGN_EPI) { if (wr == 0) PG_BAR; }
    PG_BAR;
#undef PG_SA
#undef PG_SB
#undef PG_STAGE_A
#undef PG_STAGE_B
#undef PG_LDA
#undef PG_LDB
#undef PG_MMA
#undef PG_WAIT_V
#undef PG_WAIT_L
#undef PG_BAR
#undef PG_SCHED
}
}

#define XB_TMO      128
#define XB_XCNT(j)  (256  + 64 * (j))
#define XB_XSUB(j)  (1280 + 64 * (j))
#define XB_XGEN(j)  (2304 + 64 * (j))
#define XB_TOP      3328
#define XB_TOPGEN   3392
#define XCD_BAR_WORDS 3456
#define XB_SPIN_CAP (1u << 18)
__device__ __forceinline__ unsigned xb_ld(unsigned* p)              { return __hip_atomic_load(p, __ATOMIC_RELAXED, __HIP_MEMORY_SCOPE_AGENT); }
__device__ __forceinline__ unsigned xb_add(unsigned* p, unsigned v) { return __hip_atomic_fetch_add(p, v, __ATOMIC_RELAXED, __HIP_MEMORY_SCOPE_AGENT); }
__device__ __forceinline__ unsigned xb_xcc_id() { return (unsigned)__builtin_amdgcn_s_getreg((3 << 11) | 20) & 0xFu; }
#define XB_SPIN(cond, bar) do { unsigned _sp = 0; while (cond) { __builtin_amdgcn_s_sleep(1); \
    if ((++_sp & 255u) == 0u) { if (xb_ld(&(bar)[XB_TMO])) break; if (_sp > XB_SPIN_CAP) { atomicAdd(&(bar)[XB_TMO], 1u); break; } } } } while (0)
struct XcdBarrier { unsigned* bar; unsigned x; volatile LAS unsigned* st; };
__device__ __forceinline__ XcdBarrier xcd_barrier_post(unsigned* bar, volatile LAS unsigned* st) {
    XcdBarrier b; b.bar = bar; b.x = xb_xcc_id(); b.st = st;
    if (threadIdx.x == 0) (void)xb_add(&bar[XB_XCNT(b.x)], 1u);
    return b;
}
__device__ __forceinline__ void xcd_barrier_complete(unsigned* bar, unsigned x, unsigned& nloc, unsigned& nx) {
    const unsigned G = gridDim.x * gridDim.y * gridDim.z;
    unsigned sum, cnt, mine, sp = 0u;
    for (;;) {
        sum = 0u; cnt = 0u; mine = 0u;
#pragma unroll
        for (unsigned j = 0; j < 16; ++j) { const unsigned c = xb_ld(&bar[XB_XCNT(j)]); sum += c; cnt += (c > 0u) ? 1u : 0u; mine = (j == x) ? c : mine; }
        if (sum == G) break;
        __builtin_amdgcn_s_sleep(1);
        if ((++sp & 255u) == 0u) { if (xb_ld(&bar[XB_TMO])) break; if (sp > XB_SPIN_CAP) { atomicAdd(&bar[XB_TMO], 1u); break; } }
    }
    nloc = mine > 0u ? mine : 1u; nx = cnt > 0u ? cnt : 1u;
}
__device__ __forceinline__ void xcd_barrier(const XcdBarrier& b) {
    asm volatile("s_waitcnt vmcnt(0)" ::: "memory");
    __syncthreads();
    if (threadIdx.x == 0) {
        unsigned* bar = b.bar;
        __builtin_amdgcn_s_waitcnt(0);
        unsigned nloc = b.st[0], nx = b.st[1];
        if (nloc == 0u) { xcd_barrier_complete(bar, b.x, nloc, nx); b.st[0] = nloc; b.st[1] = nx; }
        const unsigned old = xb_add(&bar[XB_XSUB(b.x)], 1u);
        const unsigned gen = old / nloc;
        if (old + 1u == (gen + 1u) * nloc) {
            __builtin_amdgcn_fence(__ATOMIC_RELEASE, "agent");
            asm volatile("s_waitcnt vmcnt(0)" ::: "memory");
            const unsigned og = xb_add(&bar[XB_TOP], 1u);
            const unsigned tg = og / nx;
            if (og + 1u == (tg + 1u) * nx) xb_add(&bar[XB_TOPGEN], 1u);
            else XB_SPIN(xb_ld(&bar[XB_TOPGEN]) == tg, bar);
            __builtin_amdgcn_fence(__ATOMIC_ACQUIRE, "agent");
            xb_add(&bar[XB_XGEN(b.x)], 1u);
            asm volatile("s_waitcnt vmcnt(0)" ::: "memory");
        } else {
            XB_SPIN(xb_ld(&bar[XB_XGEN(b.x)]) == gen, bar);
            __builtin_amdgcn_fence(__ATOMIC_ACQUIRE, "agent");
            asm volatile("s_waitcnt vmcnt(0)" ::: "memory");
        }
    }
    __syncthreads();
}

typedef const float* cfp_t; typedef const __attribute__((address_space(4))) cfp_t* in_table_t;
#define INP(i) ((const float*)(const GAS float*)F.in[i])
struct Frame {
    LAS unsigned char* lds;
    unsigned* ctl;
    int tid, lane, wave, vcu, G, bid;
    in_table_t in;
    float* out; unsigned char* ws;
};
enum { I_X = 0, I_C, I_CTX, I_CCTX, I_WMOD, I_BMOD, I_GPREMIX, I_GPOSTMIX, I_GPREFFN, I_GPOSTFFN, I_WIN, I_WLRF, I_BLRF, I_WLRB, I_BLRB, I_GGLA, I_SINK, I_WBRG, I_WBRA, I_WOUT,
       I_WFG, I_WFU, I_WFD, I_WROUTER, I_BROUTER, I_WEG, I_WEU, I_WED };

__device__ __forceinline__ void tr_item(const float* src  , int ldw, bf16* dst  , int K, LAS float* scr, int lane, bool zero) {
    if (zero) {
#pragma unroll
        for (int j = 0; j < 4; ++j) { const int n = (lane >> 3) + 8 * j; *(GAS u32x4*)(dst + (size_t)n * K + 8 * (lane & 7)) = (u32x4){0u, 0u, 0u, 0u}; }
        return;
    }
#pragma unroll
    for (int i = 0; i < 32; ++i) { const int kk = 2 * i + (lane >> 5); scr[kk * 33 + (lane & 31)] = __builtin_nontemporal_load(src + (size_t)kk * ldw + (lane & 31)); }
    LDS_WAIT(); asm volatile("" ::: "memory");
    const int c = lane & 7;
#pragma unroll
    for (int j = 0; j < 4; ++j) { const int n = (lane >> 3) + 8 * j; const LAS float* s = scr + (8 * c) * 33 + n;
        u32x4 o; o.x = cvt_pk_bf16(s[0 * 33], s[1 * 33]); o.y = cvt_pk_bf16(s[2 * 33], s[3 * 33]); o.z = cvt_pk_bf16(s[4 * 33], s[5 * 33]); o.w = cvt_pk_bf16(s[6 * 33], s[7 * 33]);
        *(GAS u32x4*)(dst + (size_t)n * K + 8 * c) = o; }
    LDS_WAIT(); asm volatile("" ::: "memory");
}
__device__ __forceinline__ void tr_plain(const float* W, int K, int N, bf16* WT, LAS float* scr, int item, int lane) {
    const int nblk = N / 32, kb = item / nblk, nb = item % nblk;
    tr_item(W + (size_t)(64 * kb) * N + 32 * nb, N, WT + (size_t)(32 * nb) * K + 64 * kb, K, scr, lane, false);
}
__device__ __forceinline__ void tr_win(const float* W, bf16* WT, LAS float* scr, int item, int lane) {
    const int nblk = NP / 32, kb = item / nblk, nb = item % nblk, n0 = 32 * nb;
    int ns; bool zero = false;
    if (n0 < 6144) ns = n0; else if (n0 < 12800) ns = n0 + 32; else if (n0 == 12800) ns = 6144; else { ns = 0; zero = true; }
    tr_item(W + (size_t)(64 * kb) * DIN + ns, DIN, WT + (size_t)n0 * D + 64 * kb, D, scr, lane, zero);
}
__device__ __forceinline__ void tr_gu(const float* Wg, const float* Wu, bf16* WT, LAS float* scr, int item, int lane) {
    const int nblk = NGU / 32, kb = item / nblk, nb = item % nblk, n0 = 32 * nb, tile = n0 >> 8, w = n0 & 255;
    const float* W = (w < 128) ? Wg : Wu; const int ns = tile * 128 + (w & 127);
    tr_item(W + (size_t)(64 * kb) * DFF + ns, DFF, WT + (size_t)n0 * D + 64 * kb, D, scr, lane, false);
}
__device__ __forceinline__ void tr_item8(const float* src, int ldw, unsigned char* dst  , int Kb, LAS float* scr, int lane, float scale) {
#pragma unroll
    for (int i = 0; i < 32; ++i) { const int kk = 2 * i + (lane >> 5); scr[kk * 33 + (lane & 31)] = __builtin_nontemporal_load(src + (size_t)kk * ldw + (lane & 31)); }
    LDS_WAIT(); asm volatile("" ::: "memory");
    const int c = lane & 3;
#pragma unroll
    for (int j = 0; j < 2; ++j) { const int n = (lane >> 2) + 16 * j; const LAS float* sp = scr + (16 * c) * 33 + n;
        u32x4 o; o.x = pk4_fp8(sp[0 * 33] * scale, sp[1 * 33] * scale, sp[2 * 33] * scale, sp[3 * 33] * scale); o.y = pk4_fp8(sp[4 * 33] * scale, sp[5 * 33] * scale, sp[6 * 33] * scale, sp[7 * 33] * scale);
        o.z = pk4_fp8(sp[8 * 33] * scale, sp[9 * 33] * scale, sp[10 * 33] * scale, sp[11 * 33] * scale); o.w = pk4_fp8(sp[12 * 33] * scale, sp[13 * 33] * scale, sp[14 * 33] * scale, sp[15 * 33] * scale);
        *(GAS u32x4*)(dst + (size_t)n * Kb + 16 * c) = o; }
    LDS_WAIT(); asm volatile("" ::: "memory");
}
__device__ __forceinline__ void tr_plain8(const float* W, int K, int N, unsigned char* WT, LAS float* scr, int item, int lane, float scale) {
    const int nblk = N / 32, kb = item / nblk, nb = item % nblk;
    tr_item8(W + (size_t)(64 * kb) * N + 32 * nb, N, WT + (size_t)(32 * nb) * K + 64 * kb, K, scr, lane, scale);
}
__device__ __forceinline__ void tr_gu8(const float* Wg, const float* Wu, unsigned char* WT, LAS float* scr, int item, int lane, float scale) {
    const int nblk = NGU / 32, kb = item / nblk, nb = item % nblk, n0 = 32 * nb, tile = n0 >> 8, w = n0 & 255;
    const float* W = (w < 128) ? Wg : Wu; const int ns = tile * 128 + (w & 127);
    tr_item8(W + (size_t)(64 * kb) * DFF + ns, DFF, WT + (size_t)n0 * D + 64 * kb, D, scr, lane, scale);
}
constexpr int IT_WIN = (D / 64) * (NP / 32), IT_SQ = (D / 64) * (D / 32), IT_GU = (D / 64) * (NGU / 32), IT_DN = (DFF / 64) * (D / 32);
constexpr int CV_A = 0, CV_B = CV_A + IT_WIN, CV_C = CV_B + 3 * IT_SQ, CV_D = CV_C + IT_GU + IT_DN, CV_E = CV_D + IT_WIN, CV_F = CV_E + 3 * IT_SQ, CV_END = CV_F + NE * (IT_GU + IT_DN);
constexpr int CVQ_MIX = 220;
constexpr int CV_MIX0 = CV_B, CV_MIX0_N = 192 * CVQ_MIX;
static_assert(CV_MIX0 + CV_MIX0_N >= CV_C && CV_MIX0 + CV_MIX0_N <= CV_F, "MIX(l0) covers B");
constexpr int CVQ_MIX1 = 300;
constexpr int CV_MIX1 = CV_F, CV_MIX1_N = 192 * CVQ_MIX1;
constexpr int CVX_MIX0 = 80;
constexpr int CV_MIX0X = CV_MIX1 + CV_MIX1_N, CV_MIX0X_N = 192 * CVX_MIX0;
constexpr int CVQ_G2 = 0;
constexpr int CV_G2 = CV_MIX0X + CV_MIX0X_N, CV_G2_N = 240 * CVQ_G2;
constexpr int CV_P0X = CV_MIX0 + CV_MIX0_N, CV_P0F = CV_G2 + CV_G2_N;
static_assert(CV_P0F <= CV_END, "conversion plan");

#define INPX(i) ((const float*)(const GAS float*)in[i])
__device__ __noinline__ void tr_dispatch_nl(in_table_t in, GAS unsigned char* wsg, int lane, int it, LAS float* scr) {
    unsigned char* ws = (unsigned char*)wsg; int r = it;
    if (r < CV_B) { tr_win(INPX(I_WIN), (bf16*)(ws + WS_WIN), scr, r, lane); return; }
    if (r < CV_C) { r -= CV_B; const int which = r / IT_SQ; const float* srcw = which == 0 ? INPX(I_WBRG) : (which == 1 ? INPX(I_WBRA) : INPX(I_WOUT)); const size_t wso = which == 0 ? WS_WBG : (which == 1 ? WS_WBA : WS_WO);
        tr_plain(srcw, D, D, (bf16*)(ws + wso), scr, r % IT_SQ, lane); return; }
#if DENSE_FP8 == 1
    if (r < CV_D) { r -= CV_C; if (r < IT_GU) tr_gu8(INPX(I_WFG), INPX(I_WFU), ws + WS_FGU, scr, r, lane, W8_SCALE); else tr_plain8(INPX(I_WFD), DFF, D, ws + WS_FDN, scr, r - IT_GU, lane, W8_SCALE); return; }
#elif DENSE_FP8 == 2
    if (r < CV_D) { r -= CV_C; if (r < IT_GU) tr_gu8(INPX(I_WFG), INPX(I_WFU), ws + WS_FGU, scr, r, lane, W8_SCALE); else tr_plain(INPX(I_WFD), DFF, D, (bf16*)(ws + WS_FDN), scr, r - IT_GU, lane); return; }
#else
    if (r < CV_D) { r -= CV_C; if (r < IT_GU) tr_gu(INPX(I_WFG), INPX(I_WFU), (bf16*)(ws + WS_FGU), scr, r, lane); else tr_plain(INPX(I_WFD), DFF, D, (bf16*)(ws + WS_FDN), scr, r - IT_GU, lane); return; }
#endif
    if (r < CV_E) { tr_win(INPX(I_WIN) + (size_t)D * DIN, (bf16*)(ws + WS_WIN + SZ_WIN), scr, r - CV_D, lane); return; }
    if (r < CV_F) { r -= CV_E; const int which = r / IT_SQ; const float* srcw = (which == 0 ? INPX(I_WBRG) : (which == 1 ? INPX(I_WBRA) : INPX(I_WOUT))) + (size_t)D * D; const size_t wso = (which == 0 ? WS_WBG : (which == 1 ? WS_WBA : WS_WO)) + SZ_WSQ;
        tr_plain(srcw, D, D, (bf16*)(ws + wso), scr, r % IT_SQ, lane); return; }
    { r -= CV_F; const int per = IT_GU + IT_DN, e = r / per, q = r % per;
#if MOE_FP8
        if (q < IT_GU) tr_gu8(INPX(I_WEG) + (size_t)e * D * DFF, INPX(I_WEU) + (size_t)e * D * DFF, ws + WS_EGU + e * (SZ_GU / 2), scr, q, lane, W8_SCALE);
        else tr_plain8(INPX(I_WED) + (size_t)e * DFF * D, DFF, D, ws + WS_EDN + e * (SZ_DN / 2), scr, q - IT_GU, lane, W8_SCALE); }
#else
        if (q < IT_GU) tr_gu(INPX(I_WEG) + (size_t)e * D * DFF, INPX(I_WEU) + (size_t)e * D * DFF, (bf16*)(ws + WS_EGU + e * SZ_GU), scr, q, lane);
        else tr_plain(INPX(I_WED) + (size_t)e * DFF * D, DFF, D, (bf16*)(ws + WS_EDN + e * SZ_DN), scr, q - IT_GU, lane); }
#endif
}
#undef INPX
__device__ __forceinline__ void tr_dispatch(Frame& F, int it, LAS float* scr) { tr_dispatch_nl(F.in, (GAS unsigned char*)F.ws, F.lane, it, scr); }
__device__ __forceinline__ void convert_range(Frame& F, int first, int n) {
    LAS float* scr = (LAS float*)(F.lds + F.wave * 16384);
    for (int i = F.wave; i < n; i += 8) tr_dispatch(F, first + i, scr);
}
__device__ __forceinline__ void p0_weights(Frame& F) {
    LAS float* scr = (LAS float*)(F.lds + F.wave * 16384);
    const int gw = F.vcu * 8 + F.wave, NGW = F.G * 8;
    if (F.G != 256) { for (int i = gw; i < CV_END; i += NGW) tr_dispatch(F, i, scr); return; }
    const int n1 = CV_B - CV_A, n2 = CV_F - CV_P0X, n3 = CV_END - CV_P0F;
    for (int i = gw; i < n1 + n2 + n3; i += NGW) tr_dispatch(F, i < n1 ? i : (i < n1 + n2 ? CV_P0X + (i - n1) : CV_P0F + (i - n1 - n2)), scr);
}
__device__ __forceinline__ void p0_mod(Frame& F) {
    LAS float* sc = (LAS float*)F.lds;
    LAS float* red = (LAS float*)(F.lds + 3 * D * 4);
    __syncthreads();
    for (int i = F.tid; i < 3 * D; i += 512) { const int r = i / D, k = i % D; const float v = r < 2 ? INP(I_C)[r * D + k] : INP(I_CCTX)[k]; sc[i] = siluf_(v); }
    __syncthreads();
    float* MOD = (float*)(F.ws + WS_MOD);
    const int col = F.lane & 31, kp = F.lane >> 5;
    for (int it = F.vcu; it < 2 * (6 * D / 32); it += F.G) {
        const int l = it / (6 * D / 32), n0 = (it % (6 * D / 32)) * 32;
        const float* W = INP(I_WMOD) + (size_t)l * D * 6 * D + n0 + col;
        float a0 = 0.f, a1 = 0.f, a2 = 0.f;
        const int kbase = F.wave * 256 + kp;
#pragma unroll 8
        for (int j = 0; j < 128; ++j) { const int k = kbase + 2 * j; const float w = W[(size_t)k * 6 * D]; a0 += sc[k] * w; a1 += sc[D + k] * w; a2 += sc[2 * D + k] * w; }
        const int slot = F.wave * 2 + kp;
        red[(slot * 3 + 0) * 32 + col] = a0; red[(slot * 3 + 1) * 32 + col] = a1; red[(slot * 3 + 2) * 32 + col] = a2;
        __syncthreads();
        if (F.tid < 96) { const int r = F.tid / 32, cc = F.tid % 32; float s = 0.f;
#pragma unroll
            for (int q = 0; q < 16; ++q) s += red[(q * 3 + r) * 32 + cc];
            MOD[((size_t)l * 3 + r) * 6 * D + n0 + cc] = s + INP(I_BMOD)[(size_t)l * 6 * D + n0 + cc]; }
        __syncthreads();
    }
}

struct Row { f32x4 v[8]; };
__device__ __forceinline__ void row_load(Row& r, const float* p, int lane) {
#pragma unroll
    for (int j = 0; j < 8; ++j) r.v[j] = *(const f32x4*)(p + 4 * lane + 256 * j);
}
__device__ __forceinline__ void row_load_bf16(Row& r, const bf16* p, int lane) {
#pragma unroll
    for (int j = 0; j < 8; ++j) { const u32x2 w = *(const u32x2*)(p + 4 * lane + 256 * j); r.v[j] = (f32x4){bflo(w.x), bfhi(w.x), bflo(w.y), bfhi(w.y)}; }
}
struct RowH { u32x2 v[8]; };
__device__ __forceinline__ void rowh_load(RowH& r, const bf16* p, int lane) {
#pragma unroll
    for (int j = 0; j < 8; ++j) r.v[j] = *(const u32x2*)(p + 4 * lane + 256 * j);
}
__device__ __forceinline__ void rowh_cvt(Row& o, const RowH& r) {
#pragma unroll
    for (int j = 0; j < 8; ++j) o.v[j] = (f32x4){bflo(r.v[j].x), bfhi(r.v[j].x), bflo(r.v[j].y), bfhi(r.v[j].y)};
}
__device__ __forceinline__ void row_touch(Row& r) { asm volatile("" : "+v"(r.v[0]), "+v"(r.v[1]), "+v"(r.v[2]), "+v"(r.v[3]), "+v"(r.v[4]), "+v"(r.v[5]), "+v"(r.v[6]), "+v"(r.v[7])); }
__device__ __forceinline__ void rowh_touch(RowH& r) { asm volatile("" : "+v"(r.v[0]), "+v"(r.v[1]), "+v"(r.v[2]), "+v"(r.v[3]), "+v"(r.v[4]), "+v"(r.v[5]), "+v"(r.v[6]), "+v"(r.v[7])); }
template <int S> __device__ __forceinline__ void row_sum_slices(Row& o, const float* p, size_t stride, int lane) {
    row_load(o, p, lane);
#pragma unroll
    for (int s0 = 1; s0 < S; s0 += 2) { Row t[2];
#pragma unroll
        for (int q = 0; q < 2; ++q) if (s0 + q < S) row_load(t[q], p + (size_t)(s0 + q) * stride, lane);
#pragma unroll
        for (int q = 0; q < 2; ++q) if (s0 + q < S) {
#pragma unroll
            for (int j = 0; j < 8; ++j) o.v[j] = o.v[j] + t[q].v[j]; } }
}
__device__ __forceinline__ float row_ss(const Row& r) {
    float s = 0.f;
#pragma unroll
    for (int j = 0; j < 8; ++j) s += (r.v[j][0] * r.v[j][0] + r.v[j][1] * r.v[j][1]) + (r.v[j][2] * r.v[j][2] + r.v[j][3] * r.v[j][3]);
    return wave_sum(s);
}
__device__ __forceinline__ int mod_row(int r) { return r < ML ? r / SEQ : 2; }
__device__ __forceinline__ void prenorm_store(const Row& x, Row& h, const float* g, const float* sc, const float* sh, bf16* hx, int lane, bool store = true) {
    const float rs = 1.0f / sqrtf(row_ss(x) * (1.0f / D) + RMS_EPS);
#pragma unroll
    for (int j = 0; j < 8; ++j) { const int o = 4 * lane + 256 * j; const f32x4 gg = *(const f32x4*)(g + o), s1 = *(const f32x4*)(sc + o), s0 = *(const f32x4*)(sh + o);
        h.v[j] = x.v[j] * rs * gg * (s1 + 1.0f) + s0;
        if (store) { u32x2 w; w.x = cvt_pk_bf16(h.v[j][0], h.v[j][1]); w.y = cvt_pk_bf16(h.v[j][2], h.v[j][3]); *(u32x2*)(hx + o) = w; } }
}
__device__ __forceinline__ const float* x_in_row(Frame& F, int r) { return r < ML ? INP(I_X) + (size_t)r * D : INP(I_CTX) + (size_t)(r - ML) * D; }

#define LV(i) ((const LAS float*)(F.lds) + (size_t)(i) * D)
__device__ __forceinline__ void stage_vec(Frame& F, int slot, const float* src) {
    LAS float* dst = (LAS float*)(F.lds) + (size_t)slot * D;
    *(LAS f32x4*)(dst + 4 * F.tid) = *(const f32x4*)(src + 4 * F.tid);
}
__device__ __forceinline__ void prenorm_store_l(const Row& x, Row& h, const LAS float* g, const LAS float* sc, const LAS float* sh, bf16* hx, int lane, bool store = true) {
    const float rs = 1.0f / sqrtf(row_ss(x) * (1.0f / D) + RMS_EPS);
#pragma unroll
    for (int j = 0; j < 8; ++j) { const int o = 4 * lane + 256 * j; const f32x4 gg = *(const LAS f32x4*)(g + o), s1 = *(const LAS f32x4*)(sc + o), s0 = *(const LAS f32x4*)(sh + o);
        h.v[j] = x.v[j] * rs * gg * (s1 + 1.0f) + s0;
        if (store) { u32x2 w; w.x = cvt_pk_bf16(h.v[j][0], h.v[j][1]); w.y = cvt_pk_bf16(h.v[j][2], h.v[j][3]); *(u32x2*)(hx + o) = w; } }
}
__device__ __forceinline__ void t1_phase(Frame& F) {
    const int gw = F.vcu * 8 + F.wave, NGW = F.G * 8;
    const float* MOD = (const float*)(F.ws + WS_MOD); bf16* HX = (bf16*)(F.ws + WS_HX);
    __syncthreads(); stage_vec(F, 0, INP(I_GPREMIX));
#pragma unroll
    for (int m = 0; m < 3; ++m) { stage_vec(F, 1 + 2 * m, MOD + (size_t)m * 6 * D + D); stage_vec(F, 2 + 2 * m, MOD + (size_t)m * 6 * D); }
    __syncthreads();
    Row xn; if (gw < MT) row_load(xn, x_in_row(F, gw), F.lane);
    for (int r = gw; r < MT; r += NGW) { Row x, h; row_touch(xn); x = xn; if (r + NGW < MT) row_load(xn, x_in_row(F, r + NGW), F.lane);
        const int m = mod_row(r);
        prenorm_store_l(x, h, LV(0), LV(1 + 2 * m), LV(2 + 2 * m), HX + (size_t)r * D, F.lane); }
}
__device__ __forceinline__ void t3_phase(Frame& F, int l) {
    const int gw = F.vcu * 8 + F.wave, NGW = F.G * 8, rows = (l == 0) ? MT : ML;
    const float* MODL = (const float*)(F.ws + WS_MOD) + (size_t)l * 3 * 6 * D; bf16* HX = (bf16*)(F.ws + WS_HX); float* XS = (float*)(F.ws + WS_XS); const bf16* Y = (const bf16*)(F.ws + WS_Y);
    const float* gpost = INP(I_GPOSTMIX) + l * D; const float* gpre = INP(I_GPREFFN) + l * D;
    volatile LAS unsigned* lcnt = (volatile LAS unsigned*)(F.lds + MISC_OFF + 64); volatile LAS unsigned* lbase = lcnt + 8; LAS int* rinfo = (LAS int*)(F.lds + 131072 + F.wave * 1024);
    __syncthreads();
    stage_vec(F, 0, gpost); stage_vec(F, 1, gpre);
#pragma unroll
    for (int m = 0; m < 3; ++m) if (l == 0 || m < 2) { stage_vec(F, 2 + 3 * m, MODL + (size_t)m * 6 * D + 2 * D); stage_vec(F, 3 + 3 * m, MODL + (size_t)m * 6 * D + 4 * D); stage_vec(F, 4 + 3 * m, MODL + (size_t)m * 6 * D + 3 * D); }
    if (l == 1) { if (F.tid < 16) lcnt[F.tid] = 0u;
        const float* wr = INP(I_WROUTER); LAS float* wt = (LAS float*)(F.lds) + (size_t)8 * D;
#pragma unroll
        for (int q = 0; q < 8; ++q) { const int i4 = (F.tid + 512 * q) * 4; const f32x4 v = *(const f32x4*)(wr + i4); const int d = i4 >> 3, e0 = i4 & 7;
            wt[(e0 + 0) * D + d] = v[0]; wt[(e0 + 1) * D + d] = v[1]; wt[(e0 + 2) * D + d] = v[2]; wt[(e0 + 3) * D + d] = v[3]; } }
    __syncthreads();
    int krow = 0;
    Row xn; RowH yn;
    if (gw < rows) { row_load(xn, l == 0 ? x_in_row(F, gw) : XS + (size_t)gw * D, F.lane); rowh_load(yn, Y + (size_t)gw * D, F.lane); }
    for (int r = gw; r < rows; r += NGW, ++krow) {
        Row x, y, h; RowH yh;
        row_touch(xn); rowh_touch(yn); x = xn; yh = yn;
        if (r + NGW < rows) { const int rn = r + NGW; row_load(xn, l == 0 ? x_in_row(F, rn) : XS + (size_t)rn * D, F.lane); rowh_load(yn, Y + (size_t)rn * D, F.lane); }
        if (CTX_SPLIT && l == 0 && r >= ML) row_sum_slices<YP_S3>(y, (const float*)(F.ws + WS_YP) + (size_t)(r - ML) * D, (size_t)MC * D, F.lane);
        else rowh_cvt(y, yh);
        const int m = mod_row(r);
        const float rs = 1.0f / sqrtf(row_ss(y) * (1.0f / D) + RMS_EPS);
#pragma unroll
        for (int j = 0; j < 8; ++j) { const int o = 4 * F.lane + 256 * j; const f32x4 gg = *(const LAS f32x4*)(LV(0) + o), gt = *(const LAS f32x4*)(LV(2 + 3 * m) + o);
            x.v[j] = x.v[j] + gt * (y.v[j] * rs * gg); *(f32x4*)(XS + (size_t)r * D + o) = x.v[j]; }
        prenorm_store_l(x, h, LV(1), LV(3 + 3 * m), LV(4 + 3 * m), HX + (size_t)r * D, F.lane, !(MOE_FP8 && l == 1) && !(DENSE_FP8 && l == 0));
#if MOE_FP8
        if (l == 1 || DENSE_FP8) {
            unsigned char* h8 = F.ws + WS_HX8 + (size_t)r * D;
#pragma unroll
            for (int j = 0; j < 8; ++j) *(unsigned*)(h8 + 4 * F.lane + 256 * j) = pk4_fp8(h.v[j][0] * X8_SCALE, h.v[j][1] * X8_SCALE, h.v[j][2] * X8_SCALE, h.v[j][3] * X8_SCALE);
        }
#endif
        if (l == 1) {
            float lg[NE];
#pragma unroll
            for (int e = 0; e < NE; ++e) { float a_ = 0.f;
#pragma unroll
                for (int j = 0; j < 8; ++j) { const f32x4 w4 = *(const LAS f32x4*)(LV(8 + e) + 4 * F.lane + 256 * j); a_ += (h.v[j][0] * w4[0] + h.v[j][1] * w4[1]) + (h.v[j][2] * w4[2] + h.v[j][3] * w4[3]); }
                lg[e] = a_; }
#pragma unroll
            for (int e = 0; e < NE; ++e) lg[e] = wave_sum(lg[e]) + INP(I_BROUTER)[e];
            int e1 = 0; float v1 = lg[0];
#pragma unroll
            for (int e = 1; e < NE; ++e) if (lg[e] > v1) { v1 = lg[e]; e1 = e; }
            int e2 = -1; float v2 = -INFINITY;
#pragma unroll
            for (int e = 0; e < NE; ++e) if (e != e1 && lg[e] > v2) { v2 = lg[e]; e2 = e; }
            if (F.lane == 0) {
                const float w1 = 1.0f / (1.0f + __expf(v2 - v1)), w2 = 1.0f - w1;
                int* ti = (int*)(F.ws + WS_TINFO) + (size_t)r * 8;
                const int s1 = (int)__hip_atomic_fetch_add((LAS unsigned*)lcnt + e1, 1u, __ATOMIC_RELAXED, __HIP_MEMORY_SCOPE_WORKGROUP), s2 = (int)__hip_atomic_fetch_add((LAS unsigned*)lcnt + e2, 1u, __ATOMIC_RELAXED, __HIP_MEMORY_SCOPE_WORKGROUP);
                if (krow < 64) { rinfo[krow * 4 + 0] = e1; rinfo[krow * 4 + 1] = s1; rinfo[krow * 4 + 2] = e2; rinfo[krow * 4 + 3] = s2; }
                ti[0] = e1; ti[2] = e2; ti[4] = (int)__float_as_uint(w1); ti[5] = (int)__float_as_uint(w2);
            }
        }
    }
    if (l == 1) {
        __syncthreads();
        if (F.tid < NE) lbase[F.tid] = atomicAdd(F.ctl + CW_CNT + F.tid, lcnt[F.tid]);
        __syncthreads();
        if (F.lane == 0) { int* list = (int*)(F.ws + WS_LIST); int k = 0;
            for (int r = gw; r < rows; r += NGW, ++k) { if (k >= 64) break;
                const int e1 = rinfo[k * 4 + 0], s1 = (int)lbase[e1] + rinfo[k * 4 + 1], e2 = rinfo[k * 4 + 2], s2 = (int)lbase[e2] + rinfo[k * 4 + 3];
                int* ti = (int*)(F.ws + WS_TINFO) + (size_t)r * 8;
                list[e1 * MOE_CAP + s1] = r; list[e2 * MOE_CAP + s2] = r; ti[1] = s1; ti[3] = s2; } }
    }
}
__device__ __forceinline__ void t5_phase(Frame& F, int l) {
    const int gw = F.vcu * 8 + F.wave, NGW = F.G * 8, rows = (l == 0) ? MT : ML;
    const float* MODL = (const float*)(F.ws + WS_MOD) + (size_t)l * 3 * 6 * D; bf16* HX = (bf16*)(F.ws + WS_HX); float* XS = (float*)(F.ws + WS_XS);
    const float* gpost = INP(I_GPOSTFFN) + l * D;
    float chk_scale = 1.0f;
#if MIXCHECK
    { const float* acc = (const float*)(F.ctl + CW_CHK); const float tol = MIXCHECK_TOL; bool badg = false, bada = false;
      for (int q = 0; q < 2; ++q) { if (!(acc[4 * q + 0] <= tol * acc[4 * q + 1])) badg = true; if (!(acc[4 * q + 2] <= tol * acc[4 * q + 3])) bada = true; }
      chk_scale = 1.0f + (badg ? 2.0f : 0.f) + (bada ? 1.0f : 0.f); }
#endif
    int pb[NE + 1]; pb[0] = 0;
    if (l == 1) {
#pragma unroll
        for (int e = 0; e < NE; ++e) { int v = __builtin_amdgcn_readfirstlane((int)F.ctl[CW_CNT + e]); v = v > MOE_CAP ? MOE_CAP : v; pb[e + 1] = pb[e] + ((v + 255) >> 8); }
    }
    __syncthreads();
    stage_vec(F, 0, gpost);
#pragma unroll
    for (int m = 0; m < 3; ++m) { stage_vec(F, 1 + m, MODL + (size_t)m * 6 * D + 5 * D);
        if (l == 0) { stage_vec(F, 5 + 2 * m, MODL + (size_t)(3 + m) * 6 * D + D); stage_vec(F, 6 + 2 * m, MODL + (size_t)(3 + m) * 6 * D); } }
    if (l == 0) stage_vec(F, 4, INP(I_GPREMIX) + D);
    __syncthreads();
    Row xn; RowH fa_n, fb_n; int tin[6] = {0, 0, 0, 0, 0, 0}, tin2[6] = {0, 0, 0, 0, 0, 0};
    const bf16* YMb = (const bf16*)(F.ws + WS_LAF); const int* TI = (const int*)(F.ws + WS_TINFO);
#define T5_YM_ADDR(ti, which) (YMb + (size_t)(({ int p_ = 0; _Pragma("unroll") for (int e = 0; e < NE; ++e) if (e == (ti)[2 * (which)]) p_ = pb[e]; p_; }) * 256 + (ti)[2 * (which) + 1]) * D)
    if (gw < rows) { row_load(xn, XS + (size_t)gw * D, F.lane);
        if (l == 0) rowh_load(fa_n, (const bf16*)(F.ws + WS_Y) + (size_t)gw * D, F.lane);
        else {
#pragma unroll
            for (int q = 0; q < 6; ++q) tin[q] = TI[(size_t)gw * 8 + q];
            if (gw + NGW < rows) {
#pragma unroll
                for (int q = 0; q < 6; ++q) tin2[q] = TI[(size_t)(gw + NGW) * 8 + q]; }
            rowh_load(fa_n, T5_YM_ADDR(tin, 0), F.lane); rowh_load(fb_n, T5_YM_ADDR(tin, 1), F.lane); } }
    for (int r = gw; r < rows; r += NGW) {
        Row x, f, h; RowH fa, fb; int tic[6];
        row_touch(xn); rowh_touch(fa_n); if (l == 1) { rowh_touch(fb_n); asm volatile("" : "+v"(tin2[0]), "+v"(tin2[1]), "+v"(tin2[2]), "+v"(tin2[3]), "+v"(tin2[4]), "+v"(tin2[5])); }
        x = xn; fa = fa_n; fb = fb_n;
#pragma unroll
        for (int q = 0; q < 6; ++q) tic[q] = tin[q];
        if (r + NGW < rows) { const int rn = r + NGW;
            if (l == 1) {
#pragma unroll
                for (int q = 0; q < 6; ++q) tin[q] = tin2[q];
                if (rn + NGW < rows) {
#pragma unroll
                    for (int q = 0; q < 6; ++q) tin2[q] = TI[(size_t)(rn + NGW) * 8 + q]; } }
            row_load(xn, XS + (size_t)rn * D, F.lane);
            if (l == 0) rowh_load(fa_n, (const bf16*)(F.ws + WS_Y) + (size_t)rn * D, F.lane);
            else { rowh_load(fa_n, T5_YM_ADDR(tin, 0), F.lane); rowh_load(fb_n, T5_YM_ADDR(tin, 1), F.lane); } }
        if (CTX_SPLIT && DENSE_FP8 != 1 && l == 0 && r >= ML) row_sum_slices<YP_S5>(f, (const float*)(F.ws + WS_YP) + (size_t)(r - ML) * D, (size_t)MC * D, F.lane);
        else if (l == 0) rowh_cvt(f, fa);
        else { const float w1 = __uint_as_float((unsigned)tic[4]), w2 = __uint_as_float((unsigned)tic[5]); Row a, b; rowh_cvt(a, fa); rowh_cvt(b, fb);
#pragma unroll
            for (int j = 0; j < 8; ++j) f.v[j] = a.v[j] * w1 + b.v[j] * w2; }
        const int m = mod_row(r);
        const float rs = 1.0f / sqrtf(row_ss(f) * (1.0f / D) + RMS_EPS);
#pragma unroll
        for (int j = 0; j < 8; ++j) { const int o = 4 * F.lane + 256 * j; const f32x4 gg = *(const LAS f32x4*)(LV(0) + o), gt = *(const LAS f32x4*)(LV(1 + m) + o);
            x.v[j] = x.v[j] + gt * (f.v[j] * rs * gg);
            if (l == 0) *(f32x4*)(XS + (size_t)r * D + o) = x.v[j]; else *(f32x4*)(F.out + (size_t)r * D + o) = x.v[j] * chk_scale; }
        if (l == 0) prenorm_store_l(x, h, LV(4), LV(5 + 2 * m), LV(6 + 2 * m), HX + (size_t)r * D, F.lane);
    }
#undef T5_YM_ADDR
}

__device__ __forceinline__ void prep_phase(Frame& F, int l) {
    const bf16* P = (const bf16*)(F.ws + WS_P);
    const size_t gt = (size_t)F.vcu * 512 + F.tid, NT = (size_t)F.G * 512;
    {
        float* LAF = (float*)(F.ws + WS_LAF); float* LAB = (float*)(F.ws + WS_LAB);
        const float* wf = INP(I_WLRF) + (size_t)l * 16 * 1024; const float* wb = INP(I_WLRB) + (size_t)l * 16 * 1024; const float* bfv = INP(I_BLRF) + l * 1024; const float* bbv = INP(I_BLRB) + l * 1024;
        for (size_t idx = gt; idx < (size_t)MT * 1024; idx += NT) { const int r = (int)(idx >> 10), d = (int)(idx & 1023);
            const u32x4* lr = (const u32x4*)((const bf16*)(F.ws + WS_LRB + (size_t)l * SZ_LRB) + (size_t)r * 256); const u32x4 a0 = lr[0], a1 = lr[1], b0 = lr[2], b1 = lr[3];
            const unsigned fa[8] = {a0.x, a0.y, a0.z, a0.w, a1.x, a1.y, a1.z, a1.w}, fb[8] = {b0.x, b0.y, b0.z, b0.w, b1.x, b1.y, b1.z, b1.w};
            float zf = bfv[d], zb = bbv[d];
#pragma unroll
            for (int j = 0; j < 8; ++j) { zf += bflo(fa[j]) * wf[(2 * j) * 1024 + d] + bfhi(fa[j]) * wf[(2 * j + 1) * 1024 + d]; zb += bflo(fb[j]) * wb[(2 * j) * 1024 + d] + bfhi(fb[j]) * wb[(2 * j + 1) * 1024 + d]; }
            LAF[idx] = logsigf_(zf) * (1.0f / 16.0f); LAB[idx] = logsigf_(zb) * (1.0f / 16.0f); }
    }
    {
        bf16* QR = (bf16*)(F.ws + WS_QR); bf16* KR = (bf16*)(F.ws + WS_KR);
        for (size_t idx = gt; idx < (size_t)MT * 1152; idx += NT) { const int r = (int)(idx / 1152), p = (int)(idx % 1152);
            const bool isq = p < 1024; const int hp = isq ? p : p - 1024, head = hp >> 5, pp = hp & 31, half = pp >> 4, i = pp & 15, d0 = half * 32 + i, d1 = d0 + 16;
            const bf16* src = P + (size_t)r * NP + (isq ? OAQ : OAK) + head * 64; float x0 = bf2f(src[d0]), x1 = bf2f(src[d1]);
            float o0 = x0, o1 = x1;
            if (r < ML) { const int t = r % SEQ; const float pos = (float)(half == 0 ? (t >> 6) : (t & 63)); const float inv = exp2f(-(float)i * (13.287712379549449f / 16.0f));
                float sn, cs; sincosf(pos * inv, &sn, &cs); o0 = x0 * cs - x1 * sn; o1 = x1 * cs + x0 * sn; }
            if (isq) { o0 *= 0.18033688011112042f; o1 *= 0.18033688011112042f; QR[(size_t)r * D + head * 64 + d0] = f2bf(o0); QR[(size_t)r * D + head * 64 + d1] = f2bf(o1); }
            else { KR[(size_t)r * 256 + head * 64 + d0] = f2bf(o0); KR[(size_t)r * 256 + head * 64 + d1] = f2bf(o1); } }
    }
}

__device__ __forceinline__ int gla_row(int b, int dir, int s) { if (s < CTXL) { const int p = dir ? CTXL - 1 - s : s; return ML + b * CTXL + p; } const int q = s - CTXL; const int p = dir ? SEQ - 1 - q : q; return b * SEQ + p; }
__device__ __forceinline__ void mix_simple_gla(Frame& F, int wg, size_t ws_of, size_t ws_ob) {
    const bf16* P = (const bf16*)(F.ws + WS_P);
    const int seq = wg >> 2, dvb = wg & 3, b = seq >> 3, h = (seq >> 1) & 3, dir = seq & 1;
    const float* LA = (const float*)(F.ws + (dir ? WS_LAB : WS_LAF)); float* O = (float*)(F.ws + (dir ? ws_ob : ws_of));
    LAS float* sa = (LAS float*)F.lds; LAS float* sq = sa + 32 * 256; LAS float* sk = sq + 32 * 256; LAS float* sv = sk + 32 * 256;
    const int qd = F.tid & 3, jl = F.tid >> 2;
    float S[64];
#pragma unroll
    for (int i = 0; i < 64; ++i) S[i] = 0.f;
    for (int c0 = 0; c0 < CTXL + SEQ; c0 += 32) {
        __syncthreads();
        for (int idx = F.tid; idx < 32 * 256; idx += 512) { const int st = idx >> 8, dk = idx & 255; const int row = gla_row(b, dir, c0 + st);
            sa[idx] = __expf(LA[(size_t)row * 1024 + h * 256 + dk]); sq[idx] = bf2f(P[(size_t)row * NP + OQ + h * 256 + dk]) * 0.0625f; sk[idx] = bf2f(P[(size_t)row * NP + OKK + h * 256 + dk]); }
        for (int idx = F.tid; idx < 32 * 128; idx += 512) { const int st = idx >> 7, j = idx & 127; const int row = gla_row(b, dir, c0 + st); sv[idx] = bf2f(P[(size_t)row * NP + OV + h * 512 + dvb * 128 + j]); }
        __syncthreads();
        for (int st = 0; st < 32; ++st) {
            const float v = sv[st * 128 + jl]; float o = 0.f;
            const LAS f32x4* pa = (const LAS f32x4*)(sa + st * 256 + qd * 64); const LAS f32x4* pq = (const LAS f32x4*)(sq + st * 256 + qd * 64); const LAS f32x4* pk = (const LAS f32x4*)(sk + st * 256 + qd * 64);
#pragma unroll
            for (int i4 = 0; i4 < 16; ++i4) { const f32x4 a = pa[i4], q = pq[i4], k = pk[i4];
#pragma unroll
                for (int e = 0; e < 4; ++e) { const float s = a[e] * S[i4 * 4 + e] + k[e] * v; S[i4 * 4 + e] = s; o += q[e] * s; } }
            o += __shfl_xor(o, 1); o += __shfl_xor(o, 2);
            if (qd == 0) ((bf16*)O)[(size_t)gla_row(b, dir, c0 + st) * D + h * 512 + dvb * 128 + jl] = f2bf(o);
        }
    }
}
__device__ __forceinline__ void mix_simple_attn(Frame& F, int l, int wg, int nwg, size_t ws_ax) {
    const bf16* P = (const bf16*)(F.ws + WS_P); const bf16* QR = (const bf16*)(F.ws + WS_QR); const bf16* KR = (const bf16*)(F.ws + WS_KR); bf16* AX = (bf16*)(F.ws + ws_ax);
    const int rows = (l == 0) ? MT : ML;
    for (size_t idx = (size_t)wg * 512 + F.tid; idx < (size_t)rows * AHQ; idx += (size_t)nwg * 512) {
        const int r = (int)(idx >> 5), hq = (int)(idx & 31), kvh = hq >> 3;
        float q[64], o[64];
        { const u32x4* qp = (const u32x4*)(QR + (size_t)r * D + hq * 64);
#pragma unroll
            for (int j = 0; j < 8; ++j) { const u32x4 w = qp[j]; q[8 * j] = bflo(w.x); q[8 * j + 1] = bfhi(w.x); q[8 * j + 2] = bflo(w.y); q[8 * j + 3] = bfhi(w.y); q[8 * j + 4] = bflo(w.z); q[8 * j + 5] = bfhi(w.z); q[8 * j + 6] = bflo(w.w); q[8 * j + 7] = bfhi(w.w); } }
#pragma unroll
        for (int d = 0; d < 64; ++d) o[d] = 0.f;
        float m = INP(I_SINK)[l * AHQ + hq] * 1.4426950408889634f, lsum = 1.0f;
        int b, k0 = 0, k1 = 0;
        if (r < ML) { b = r / SEQ; const int t = r % SEQ; k0 = t - AWIN < 0 ? 0 : t - AWIN; k1 = t + AWIN > SEQ - 1 ? SEQ - 1 : t + AWIN; k1 += 1; } else b = (r - ML) / CTXL;
        const int nloc = k1 - k0, ntot = nloc + CTXL;
        for (int kk = 0; kk < ntot; ++kk) {
            const int kr = kk < nloc ? b * SEQ + k0 + kk : ML + b * CTXL + (kk - nloc);
            const u32x4* kp = (const u32x4*)(KR + (size_t)kr * 256 + kvh * 64); float s = 0.f;
#pragma unroll
            for (int j = 0; j < 8; ++j) { const u32x4 w = kp[j]; s += q[8 * j] * bflo(w.x) + q[8 * j + 1] * bfhi(w.x) + q[8 * j + 2] * bflo(w.y) + q[8 * j + 3] * bfhi(w.y) + q[8 * j + 4] * bflo(w.z) + q[8 * j + 5] * bfhi(w.z) + q[8 * j + 6] * bflo(w.w) + q[8 * j + 7] * bfhi(w.w); }
            float p;
            if (s > m) { const float sc = __builtin_amdgcn_exp2f(m - s); lsum *= sc;
#pragma unroll
                for (int d = 0; d < 64; ++d) o[d] *= sc;
                m = s; p = 1.0f; } else p = __builtin_amdgcn_exp2f(s - m);
            lsum += p;
            const u32x4* vp = (const u32x4*)(P + (size_t)kr * NP + OAV + kvh * 64);
#pragma unroll
            for (int j = 0; j < 8; ++j) { const u32x4 w = vp[j]; o[8 * j] += p * bflo(w.x); o[8 * j + 1] += p * bfhi(w.x); o[8 * j + 2] += p * bflo(w.y); o[8 * j + 3] += p * bfhi(w.y); o[8 * j + 4] += p * bflo(w.z); o[8 * j + 5] += p * bfhi(w.z); o[8 * j + 6] += p * bflo(w.w); o[8 * j + 7] += p * bfhi(w.w); }
        }
        const float il = 1.0f / lsum; u32x4* op = (u32x4*)(AX + (size_t)r * D + hq * 64);
#pragma unroll
        for (int j = 0; j < 8; ++j) { u32x4 w; w.x = cvt_pk_bf16(o[8 * j] * il, o[8 * j + 1] * il); w.y = cvt_pk_bf16(o[8 * j + 2] * il, o[8 * j + 3] * il); w.z = cvt_pk_bf16(o[8 * j + 4] * il, o[8 * j + 5] * il); w.w = cvt_pk_bf16(o[8 * j + 6] * il, o[8 * j + 7] * il); op[j] = w; }
    }
}
__device__ __forceinline__ void ro_phase(Frame& F, int l) {
    const int gw = F.vcu * 8 + F.wave, NGW = F.G * 8, rows = (l == 0) ? MT : ML;
    const bf16* P = (const bf16*)(F.ws + WS_P); const bf16* OF = (const bf16*)(F.ws + WS_OF); const bf16* OB = (const bf16*)(F.ws + WS_OB); bf16* GX = (bf16*)(F.ws + WS_GX);
    const float* gg = INP(I_GGLA) + l * GDV;
    const f32x4 gla0 = *(const f32x4*)(gg + 4 * F.lane), gla1 = *(const f32x4*)(gg + 4 * F.lane + 256);
    RowH an, bn, gn;
    if (gw < rows) { rowh_load(an, OF + (size_t)gw * D, F.lane); rowh_load(bn, OB + (size_t)gw * D, F.lane); rowh_load(gn, P + (size_t)gw * NP + ORG, F.lane); }
    for (int r = gw; r < rows; r += NGW) {
        Row a, b; RowH ah, bh, gh; rowh_touch(an); rowh_touch(bn); rowh_touch(gn); ah = an; bh = bn; gh = gn;
        if (r + NGW < rows) { const int rn = r + NGW; rowh_load(an, OF + (size_t)rn * D, F.lane); rowh_load(bn, OB + (size_t)rn * D, F.lane); rowh_load(gn, P + (size_t)rn * NP + ORG, F.lane); }
        rowh_cvt(a, ah); rowh_cvt(b, bh);
#pragma unroll
        for (int j = 0; j < 8; ++j) a.v[j] = a.v[j] + b.v[j];
#pragma unroll
        for (int hh = 0; hh < 4; ++hh) {
            float s = 0.f;
#pragma unroll
            for (int j = 2 * hh; j < 2 * hh + 2; ++j) s += (a.v[j][0] * a.v[j][0] + a.v[j][1] * a.v[j][1]) + (a.v[j][2] * a.v[j][2] + a.v[j][3] * a.v[j][3]);
            const float rs = 1.0f / sqrtf(wave_sum(s) * (1.0f / GDV) + RMS_EPS);
#pragma unroll
            for (int j = 2 * hh; j < 2 * hh + 2; ++j) { const int o = 4 * F.lane + 256 * j; const f32x4 g4 = (j & 1) ? gla1 : gla0;
                const u32x2 rw = gh.v[j]; const float r0 = bflo(rw.x), r1 = bfhi(rw.x), r2 = bflo(rw.y), r3 = bfhi(rw.y);
                u32x2 w; w.x = cvt_pk_bf16(a.v[j][0] * rs * g4[0] * siluf_(r0), a.v[j][1] * rs * g4[1] * siluf_(r1)); w.y = cvt_pk_bf16(a.v[j][2] * rs * g4[2] * siluf_(r2), a.v[j][3] * rs * g4[3] * siluf_(r3));
                *(u32x2*)(GX + (size_t)r * D + o) = w; }
        }
    }
}

__device__ __forceinline__ int swzQ(int row, int bytecol) { return row * 512 + ((((bytecol >> 4) ^ (row & 15)) << 4) | (bytecol & 15)); }
__device__ __forceinline__ int swz64(int row, int bytecol) { return row * 128 + ((((bytecol >> 4) ^ ((row >> 1) & 7)) << 4) | (bytecol & 15)); }
__device__ __forceinline__ void glds16(const void* gsrc, LAS unsigned char* dst_uniform) { __builtin_amdgcn_global_load_lds((const unsigned*)gsrc, (LAS unsigned*)dst_uniform, 16, 0, 0); }
typedef short s16x4 __attribute__((ext_vector_type(4)));
__device__ __forceinline__ bf16x8 cat8(s16x4 a, s16x4 b) { return (bf16x8){a[0], a[1], a[2], a[3], b[0], b[1], b[2], b[3]}; }
typedef __bf16 bf16x2_t __attribute__((ext_vector_type(2)));
__device__ __forceinline__ unsigned cvt_pk_bf16_b(float lo, float hi) { const f32x2 v = {lo, hi}; const bf16x2_t b = __builtin_convertvector(v, bf16x2_t); return __builtin_bit_cast(unsigned, b); }
__device__ __forceinline__ bf16x8 pack8b(const f32x4& a, const f32x4& b) { u32x4 w; w.x = cvt_pk_bf16_b(a[0], a[1]); w.y = cvt_pk_bf16_b(a[2], a[3]); w.z = cvt_pk_bf16_b(b[0], b[1]); w.w = cvt_pk_bf16_b(b[2], b[3]); return __builtin_bit_cast(bf16x8, w); }
__device__ __forceinline__ bf16x8 pack8(const f32x4& a, const f32x4& b) { u32x4 w; w.x = cvt_pk_bf16(a[0], a[1]); w.y = cvt_pk_bf16(a[2], a[3]); w.z = cvt_pk_bf16(b[0], b[1]); w.w = cvt_pk_bf16(b[2], b[3]);
    return __builtin_bit_cast(bf16x8, w); }
__device__ __forceinline__ int gla_item_row0(int it) { const int c = it % 68, bh = it / 68, b = bh >> 2; return c < 4 ? ML + b * CTXL + 64 * c : b * SEQ + 64 * (c - 4); }

typedef unsigned u32x8 __attribute__((ext_vector_type(8)));
#define CAS __attribute__((address_space(4)))
__device__ __forceinline__ void gla_prep_item(Frame& F, int l, int it) {
    const bf16* P = (const bf16*)(F.ws + WS_P);
    const int bh = it / 68, h = bh & 3, r0 = gla_item_row0(it);
    LAS unsigned char* Qs = F.lds; LAS unsigned char* Ks = F.lds + 65536;
    const int tid = F.tid, d = tid & 255, dir = __builtin_amdgcn_readfirstlane(tid >> 8);
    __syncthreads();
#pragma unroll
    for (int m = 0; m < 4; ++m) { const int ci = tid + 512 * m, row = ci >> 5, c = ci & 31, off = row * 512 + ((c ^ (row & 15)) << 4);
        const u32x4 qv = *(const u32x4*)(P + (size_t)(r0 + row) * NP + OQ + h * 256 + 8 * c), kv = *(const u32x4*)(P + (size_t)(r0 + row) * NP + OKK + h * 256 + 8 * c);
        *(LAS u32x4*)(Qs + off) = qv; *(LAS u32x4*)(Qs + 32768 + off) = qv; *(LAS u32x4*)(Ks + off) = kv; *(LAS u32x4*)(Ks + 32768 + off) = kv; }
    const float* wl = (dir ? INP(I_WLRB) : INP(I_WLRF)) + (size_t)l * 16 * 1024 + h * 256 + d;
    float w[16];
#pragma unroll
    for (int j = 0; j < 16; ++j) w[j] = wl[j * 1024];
    const float bias = (dir ? INP(I_BLRB) : INP(I_BLRF))[l * 1024 + h * 256 + d];
    bf16* QIN = (bf16*)(F.ws + WS_QIN + dir * SZ_QIN);
    const CAS unsigned* lrp = (const CAS unsigned*)(const GAS unsigned*)((const bf16*)(F.ws + WS_LRB + (size_t)l * SZ_LRB) + (size_t)r0 * 256 + dir * 16);
    const int qoff = dir * 32768 + ((d * 2) & 15), cblk = d >> 3;
    __syncthreads();
    float bsum = 0.f;
#define LR_LOAD(dst, s0_) _Pragma("unroll") for (int u = 0; u < 4; ++u) { const int i_ = dir ? 63 - ((s0_) + u) : (s0_) + u; dst[u] = *(const CAS u32x8*)(lrq + (size_t)i_ * 128); }
    const CAS unsigned* lrq = lrp;
    u32x8 cur[4]; LR_LOAD(cur, 0)
#pragma unroll 2
    for (int s0 = 0; s0 < 64; s0 += 4) {
        u32x8 nxt[4];
        asm volatile("" : "+s"(cur[0]), "+s"(cur[1]), "+s"(cur[2]), "+s"(cur[3]), "+s"(lrq));
        { const int sn = (s0 + 4) & 63; LR_LOAD(nxt, sn) }
        float e[4], ie[4]; int off[4];
#pragma unroll
        for (int u = 0; u < 4; ++u) {
            const int i = dir ? 63 - (s0 + u) : s0 + u;
            const u32x8 lv = cur[u];
            float z0 = bias, z1 = 0.f;
#pragma unroll
            for (int j = 0; j < 8; ++j) { z0 += bflo(lv[j]) * w[2 * j]; z1 += bfhi(lv[j]) * w[2 * j + 1]; }
            const float z = z0 + z1;
            bsum += fminf(z, 0.f) * (1.4426950408889634f / 16.0f) - __builtin_amdgcn_logf(1.0f + __builtin_amdgcn_exp2f(-1.4426950408889634f * fabsf(z))) * (1.0f / 16.0f);
            e[u] = __builtin_amdgcn_exp2f(bsum - 4.0f); ie[u] = __builtin_amdgcn_exp2f(-bsum);
            off[u] = qoff + i * 512 + ((cblk ^ (i & 15)) << 4);
        }
        unsigned short qr[4], kr[4];
#pragma unroll
        for (int u = 0; u < 4; ++u) { qr[u] = *(const LAS unsigned short*)(Qs + off[u]); kr[u] = *(const LAS unsigned short*)(Ks + off[u]); }
#pragma unroll
        for (int u = 0; u < 4; ++u) { const int i = dir ? 63 - (s0 + u) : s0 + u;
            const bf16 qb = f2bf(__builtin_bit_cast(float, (unsigned)qr[u] << 16) * e[u]); const bf16 kb = f2bf(__builtin_bit_cast(float, (unsigned)kr[u] << 16) * ie[u]);
            *(LAS bf16*)(Qs + off[u]) = qb; *(LAS bf16*)(Ks + off[u]) = kb;
            QIN[(size_t)(r0 + i) * 1024 + h * 256 + d] = qb; }
#pragma unroll
        for (int u = 0; u < 4; ++u) cur[u] = nxt[u];
    }
#undef LR_LOAD
    {
        const float eb = __builtin_amdgcn_exp2f(bsum);
        ((float*)(F.ws + WS_DEC + dir * SZ_DEC))[(size_t)it * 256 + d] = eb;
        u32x4* kt = (u32x4*)((bf16*)(F.ws + WS_KTO + dir * SZ_KTO) + ((size_t)it * 256 + d) * 64);
#pragma unroll
        for (int t8 = 0; t8 < 8; ++t8) { float v[8];
#pragma unroll
            for (int j = 0; j < 8; ++j) v[j] = bf2f(*(const LAS bf16*)(Ks + dir * 32768 + swzQ(t8 * 8 + j, d * 2))) * eb;
            u32x4 wv; wv.x = cvt_pk_bf16(v[0], v[1]); wv.y = cvt_pk_bf16(v[2], v[3]); wv.z = cvt_pk_bf16(v[4], v[5]); wv.w = cvt_pk_bf16(v[6], v[7]); kt[t8] = wv; }
    }
    u32x4 vreg[8];
#pragma unroll
    for (int m = 0; m < 8; ++m) { const int ci = tid + 512 * m, row = ci >> 6, c = ci & 63; vreg[m] = *(const u32x4*)(P + (size_t)(r0 + row) * NP + OV + h * 512 + 8 * c); }
    __syncthreads();
    {
        const int wv = F.wave, dw = wv >> 2, itile = wv & 3, r = F.lane & 15, g = F.lane >> 4;
        bf16x8 af[8];
#pragma unroll
        for (int kk = 0; kk < 8; ++kk) af[kk] = *(const LAS bf16x8*)(Qs + dw * 32768 + swzQ(16 * itile + r, (32 * kk + 8 * g) * 2));
        bf16* AO = (bf16*)(F.ws + WS_AIN + dw * SZ_AIN) + (size_t)it * 4096;
#pragma unroll
        for (int jt = 0; jt < 4; ++jt) {
            f32x4 acc = (f32x4){0.f, 0.f, 0.f, 0.f};
            const bool live = dw == 0 ? (jt <= itile) : (jt >= itile);
            if (live) {
#pragma unroll
                for (int kk = 0; kk < 8; ++kk) { const bf16x8 bq = *(const LAS bf16x8*)(Ks + dw * 32768 + swzQ(16 * jt + r, (32 * kk + 8 * g) * 2)); acc = __builtin_amdgcn_mfma_f32_16x16x32_bf16(af[kk], bq, acc, 0, 0, 0); }
            }
#pragma unroll
            for (int q = 0; q < 4; ++q) { const int i = 16 * itile + 4 * g + q, j = 16 * jt + r; const bool keep = dw == 0 ? (j <= i) : (j >= i); AO[i * 64 + j] = f2bf(keep ? acc[q] : 0.f); }
        }
    }
    __syncthreads();
#pragma unroll
    for (int m = 0; m < 8; ++m) { const int ci = tid + 512 * m; *(LAS u32x4*)(Qs + ci * 16) = vreg[m]; }
    __syncthreads();
    {
        const int dv = tid;
        u32x4* vt = (u32x4*)((bf16*)(F.ws + WS_VT) + ((size_t)it * 512 + dv) * 64);
#pragma unroll
        for (int t8 = 0; t8 < 8; ++t8) { unsigned wd[4];
#pragma unroll
            for (int p = 0; p < 4; ++p) { const unsigned lo = *(const LAS unsigned short*)(Qs + (8 * t8 + 2 * p) * 1024 + 2 * dv), hi = *(const LAS unsigned short*)(Qs + (8 * t8 + 2 * p + 1) * 1024 + 2 * dv); wd[p] = lo | (hi << 16); }
            u32x4 wv; wv.x = wd[0]; wv.y = wd[1]; wv.z = wd[2]; wv.w = wd[3]; vt[t8] = wv; }
    }
}
__device__ __forceinline__ void prep_fast_phase(Frame& F, int l, int parts) {
    if (parts & 1) for (int it = F.vcu; it < NIT; it += F.G) gla_prep_item(F, l, it);
    const bf16* P = (const bf16*)(F.ws + WS_P);
    const size_t gt = (size_t)F.vcu * 512 + F.tid, NT = (size_t)F.G * 512;
    if (parts & 2) {
        bf16* QR = (bf16*)(F.ws + WS_QR); bf16* KR = (bf16*)(F.ws + WS_KR);
        LAS float* tcs = (LAS float*)(F.lds + 131072); LAS float* tsn = tcs + 1024;
        for (int idx = F.tid; idx < 1024; idx += 512) { const float ang = (float)(idx >> 4) * __builtin_amdgcn_exp2f(-(float)(idx & 15) * (13.287712379549449f / 16.0f)) * 0.15915494309189535f;
            tcs[idx] = __builtin_amdgcn_cosf(ang); tsn[idx] = __builtin_amdgcn_sinf(ang); }
        __syncthreads();
        const int nfull = NIT - 2 * F.G, nwv = (F.G - nfull) * 8, rpw = (MT + nwv - 1) / nwv;
        const int wv_ = (F.vcu - nfull) * 8 + F.wave, rbeg = wv_ * rpw, rend = (F.vcu < nfull) ? 0 : min(MT, rbeg + rpw);
        const int ntask = (F.vcu < nfull) ? 0 : (rend - rbeg) * 144;
#pragma unroll 3
        for (int t_ = F.lane; t_ < ntask; t_ += 64) { const int r = rbeg + t_ / 144, p = t_ % 144;
                const bool isq = p < 128; const int hp = isq ? p : p - 128, head = hp >> 2, half = (hp >> 1) & 1, sub = hp & 1, d0 = half * 32 + sub * 8;
                const bf16* src = P + (size_t)r * NP + (isq ? OAQ : OAK) + head * 64 + d0;
                const u32x4 a = *(const u32x4*)src, bq = *(const u32x4*)(src + 16);
                float x0[8] = {bflo(a.x), bfhi(a.x), bflo(a.y), bfhi(a.y), bflo(a.z), bfhi(a.z), bflo(a.w), bfhi(a.w)}, x1[8] = {bflo(bq.x), bfhi(bq.x), bflo(bq.y), bfhi(bq.y), bflo(bq.z), bfhi(bq.z), bflo(bq.w), bfhi(bq.w)};
                float o0[8], o1[8];
                const float sc = isq ? 0.18033688011112042f : 1.0f;
                if (r < ML) { const int t = r % SEQ, pos = half == 0 ? (t >> 6) : (t & 63);
                    const LAS f32x4* pc = (const LAS f32x4*)(tcs + pos * 16 + sub * 8); const LAS f32x4* ps = (const LAS f32x4*)(tsn + pos * 16 + sub * 8);
                    const f32x4 c0 = pc[0], c1 = pc[1], s0 = ps[0], s1 = ps[1];
#pragma unroll
                    for (int j = 0; j < 8; ++j) { const float cs = j < 4 ? c0[j & 3] : c1[j & 3], sn = j < 4 ? s0[j & 3] : s1[j & 3]; o0[j] = (x0[j] * cs - x1[j] * sn) * sc; o1[j] = (x1[j] * cs + x0[j] * sn) * sc; } }
                else {
#pragma unroll
                    for (int j = 0; j < 8; ++j) { o0[j] = x0[j] * sc; o1[j] = x1[j] * sc; } }
                bf16* dst = (isq ? QR + (size_t)r * D : KR + (size_t)r * 256) + head * 64 + d0;
                u32x4 w0, w1; w0.x = cvt_pk_bf16(o0[0], o0[1]); w0.y = cvt_pk_bf16(o0[2], o0[3]); w0.z = cvt_pk_bf16(o0[4], o0[5]); w0.w = cvt_pk_bf16(o0[6], o0[7]);
                w1.x = cvt_pk_bf16(o1[0], o1[1]); w1.y = cvt_pk_bf16(o1[2], o1[3]); w1.z = cvt_pk_bf16(o1[4], o1[5]); w1.w = cvt_pk_bf16(o1[6], o1[7]);
                *(u32x4*)dst = w0; *(u32x4*)(dst + 16) = w1; }
    }
    if (parts & 4) {   bf16* VAT = (bf16*)(F.ws + WS_VAT);
        const size_t gtr = (size_t)(F.G - 1 - F.vcu) * 512 + F.tid;
        for (size_t idx = gtr; idx < (size_t)(MT / 64) * 256; idx += NT) { const int ch = (int)(idx >> 8), kd = (int)(idx & 255);
            float v[64];
#pragma unroll
            for (int i = 0; i < 64; ++i) v[i] = bf2f(P[(size_t)(ch * 64 + i) * NP + OAV + kd]);
            u32x4* vt = (u32x4*)(VAT + ((size_t)ch * 256 + kd) * 64);
#pragma unroll
            for (int t8 = 0; t8 < 8; ++t8) { u32x4 wv; wv.x = cvt_pk_bf16(v[8 * t8], v[8 * t8 + 1]); wv.y = cvt_pk_bf16(v[8 * t8 + 2], v[8 * t8 + 3]); wv.z = cvt_pk_bf16(v[8 * t8 + 4], v[8 * t8 + 5]); wv.w = cvt_pk_bf16(v[8 * t8 + 6], v[8 * t8 + 7]); vt[t8] = wv; } }
    }
}

constexpr int SC_STAGE = 73728, SC_Q = 0, SC_KT = 32768, SC_A = 65536, SC_DEC = 147712;
constexpr int SC_FLAGS = MISC_OFF + 64;
__device__ __forceinline__ void sc_wait4(const volatile LAS unsigned* w4, unsigned need) {
    for (unsigned spins = 0; spins < (1u << 22); ++spins) {
        const unsigned a = w4[0], b = w4[1], c = w4[2], d = w4[3];
        const unsigned m = min(min(a, b), min(c, d));
        if (__builtin_amdgcn_readfirstlane(m) >= need) return;
        __builtin_amdgcn_s_sleep(1);
    }
}
template <int VAR> __device__ __forceinline__ void gla_scan(Frame& F, int wg) {
    const int seq = wg >> 2, dvb = wg & 3, b = seq >> 3, h = (seq >> 1) & 3, dir = seq & 1;
    const int w = F.wave, lane = F.lane, r = lane & 15, g = lane >> 4;
    const unsigned char* QIN = F.ws + WS_QIN + dir * SZ_QIN; const unsigned char* KTO = F.ws + WS_KTO + dir * SZ_KTO; const unsigned char* AIN = F.ws + WS_AIN + dir * SZ_AIN;
    const unsigned char* DEC = F.ws + WS_DEC + dir * SZ_DEC; const bf16* VT = (const bf16*)(F.ws + WS_VT);
    bf16* O = (bf16*)(F.ws + (dir ? WS_OB : WS_OF));
    const int itb = (b * 4 + h) * 68;
    LAS unsigned char* lds = F.lds;
    volatile LAS unsigned* flags = (volatile LAS unsigned*)(lds + SC_FLAGS);
    __syncthreads();
    if (F.tid < 16) flags[F.tid] = 0u;
    __syncthreads();
#define SC_CHUNK(n) (dir == 0 ? (n) : ((n) < 4 ? 3 - (n) : 71 - (n)))
    if (w >= 4) {
        const int hl = w - 4;
        for (int m = 0; m < 68; ++m) {
            const int it_ = itb + SC_CHUNK(m), r0_ = gla_item_row0(it_); LAS unsigned char* st_ = lds + (m & 1) * SC_STAGE;
            if (m >= 2) sc_wait4(flags + 8, (unsigned)(m - 1));
            if (VAR != 2) {
#pragma unroll
                for (int qi = 0; qi < 8; ++qi) { const int q_ = 8 * hl + qi, row_ = 2 * q_ + (lane >> 5), cc_ = (lane & 31) ^ (row_ & 15);
                    glds16(QIN + (size_t)(r0_ + row_) * 2048 + h * 512 + cc_ * 16, st_ + SC_Q + q_ * 1024); }
#pragma unroll
                for (int qi = 0; qi < 2; ++qi) { const int q_ = 2 * hl + qi, row_ = 8 * q_ + (lane >> 3), cc_ = (lane & 7) ^ ((row_ >> 1) & 7);
                    glds16(AIN + (size_t)it_ * 8192 + row_ * 128 + cc_ * 16, st_ + SC_A + q_ * 1024); }
            }
            if (m >= 1) { asm volatile("s_waitcnt vmcnt(10)" ::: "memory"); if (lane == 0) flags[4 + hl] = (unsigned)m; }
            if (m >= 2) sc_wait4(flags + 12, (unsigned)(m - 1));
            if (VAR != 2) {
#pragma unroll
                for (int qi = 0; qi < 8; ++qi) { const int q_ = 8 * hl + qi, row_ = 8 * q_ + (lane >> 3), cc_ = (lane & 7) ^ ((row_ >> 1) & 7);
                    glds16(KTO + (size_t)it_ * 32768 + row_ * 128 + cc_ * 16, st_ + SC_KT + q_ * 1024); }
                __builtin_amdgcn_global_load_lds((const unsigned*)(DEC + (size_t)it_ * 1024 + hl * 256 + lane * 4), (LAS unsigned*)(lds + SC_DEC + (m & 1) * 1024 + hl * 256), 4, 0, 0);
            }
            asm volatile("s_waitcnt vmcnt(9)" ::: "memory"); if (lane == 0) flags[hl] = (unsigned)(m + 1);
        }
        asm volatile("s_waitcnt vmcnt(0)" ::: "memory"); if (lane == 0) flags[4 + hl] = 68u;
    } else {
        const int c = w;
        f32x4 S[16][2];
#pragma unroll
        for (int t = 0; t < 16; ++t) { S[t][0] = (f32x4){0.f, 0.f, 0.f, 0.f}; S[t][1] = (f32x4){0.f, 0.f, 0.f, 0.f}; }
        bf16x8 vt[2][2];
        int k64off[2];
        const int qoff0 = r * 512 + ((((g >> 1) ^ r) & 15) << 4) + 8 * (g & 1);
#pragma unroll
        for (int ks = 0; ks < 2; ++ks) k64off[ks] = r * 128 + (((4 * ks + g) ^ ((r >> 1) & 7)) << 4);
#define SC_LOADVT(n) do { const int it_ = itb + SC_CHUNK(n); _Pragma("unroll") for (int ks = 0; ks < 2; ++ks) _Pragma("unroll") for (int nt = 0; nt < 2; ++nt) \
            vt[ks][nt] = *(const bf16x8*)(VT + ((size_t)it_ * 512 + dvb * 128 + 32 * c + 16 * nt + r) * 64 + 32 * ks + 8 * g); } while (0)
        SC_LOADVT(0);
        for (int n = 0; n < 68; ++n) {
            const LAS unsigned char* st = lds + (n & 1) * SC_STAGE; const LAS unsigned char* dec = lds + SC_DEC + (n & 1) * 1024 + 16 * g;
            const int row0 = gla_item_row0(itb + SC_CHUNK(n));
            const LAS unsigned char* kp0 = st + SC_KT + k64off[0]; const LAS unsigned char* kp1 = st + SC_KT + k64off[1];
            const LAS unsigned char* ap0 = st + SC_A + k64off[0]; const LAS unsigned char* ap1 = st + SC_A + k64off[1];
            sc_wait4(flags + 0, (unsigned)(n + 1));
            asm volatile("" ::: "memory");
#pragma unroll
            for (int mh = 0; mh < 2; ++mh) {
                f32x4 o[2][2];
#pragma unroll
                for (int mt = 0; mt < 2; ++mt) { o[mt][0] = (f32x4){0.f, 0.f, 0.f, 0.f}; o[mt][1] = (f32x4){0.f, 0.f, 0.f, 0.f}; }
                if (VAR != 1) {
                s16x4 qa[3][2][2];
#define SC_LOADQ(buf, ks_) do { _Pragma("unroll") for (int mt = 0; mt < 2; ++mt) { \
                    qa[buf][mt][0] = *(const LAS s16x4*)(st + SC_Q + (qoff0 ^ ((4 * ((ks_) & 3)) << 4)) + ((ks_) >> 2) * 256 + (2 * mh + mt) * 8192); \
                    qa[buf][mt][1] = *(const LAS s16x4*)(st + SC_Q + (qoff0 ^ ((4 * ((ks_) & 3) + 2) << 4)) + ((ks_) >> 2) * 256 + (2 * mh + mt) * 8192); } } while (0)
                SC_LOADQ(0, 0); SC_LOADQ(1, 1); __builtin_amdgcn_sched_barrier(0);
#pragma unroll
                for (int ks = 0; ks < 8; ++ks) {
                    if (ks < 6) SC_LOADQ((ks + 2) % 3, ks + 2);
                    __builtin_amdgcn_sched_barrier(0);
                    const bf16x8 sb0 = pack8(S[2 * ks][0], S[2 * ks + 1][0]), sb1 = pack8(S[2 * ks][1], S[2 * ks + 1][1]);
#pragma unroll
                    for (int mt = 0; mt < 2; ++mt) { const bf16x8 a_ = cat8(qa[ks % 3][mt][0], qa[ks % 3][mt][1]);
                        o[mt][0] = __builtin_amdgcn_mfma_f32_16x16x32_bf16(a_, sb0, o[mt][0], 0, 0, 0); o[mt][1] = __builtin_amdgcn_mfma_f32_16x16x32_bf16(a_, sb1, o[mt][1], 0, 0, 0); }
                    __builtin_amdgcn_sched_barrier(0);
                }
#undef SC_LOADQ
#pragma unroll
                for (int ks = 0; ks < 2; ++ks) { bf16x8 aa[2];
#pragma unroll
                    for (int mt = 0; mt < 2; ++mt) aa[mt] = *(const LAS bf16x8*)((ks ? ap1 : ap0) + (2 * mh + mt) * 2048);
                    __builtin_amdgcn_sched_barrier(0);
#pragma unroll
                    for (int mt = 0; mt < 2; ++mt) { o[mt][0] = __builtin_amdgcn_mfma_f32_16x16x32_bf16(aa[mt], vt[ks][0], o[mt][0], 0, 0, 0); o[mt][1] = __builtin_amdgcn_mfma_f32_16x16x32_bf16(aa[mt], vt[ks][1], o[mt][1], 0, 0, 0); }
                    __builtin_amdgcn_sched_barrier(0); }
                }
                if (mh == 1) { asm volatile("s_waitcnt lgkmcnt(0)" ::: "memory"); if (lane == 0) flags[8 + c] = (unsigned)(n + 1); }
                { int lo_ = (4 * g) * D + r; asm volatile("" : "+v"(lo_));
                  bf16* ob = O + (size_t)(row0 + 32 * mh) * D + h * 512 + dvb * 128 + 32 * c + lo_;
#pragma unroll
                  for (int mt = 0; mt < 2; ++mt)
#pragma unroll
                    for (int q = 0; q < 4; ++q) { ob[(16 * mt + q) * D] = f2bf(o[mt][0][q]); ob[(16 * mt + q) * D + 16] = f2bf(o[mt][1][q]); } }
            }
            sc_wait4(flags + 4, (unsigned)(n + 1));
            asm volatile("" ::: "memory");
            if (VAR != 1) {
            bf16x8 ka[3][2]; f32x4 dcv[3][2];
#define SC_LOADK(buf, bi) do { _Pragma("unroll") for (int t4 = 0; t4 < 2; ++t4) { const int ks_ = (bi) >> 3, t_ = 2 * ((bi) & 7) + t4; \
                ka[buf][t4] = *(const LAS bf16x8*)((ks_ ? kp1 : kp0) + t_ * 2048); \
                if ((bi) < 8) dcv[buf][t4] = *(const LAS f32x4*)(dec + t_ * 64); } } while (0)
            SC_LOADK(0, 0); SC_LOADK(1, 1); __builtin_amdgcn_sched_barrier(0);
#pragma unroll
            for (int bi = 0; bi < 16; ++bi) {
                if (bi < 14) SC_LOADK((bi + 2) % 3, bi + 2);
                __builtin_amdgcn_sched_barrier(0);
#pragma unroll
                for (int t4 = 0; t4 < 2; ++t4) { const int ks = bi >> 3, t = 2 * (bi & 7) + t4;
                    if (bi < 8) { S[t][0] = S[t][0] * dcv[bi % 3][t4]; S[t][1] = S[t][1] * dcv[bi % 3][t4]; }
                    S[t][0] = __builtin_amdgcn_mfma_f32_16x16x32_bf16(ka[bi % 3][t4], vt[ks][0], S[t][0], 0, 0, 0); S[t][1] = __builtin_amdgcn_mfma_f32_16x16x32_bf16(ka[bi % 3][t4], vt[ks][1], S[t][1], 0, 0, 0); }
                __builtin_amdgcn_sched_barrier(0);
            }
#undef SC_LOADK
            }
            asm volatile("s_waitcnt lgkmcnt(0)" ::: "memory");
            if (lane == 0) flags[12 + c] = (unsigned)(n + 1);
            if (n + 1 < 68) SC_LOADVT(n + 1);
        }
#undef SC_LOADVT
    }
    asm volatile("s_waitcnt vmcnt(0) lgkmcnt(0)" ::: "memory");
    __syncthreads();
#undef SC_CHUNK
}

__device__ __forceinline__ float xg_max(float x) {
    auto a = __builtin_amdgcn_permlane16_swap(__float_as_uint(x), __float_as_uint(x), false, false); x = fmaxf(__uint_as_float(a[0]), __uint_as_float(a[1]));
    auto b = __builtin_amdgcn_permlane32_swap(__float_as_uint(x), __float_as_uint(x), false, false); return fmaxf(__uint_as_float(b[0]), __uint_as_float(b[1]));
}
__device__ __forceinline__ float xg_sum(float x) {
    auto a = __builtin_amdgcn_permlane16_swap(__float_as_uint(x), __float_as_uint(x), false, false); x = __uint_as_float(a[0]) + __uint_as_float(a[1]);
    auto b = __builtin_amdgcn_permlane32_swap(__float_as_uint(x), __float_as_uint(x), false, false); return __uint_as_float(b[0]) + __uint_as_float(b[1]);
}
template <int AVAR> __device__ __forceinline__ void attn_unit(Frame& F, int l, int u, size_t ws_ax) {
    const bf16* QR = (const bf16*)(F.ws + WS_QR); const unsigned char* KR = F.ws + WS_KR; const unsigned char* VAT = F.ws + WS_VAT; bf16* AX = (bf16*)(F.ws + ws_ax);
    int b, kvh, qb, qrow0; bool lat;
    if (u < 512) { lat = true; b = u >> 8; kvh = (u >> 6) & 3; qb = u & 63; qrow0 = b * SEQ + 64 * qb; } else { const int v = u - 512; lat = false; b = v >> 4; kvh = (v >> 2) & 3; qb = v & 3; qrow0 = ML + b * CTXL + 64 * qb; }
    const int w = F.wave, lane = F.lane, r = lane & 15, g = lane >> 4, hq = kvh * 8 + w;
    LAS unsigned char* lds = F.lds;
    asm volatile("s_waitcnt lgkmcnt(0)\n\ts_barrier" ::: "memory");
    for (int idx = w; idx < 144; idx += 8) { const int j = idx >> 4, kind = (idx >> 3) & 1, q = idx & 7;
        int krow;
        if (j < 5) { const int t0 = 64 * qb - 128 + 64 * j; krow = (lat && t0 >= 0 && t0 < SEQ) ? b * SEQ + t0 : -1; } else krow = ML + b * CTXL + 64 * (j - 5);
        if (krow < 0 || AVAR == 1) continue;
        const int row = 8 * q + (lane >> 3), cc = (lane & 7) ^ ((row >> 1) & 7);
        if (kind == 0) glds16(KR + (size_t)(krow + row) * 512 + kvh * 128 + cc * 16, lds + j * 8192 + q * 1024);
        else glds16(VAT + ((size_t)(krow >> 6) * 4 + kvh) * 8192 + row * 128 + cc * 16, lds + 73728 + j * 8192 + q * 1024);
    }
    bf16x8 qf[4][2];
#pragma unroll
    for (int qt = 0; qt < 4; ++qt)
#pragma unroll
        for (int ks = 0; ks < 2; ++ks) qf[qt][ks] = *(const bf16x8*)(QR + (size_t)(qrow0 + 16 * qt + r) * D + hq * 64 + 32 * ks + 8 * g);
    int k64off[2], v64off[2][2];
#pragma unroll
    for (int ks = 0; ks < 2; ++ks) { k64off[ks] = r * 128 + (((4 * ks + g) ^ ((r >> 1) & 7)) << 4);
#pragma unroll
        for (int hs = 0; hs < 2; ++hs) v64off[ks][hs] = r * 128 + (((4 * ks + 2 * hs + (g >> 1)) ^ ((r >> 1) & 7)) << 4) + 8 * (g & 1); }
    const float sink = INP(I_SINK)[l * AHQ + hq] * 1.4426950408889634f;
    float mrow[4]; f32x4 lacc[4]; f32x4 O[4][4];
    const bf16x8 ones8 = (bf16x8){0x3F80, 0x3F80, 0x3F80, 0x3F80, 0x3F80, 0x3F80, 0x3F80, 0x3F80};
#pragma unroll
    for (int qt = 0; qt < 4; ++qt) { mrow[qt] = sink; lacc[qt] = (f32x4){1.f, 1.f, 1.f, 1.f};
#pragma unroll
        for (int dt = 0; dt < 4; ++dt) O[dt][qt] = (f32x4){0.f, 0.f, 0.f, 0.f}; }
    asm volatile("s_waitcnt vmcnt(0)\n\ts_barrier" ::: "memory");
    for (int j = 0; j < 9; ++j) {
        if (j < 5) { const int t0 = 64 * qb - 128 + 64 * j; if (!(lat && t0 >= 0 && t0 < SEQ)) continue; }
        const LAS unsigned char* Kt = lds + j * 8192; const LAS unsigned char* Vt = lds + 73728 + j * 8192;
        f32x4 Sc[4][4];
#pragma unroll
        for (int kk = 0; kk < 4; ++kk)
#pragma unroll
            for (int qt = 0; qt < 4; ++qt) Sc[kk][qt] = (f32x4){0.f, 0.f, 0.f, 0.f};
        { bf16x8 kaf[2][4];
#pragma unroll
            for (int kk = 0; kk < 4; ++kk) kaf[0][kk] = *(const LAS bf16x8*)(Kt + k64off[0] + kk * 2048);
        __builtin_amdgcn_sched_barrier(0);
#pragma unroll
        for (int ks = 0; ks < 2; ++ks) {
            if (ks == 0) {
#pragma unroll
                for (int kk = 0; kk < 4; ++kk) kaf[1][kk] = *(const LAS bf16x8*)(Kt + k64off[1] + kk * 2048);
            }
            __builtin_amdgcn_sched_barrier(0);
#pragma unroll
            for (int kk = 0; kk < 4; ++kk)
#pragma unroll
                for (int qt = 0; qt < 4; ++qt) { if (AVAR == 3) Sc[kk][qt][0] += __builtin_bit_cast(f32x4, kaf[ks][kk])[0]; else Sc[kk][qt] = __builtin_amdgcn_mfma_f32_16x16x32_bf16(kaf[ks][kk], qf[qt][ks], Sc[kk][qt], 0, 0, 0); }
            __builtin_amdgcn_sched_barrier(0); } }
        if (j == 0 || j == 4) {
#pragma unroll
            for (int kk = 0; kk < 4; ++kk)
#pragma unroll
                for (int qt = 0; qt < 4; ++qt)
#pragma unroll
                    for (int q = 0; q < 4; ++q) { const int ki = 16 * kk + 4 * g + q, qi = 16 * qt + r; const bool ok = (j == 0) ? (ki >= qi) : (ki <= qi); if (!ok) Sc[kk][qt][q] = -1e30f; }
        }
        bf16x8 pf[2][4];
        if (AVAR == 2) {
#pragma unroll
            for (int qt = 0; qt < 4; ++qt) { pf[0][qt] = pack8b(Sc[0][qt], Sc[1][qt]); pf[1][qt] = pack8b(Sc[2][qt], Sc[3][qt]); }
        } else {
            float mx[4]; bool grow = false;
#pragma unroll
            for (int qt = 0; qt < 4; ++qt) { float v = -1e30f;
#pragma unroll
                for (int kk = 0; kk < 4; ++kk) v = fmaxf(v, fmaxf(fmaxf(Sc[kk][qt][0], Sc[kk][qt][1]), fmaxf(Sc[kk][qt][2], Sc[kk][qt][3])));
                mx[qt] = xg_max(v); grow |= (mx[qt] > mrow[qt] + 8.0f); }
            if (__any(grow)) {
#pragma unroll
                for (int qt = 0; qt < 4; ++qt) { const float mn = fmaxf(mrow[qt], mx[qt]), sc = __builtin_amdgcn_exp2f(mrow[qt] - mn); mrow[qt] = mn; lacc[qt] = lacc[qt] * sc;
#pragma unroll
                    for (int dt = 0; dt < 4; ++dt) O[dt][qt] = O[dt][qt] * sc; }
            }
#pragma unroll
            for (int qt = 0; qt < 4; ++qt) { const float mn = mrow[qt];
#pragma unroll
                for (int kk = 0; kk < 4; ++kk)
#pragma unroll
                    for (int q = 0; q < 4; ++q) Sc[kk][qt][q] = __builtin_amdgcn_exp2f(Sc[kk][qt][q] - mn);
                pf[0][qt] = pack8b(Sc[0][qt], Sc[1][qt]); pf[1][qt] = pack8b(Sc[2][qt], Sc[3][qt]); }
        }
#pragma unroll
        for (int ks = 0; ks < 2; ++ks)
#pragma unroll
            for (int qt = 0; qt < 4; ++qt) lacc[qt] = __builtin_amdgcn_mfma_f32_16x16x32_bf16(ones8, pf[ks][qt], lacc[qt], 0, 0, 0);
        s16x4 vaf[2][4][2];
#pragma unroll
        for (int dt = 0; dt < 4; ++dt) { vaf[0][dt][0] = *(const LAS s16x4*)(Vt + v64off[0][0] + dt * 2048); vaf[0][dt][1] = *(const LAS s16x4*)(Vt + v64off[0][1] + dt * 2048); }
        __builtin_amdgcn_sched_barrier(0);
#pragma unroll
        for (int ks = 0; ks < 2; ++ks) {
            if (ks == 0) {
#pragma unroll
                for (int dt = 0; dt < 4; ++dt) { vaf[1][dt][0] = *(const LAS s16x4*)(Vt + v64off[1][0] + dt * 2048); vaf[1][dt][1] = *(const LAS s16x4*)(Vt + v64off[1][1] + dt * 2048); }
            }
            __builtin_amdgcn_sched_barrier(0);
#pragma unroll
            for (int dt = 0; dt < 4; ++dt)
#pragma unroll
                for (int qt = 0; qt < 4; ++qt) { if (AVAR == 3) O[dt][qt][0] += __builtin_bit_cast(f32x4, pf[ks][qt])[0] + (float)vaf[ks][dt][0][0]; else O[dt][qt] = __builtin_amdgcn_mfma_f32_16x16x32_bf16(cat8(vaf[ks][dt][0], vaf[ks][dt][1]), pf[ks][qt], O[dt][qt], 0, 0, 0); }
            __builtin_amdgcn_sched_barrier(0); }
    }
    { int lo_ = r * D + 4 * g; asm volatile("" : "+v"(lo_));
      bf16* ab = AX + (size_t)qrow0 * D + hq * 64 + lo_;
#pragma unroll
      for (int qt = 0; qt < 4; ++qt) { const float il = 1.0f / lacc[qt][0];
#pragma unroll
        for (int dt = 0; dt < 4; ++dt) { u32x2 wv; wv.x = cvt_pk_bf16(O[dt][qt][0] * il, O[dt][qt][1] * il); wv.y = cvt_pk_bf16(O[dt][qt][2] * il, O[dt][qt][3] * il);
            *(u32x2*)(ab + (size_t)(16 * qt) * D + 16 * dt) = wv; } } }
}
__device__ __forceinline__ void mix_fast_phase(Frame& F, int l, size_t ws_ax, int parts) {
    if (F.bid < 64) { if (parts & 1) { if (parts & 16) gla_scan<1>(F, F.bid); else if (parts & 32) gla_scan<2>(F, F.bid); else gla_scan<0>(F, F.bid); } return; }
    const int nu = (l == 0) ? 544 : 512;
    if (parts & 2) { if (parts & 64) { for (int u = F.bid - 64; u < nu; u += F.G - 64) attn_unit<1>(F, l, u, ws_ax); }
                     else if (parts & 128) { for (int u = F.bid - 64; u < nu; u += F.G - 64) attn_unit<2>(F, l, u, ws_ax); }
                     else if (parts & 256) { for (int u = F.bid - 64; u < nu; u += F.G - 64) attn_unit<3>(F, l, u, ws_ax); }
                     else { for (int u = F.bid - 64; u < nu; u += F.G - 64) attn_unit<0>(F, l, u, ws_ax); } }
    asm volatile("s_waitcnt vmcnt(0) lgkmcnt(0)\n\ts_barrier" ::: "memory");
    if ((parts & 3) == 3 && F.G == 256) { convert_range(F, l == 0 ? CV_MIX0 + (F.bid - 64) * CVQ_MIX : CV_MIX1 + (F.bid - 64) * CVQ_MIX1, l == 0 ? CVQ_MIX : CVQ_MIX1);
        if (l == 0 && CVX_MIX0 > 0) convert_range(F, CV_MIX0X + (F.bid - 64) * CVX_MIX0, CVX_MIX0); }
}
#if MIXCHECK
__device__ __forceinline__ void mixcheck_phase(Frame& F, int l) {
    const size_t gt = (size_t)F.vcu * 512 + F.tid, NT = (size_t)F.G * 512; const size_t n = (size_t)((l == 0) ? MT : ML) * D;
    const bf16* OFa = (const bf16*)(F.ws + WS_OF); const bf16* OBa = (const bf16*)(F.ws + WS_OB);
    const bf16* OF2 = (const bf16*)(F.ws + WS_OF2); const bf16* OB2 = (const bf16*)(F.ws + WS_OB2);
    const bf16* AXa = (const bf16*)(F.ws + WS_AX); const bf16* AX2 = (const bf16*)(F.ws + WS_AX2);
    float dg = 0.f, ng = 0.f, da = 0.f, na = 0.f;
    for (size_t i = gt; i < n; i += NT) { const float a = bf2f(OFa[i]) + bf2f(OBa[i]), b = bf2f(OF2[i]) + bf2f(OB2[i]); dg += (a - b) * (a - b); ng += b * b; const float c = bf2f(AXa[i]), e = bf2f(AX2[i]); da += (c - e) * (c - e); na += e * e; }
    dg = wave_sum(dg); ng = wave_sum(ng); da = wave_sum(da); na = wave_sum(na);
    if (F.lane == 0) { float* acc = (float*)(F.ctl + CW_CHK) + 4 * l; atomicAdd(acc + 0, dg); atomicAdd(acc + 1, ng); atomicAdd(acc + 2, da); atomicAdd(acc + 3, na); }
}
#endif

constexpr int NPH = 22;
struct Args { const float* in[28]; float* out; unsigned char* ws; int ph_lo, ph_hi; };
__device__ __forceinline__ void make_frame(Frame& F, const Args& args, unsigned char* lds_raw) {
    int tid = threadIdx.x; asm volatile("" : "+v"(tid));
    int G = gridDim.x, bx = blockIdx.x; asm volatile("" : "+s"(G), "+s"(bx));
    GAS unsigned char* ws = (GAS unsigned char*)args.ws; asm volatile("" : "+s"(ws));
    F.lds = (LAS unsigned char*)lds_raw;
    F.tid = tid; F.lane = tid & 63; F.wave = __builtin_amdgcn_readfirstlane(tid >> 6);
    F.G = G; F.bid = bx; F.vcu = (G % 8 == 0) ? (bx % 8) * (G / 8) + bx / 8 : bx;
    const __attribute__((address_space(4))) void* ka = (const __attribute__((address_space(4))) void*)__builtin_amdgcn_kernarg_segment_ptr(); asm volatile("" : "+s"(ka));
    F.in = (in_table_t)ka; F.out = args.out; F.ws = (unsigned char*)ws; F.ctl = (unsigned*)(F.ws + WS_CTL);
}
__global__ void __launch_bounds__(512, 2) fwd_kernel(Args args) {
    extern __shared__ __attribute__((aligned(16))) unsigned char lds_raw[];
    volatile LAS unsigned* MISC = (volatile LAS unsigned*)((LAS unsigned char*)lds_raw + MISC_OFF);
    if (threadIdx.x < 32) MISC[threadIdx.x] = 0u;
    __syncthreads();
    XcdBarrier bar; bar.bar = (unsigned*)(args.ws + WS_CTL) + CW_BAR; bar.x = 0; bar.st = MISC + 8;
    const int lo = args.ph_lo, hi = args.ph_hi;
    if (hi - lo > 1) bar = xcd_barrier_post((unsigned*)(args.ws + WS_CTL) + CW_BAR, MISC + 8);
#ifndef PHMASK
#define PHMASK 0xFFFFFFFFu
#endif
#define IN(k) (((PHMASK >> (k)) & 1u) && lo <= (k) && (k) < hi)
#define SEAM(k) do { if (lo <= (k) && (k) + 1 < hi) xcd_barrier(bar); } while (0)
#define REP(k) for (int rep_ = 0; rep_ < (((PROBE_MASK >> (k)) & 1u) ? 2 : 1); ++rep_)
#define REPBAR(k) do { if (((PROBE_MASK >> (k)) & 1u) && rep_ == 0) xcd_barrier(bar); } while (0)
#define PHASE_BEGIN Frame F; make_frame(F, args, lds_raw); unsigned char* ws = F.ws; int l = l_; asm volatile("" : "+s"(l)); (void)ws; (void)l;

    { const int l_ = 0; REP(0) { if (IN(0)) { PHASE_BEGIN p0_weights(F); p0_mod(F); } REPBAR(0); } SEAM(0); }
    { const int l_ = 0; REP(1) { if (IN(1)) { PHASE_BEGIN t1_phase(F); } REPBAR(1); } SEAM(1); }
    for (int l_ = 0; l_ < 2; ++l_) {
        const int pb = 2 + 10 * l_;
        REP(pb + 0) { if (IN(pb + 0)) { PHASE_BEGIN
            pg::SchedDense S; S.init(ws + WS_HX, ws + WS_WIN + l * SZ_WIN, l == 0 ? MT : ML, NP, D, F.G, F.bid, l == 0 ? 0 : 30);
            pg::EpiBf16 E{(bf16*)(ws + WS_P), NP, 0, (bf16*)(ws + WS_LRB + (size_t)l * SZ_LRB), OLR / 256};
            if (((PROBE_MASK >> (pb + 0)) & 1u) && rep_ == 0) E.skip = PROBE_PARTS;
            pg::gemm_phase<pg::EpiBf16, pg::SchedDense, true>(F.lds, F.tid, S, E);
        } REPBAR(pb + 0); } SEAM(pb + 0);
#if MIXCHECK
        REP(pb + 1) { if (IN(pb + 1)) { PHASE_BEGIN prep_phase(F, l); __syncthreads(); prep_fast_phase(F, l, 7); } REPBAR(pb + 1); } SEAM(pb + 1);
        REP(pb + 2) { if (IN(pb + 2)) { PHASE_BEGIN if (F.bid < 64) mix_simple_gla(F, F.bid, WS_OF2, WS_OB2); else mix_simple_attn(F, l, F.bid - 64, F.G - 64, WS_AX2);
            __syncthreads(); mix_fast_phase(F, l, WS_AX, 3); } REPBAR(pb + 2); } SEAM(pb + 2);
#elif FAST_MIX
        REP(pb + 1) { if (IN(pb + 1)) { PHASE_BEGIN if (rep_ == 0) prep_fast_phase(F, l, 7); else prep_fast_phase(F, l, PROBE_PARTS); } REPBAR(pb + 1); } SEAM(pb + 1);
        REP(pb + 2) { if (IN(pb + 2)) { PHASE_BEGIN if (((PROBE_MASK >> (pb + 2)) & 1u) && rep_ == 0) mix_fast_phase(F, l, WS_AX, PROBE_PARTS); else mix_fast_phase(F, l, WS_AX, 3); } REPBAR(pb + 2); } SEAM(pb + 2);
#else
        REP(pb + 1) { if (IN(pb + 1)) { PHASE_BEGIN prep_phase(F, l); } REPBAR(pb + 1); } SEAM(pb + 1);
        REP(pb + 2) { if (IN(pb + 2)) { PHASE_BEGIN if (F.bid < 64) mix_simple_gla(F, F.bid, WS_OF, WS_OB); else mix_simple_attn(F, l, F.bid - 64, F.G - 64, WS_AX); } REPBAR(pb + 2); } SEAM(pb + 2);
#endif
#if MIXCHECK
        REP(pb + 3) { if (IN(pb + 3)) { PHASE_BEGIN mixcheck_phase(F, l); ro_phase(F, l); } REPBAR(pb + 3); } SEAM(pb + 3);
#else
        REP(pb + 3) { if (IN(pb + 3)) { PHASE_BEGIN ro_phase(F, l); } REPBAR(pb + 3); } SEAM(pb + 3);
#endif
        REP(pb + 4) { if (IN(pb + 4)) { PHASE_BEGIN
            pg::SchedBranch S; S.init(ws + WS_GX, ws + WS_AX, ws + WS_WBG + l * SZ_WSQ, ws + WS_WBA + l * SZ_WSQ, l == 0 ? MT : ML, D, D, F.G, F.bid);
            pg::EpiBranch E{(const bf16*)(ws + WS_P), (bf16*)(ws + WS_O1), D};
            pg::gemm_phase<pg::EpiBranch, pg::SchedBranch, true>(F.lds, F.tid, S, E);
            if (CVQ_G2 > 0 && l == 0 && F.G == 256 && F.bid >= 16) convert_range(F, CV_G2 + (F.bid - 16) * CVQ_G2, CVQ_G2);
        } REPBAR(pb + 4); } SEAM(pb + 4);
        REP(pb + 5) { if (IN(pb + 5)) { PHASE_BEGIN
            if (CTX_SPLIT && l == 0) {
                pg::SchedCtxSplit S; S.init(ws + WS_O1, ws + WS_WO, D, D, F.G, F.bid, YP_S3);
                pg::EpiBf16Ctx E{(bf16*)(ws + WS_Y), (float*)(ws + WS_YP), D};
                pg::gemm_phase<pg::EpiBf16Ctx, pg::SchedCtxSplit, true>(F.lds, F.tid, S, E);
            } else {
            pg::SchedDense S; S.init(ws + WS_O1, ws + WS_WO + l * SZ_WSQ, l == 0 ? MT : ML, D, D, F.G, F.bid, 0);
            pg::EpiBf16 E{(bf16*)(ws + WS_Y), D};
            pg::gemm_phase<pg::EpiBf16, pg::SchedDense, true>(F.lds, F.tid, S, E);
            }
        } REPBAR(pb + 5); } SEAM(pb + 5);
        REP(pb + 6) { if (IN(pb + 6)) { PHASE_BEGIN t3_phase(F, l); } REPBAR(pb + 6); } SEAM(pb + 6);
        if (l_ == 0) {
            REP(pb + 7) { if (IN(pb + 7)) { PHASE_BEGIN
#if DENSE_FP8 == 1
                pg::SchedDense S; S.init(ws + WS_HX8, ws + WS_FGU, MT, NGU, D / 2, F.G, F.bid, 0); S.sa = X8_E; S.sb = W8_E;
                pg::EpiSwiGLU8 E{ws + WS_P, DFF, H8_SCALE};
                pg::gemm_phase<pg::EpiSwiGLU8, pg::SchedDense, true, true, D / 2>(F.lds, F.tid, S, E);
#elif DENSE_FP8 == 2
                pg::SchedDense S; S.init(ws + WS_HX8, ws + WS_FGU, MT, NGU, D / 2, F.G, F.bid, 0); S.sa = X8_E; S.sb = W8_E;
                pg::EpiSwiGLU E{(bf16*)(ws + WS_P), DFF};
                pg::gemm_phase<pg::EpiSwiGLU, pg::SchedDense, true, true, D / 2>(F.lds, F.tid, S, E);
#else
                pg::SchedDense S; S.init(ws + WS_HX, ws + WS_FGU, MT, NGU, D, F.G, F.bid, 0);
                pg::EpiSwiGLU E{(bf16*)(ws + WS_P), DFF};
                pg::gemm_phase<pg::EpiSwiGLU, pg::SchedDense, true>(F.lds, F.tid, S, E);
#endif
            } REPBAR(pb + 7); } SEAM(pb + 7);
            REP(pb + 8) { if (IN(pb + 8)) { PHASE_BEGIN
#if DENSE_FP8 == 1
                pg::SchedDense S; S.init(ws + WS_P, ws + WS_FDN, MT, D, DFF / 2, F.G, F.bid, 0); S.sa = H8_E; S.sb = W8_E;
                pg::EpiBf16 E{(bf16*)(ws + WS_Y), D};
                pg::gemm_phase<pg::EpiBf16, pg::SchedDense, true, true, DFF / 2>(F.lds, F.tid, S, E);
#else
#if CTX_SPLIT
                pg::SchedCtxSplit S; S.init(ws + WS_P, ws + WS_FDN, D, DFF, F.G, F.bid, YP_S5);
                pg::EpiBf16Ctx E{(bf16*)(ws + WS_Y), (float*)(ws + WS_YP), D};
                pg::gemm_phase<pg::EpiBf16Ctx, pg::SchedCtxSplit, true>(F.lds, F.tid, S, E);
#else
                pg::SchedDense S; S.init(ws + WS_P, ws + WS_FDN, MT, D, DFF, F.G, F.bid, 0);
                pg::EpiBf16 E{(bf16*)(ws + WS_Y), D};
                pg::gemm_phase<pg::EpiBf16, pg::SchedDense, true>(F.lds, F.tid, S, E);
#endif
#endif
            } REPBAR(pb + 8); } SEAM(pb + 8);
        } else {
            REP(pb + 7) { if (IN(pb + 7)) { PHASE_BEGIN
#if MOE_FP8
                pg::SchedMoe<true> S; S.init(ws + WS_HX8, ws + WS_EGU, SZ_GU / 2, F.ctl + CW_CNT, (const int*)(ws + WS_LIST), NGU, D / 2, F.G, F.bid); S.sa = X8_E; S.sb = W8_E;
                pg::EpiSwiGLU8 E{ws + WS_P, DFF, H8_SCALE};
                pg::gemm_phase<pg::EpiSwiGLU8, pg::SchedMoe<true>, true, true, D / 2>(F.lds, F.tid, S, E);
#else
                pg::SchedMoe<true> S; S.init(ws + WS_HX, ws + WS_EGU, SZ_GU, F.ctl + CW_CNT, (const int*)(ws + WS_LIST), NGU, D, F.G, F.bid);
                pg::EpiSwiGLU E{(bf16*)(ws + WS_P), DFF};
                pg::gemm_phase<pg::EpiSwiGLU, pg::SchedMoe<true>, true>(F.lds, F.tid, S, E);
#endif
            } REPBAR(pb + 7); } SEAM(pb + 7);
            REP(pb + 8) { if (IN(pb + 8)) { PHASE_BEGIN
#if MOE_FP8
                pg::SchedMoe<false> S; S.init(ws + WS_P, ws + WS_EDN, SZ_DN / 2, F.ctl + CW_CNT, (const int*)(ws + WS_LIST), D, DFF / 2, F.G, F.bid); S.sa = H8_E; S.sb = W8_E;
                pg::EpiBf16 E{(bf16*)(ws + WS_LAF), D};
                pg::gemm_phase<pg::EpiBf16, pg::SchedMoe<false>, true, true, DFF / 2>(F.lds, F.tid, S, E);
#else
                pg::SchedMoe<false> S; S.init(ws + WS_P, ws + WS_EDN, SZ_DN, F.ctl + CW_CNT, (const int*)(ws + WS_LIST), D, DFF, F.G, F.bid);
                pg::EpiBf16 E{(bf16*)(ws + WS_LAF), D};
                pg::gemm_phase<pg::EpiBf16, pg::SchedMoe<false>, true>(F.lds, F.tid, S, E);
#endif
            } REPBAR(pb + 8); } SEAM(pb + 8);
        }
        REP(pb + 9) { if (IN(pb + 9)) { PHASE_BEGIN t5_phase(F, l); } REPBAR(pb + 9); } SEAM(pb + 9);
    }
#undef IN
#undef SEAM
}

extern "C" void kernel_launch(void* const* d_in, const int* in_sizes, int n_in, void* d_out, int out_size, void* d_ws, size_t ws_size, hipStream_t stream) {
    static int grid = 0;
    if (grid == 0) {
        if (n_in != 28 || in_sizes[0] != ML * D || out_size != ML * D || ws_size < WS_END) { fprintf(stderr, "kernel_launch: unexpected problem (n_in %d, in0 %d, out %d, ws %zu < %zu); nothing launched\n", n_in, n_in > 0 ? in_sizes[0] : -1, out_size, ws_size, (size_t)WS_END); grid = -1; return; }
        int dev = 0, cus = 0, per_cu = 0;
        if (hipGetDevice(&dev) != hipSuccess || hipDeviceGetAttribute(&cus, hipDeviceAttributeMultiprocessorCount, dev) != hipSuccess) { grid = -1; return; }
        if (hipFuncSetAttribute((const void*)fwd_kernel, hipFuncAttributeMaxDynamicSharedMemorySize, LDS_BYTES) != hipSuccess) { fprintf(stderr, "kernel_launch: hipFuncSetAttribute failed\n"); grid = -1; return; }
        if (hipOccupancyMaxActiveBlocksPerMultiprocessor(&per_cu, (const void*)fwd_kernel, 512, LDS_BYTES) != hipSuccess || per_cu < 1) fprintf(stderr, "kernel_launch: occupancy query reports %d\n", per_cu);
        (void)hipGetLastError();
        grid = cus;
    }
    if (grid < 0) return;
    if (hipMemsetAsync((char*)d_ws + WS_CTL, 0, CTL_ZERO_BYTES, stream) != hipSuccess) return;
    Args a{};
    for (int i = 0; i < 28; ++i) a.in[i] = (const float*)d_in[i];
    a.out = (float*)d_out; a.ws = (unsigned char*)d_ws;
#if MK_N_LAUNCHES == 1
    a.ph_lo = 0; a.ph_hi = NPH;
    hipLaunchKernelGGL(fwd_kernel, dim3(grid), dim3(512), LDS_BYTES, stream, a);
#else
    for (int p = 0; p < NPH; ++p) { a.ph_lo = p; a.ph_hi = p + 1; hipLaunchKernelGGL(fwd_kernel, dim3(grid), dim3(512), LDS_BYTES, stream, a); }
#endif
}
```

```cpp
#include <hip/hip_runtime.h>
#include <cstdio>
#include <cstdint>

#ifndef FAST_MIX
#define FAST_MIX 1
#endif
#ifndef MIXCHECK
#define MIXCHECK 0
#endif
#ifndef MIXCHECK_TOL
#define MIXCHECK_TOL 1e-3f
#endif
#ifndef PROBE_PARTS
#define PROBE_PARTS 3
#endif
#ifndef PROBE_MASK
#define PROBE_MASK 0u
#endif
#ifndef MOE_FP8
#define MOE_FP8 1
#endif
#ifndef DENSE_FP8
#define DENSE_FP8 2
#endif
#ifndef CTX_SPLIT
#define CTX_SPLIT 1
#endif
#ifndef MK_N_LAUNCHES
#define MK_N_LAUNCHES 1
#endif

#define LAS __attribute__((address_space(3)))
#define GAS __attribute__((address_space(1)))
typedef unsigned short bf16;
typedef short bf16x8 __attribute__((ext_vector_type(8)));
typedef float f32x4 __attribute__((ext_vector_type(4)));
typedef float f32x2 __attribute__((ext_vector_type(2)));
typedef unsigned u32x4 __attribute__((ext_vector_type(4)));
typedef unsigned u32x2 __attribute__((ext_vector_type(2)));
typedef int v4i_t __attribute__((ext_vector_type(4)));
typedef int v8i_t __attribute__((ext_vector_type(8)));

constexpr int D = 2048, NB = 2, SEQ = 4096, CTXL = 256, ML = NB * SEQ, MC = NB * CTXL, MT = ML + MC;
constexpr int DIN = 12832, NP = 13056;
constexpr int OQ = 0, OKK = 1024, OV = 2048, ORG = 4096, OAQ = 6144, OAK = 8192, OAV = 8448, OG9 = 8704, OG10 = 10752, OLR = 12800;
constexpr int DFF = 5632, NE = 8, NGU = 2 * DFF;
constexpr int GH = 4, GDK = 256, GDV = 512;
constexpr int AHQ = 32, AHKV = 4, AHD = 64, AWIN = 128;
constexpr float RMS_EPS = 1e-6f;
constexpr float W8_SCALE = 64.0f, X8_SCALE = 16.0f, H8_SCALE = 8.0f; constexpr int W8_E = 127 - 6, X8_E = 127 - 4, H8_E = 127 - 3;
constexpr int MOE_CAP = 8192;
constexpr int MOE_ROWS = 2 * ML + NE * 256;

constexpr size_t MiB = 1u << 20;
constexpr size_t WS_CTL = 0, CTL_ZERO_BYTES = 1 * MiB;
constexpr size_t WS_MOD = 1 * MiB;
constexpr size_t SZ_WIN = (size_t)NP * D * 2, SZ_WSQ = (size_t)D * D * 2, SZ_GU = (size_t)NGU * D * 2, SZ_DN = (size_t)D * DFF * 2;
constexpr size_t WS_WIN = 2 * MiB;
constexpr size_t WS_WBG = WS_WIN + 2 * SZ_WIN, WS_WBA = WS_WBG + 2 * SZ_WSQ, WS_WO = WS_WBA + 2 * SZ_WSQ;
constexpr size_t WS_FGU = WS_WO + 2 * SZ_WSQ, WS_FDN = WS_FGU + SZ_GU;
constexpr size_t WS_EGU = WS_FDN + SZ_DN, WS_EDN = WS_EGU + NE * SZ_GU;
constexpr size_t WS_WEND = WS_EDN + NE * SZ_DN;
constexpr size_t alignup(size_t x) { return (x + MiB - 1) / MiB * MiB; }
constexpr size_t WS_XS = alignup(WS_WEND);
constexpr size_t WS_HX = WS_XS + alignup((size_t)MT * D * 4);
constexpr size_t WS_P = WS_HX + alignup((size_t)MT * D * 2);
constexpr size_t SZ_P = alignup((size_t)MT * NP * 2);
static_assert((size_t)MOE_ROWS * DFF * 2 <= SZ_P, "H_moe overlays P");
constexpr size_t WS_LAF = WS_P + SZ_P;
constexpr size_t WS_LAB = WS_LAF + alignup((size_t)MT * 1024 * 4);
constexpr size_t WS_OF = WS_LAB + alignup((size_t)MT * 1024 * 4);
constexpr size_t WS_OB = WS_OF + alignup((size_t)MT * D * 4);
constexpr size_t WS_QR = WS_OB + alignup((size_t)MT * D * 4);
static_assert((size_t)MOE_ROWS * D * 4 <= WS_QR - WS_LAF, "YM overlays LA/OF/OB");
constexpr size_t WS_KR = WS_QR + alignup((size_t)MT * D * 2);
constexpr size_t WS_GX = WS_KR + alignup((size_t)MT * 256 * 2);
constexpr size_t WS_AX = WS_GX + alignup((size_t)MT * D * 2);
constexpr size_t WS_O1 = WS_AX + alignup((size_t)MT * D * 2);
constexpr size_t WS_Y = WS_O1 + alignup((size_t)MT * D * 2);
constexpr size_t WS_YP = WS_OF;
constexpr int YP_S3 = 8, YP_S5 = 11;
static_assert((size_t)YP_S5 * MC * D * 4 <= 2 * ((size_t)MT * D * 4), "YP fits OF|OB");
constexpr size_t WS_HX8 = WS_O1;
constexpr size_t WS_LIST = WS_Y + alignup((size_t)MT * D * 4);
constexpr size_t WS_TINFO = WS_LIST + (size_t)NE * MOE_CAP * 4;
constexpr int NIT = NB * GH * 68;
constexpr size_t WS_QIN = alignup(WS_TINFO + (size_t)ML * 8 * 4);
constexpr size_t SZ_QIN = (size_t)MT * 1024 * 2;
constexpr size_t WS_KTO = WS_QIN + alignup(2 * SZ_QIN);
constexpr size_t SZ_KTO = (size_t)NIT * 256 * 64 * 2;
constexpr size_t WS_AIN = WS_KTO + alignup(2 * SZ_KTO);
constexpr size_t SZ_AIN = (size_t)NIT * 64 * 64 * 2;
constexpr size_t WS_DEC = WS_AIN + alignup(2 * SZ_AIN);
constexpr size_t SZ_DEC = (size_t)NIT * 256 * 4;
constexpr size_t WS_VT = WS_DEC + alignup(2 * SZ_DEC);
constexpr size_t WS_VAT = WS_VT + alignup((size_t)NIT * 512 * 64 * 2);
constexpr size_t WS_CHK = WS_VAT + alignup((size_t)(MT / 64) * 4 * 64 * 64 * 2);
constexpr size_t WS_LRB = WS_CHK;
constexpr size_t SZ_LRB = (size_t)MT * 256 * 2;
constexpr size_t WS_END = WS_LRB + alignup(2 * SZ_LRB);
constexpr size_t WS_OF2 = WS_Y, WS_OB2 = WS_Y + alignup((size_t)MT * D * 2), WS_AX2 = WS_O1;
constexpr int CW_CNT = 64;
constexpr int CW_ROPE = 96;
constexpr int CW_CHK = 128;
constexpr int CW_BAR = 4096;

constexpr int RING_BYTES = 131072;
constexpr int MISC_OFF = 147456;
constexpr int LDS_BYTES = 151552;

__device__ __forceinline__ unsigned cvt_pk_bf16(float lo, float hi) { unsigned r; asm volatile("v_cvt_pk_bf16_f32 %0, %1, %2" : "=v"(r) : "v"(lo), "v"(hi)); return r; }
__device__ __forceinline__ bf16 f2bf(float f) { return (bf16)(cvt_pk_bf16(f, 0.f) & 0xffffu); }
__device__ __forceinline__ float bf2f(bf16 b) { return __uint_as_float(((unsigned)b) << 16); }
__device__ __forceinline__ float bflo(unsigned w) { return __uint_as_float(w << 16); }
__device__ __forceinline__ float bfhi(unsigned w) { return __uint_as_float(w & 0xffff0000u); }
__device__ __forceinline__ float wave_sum(float v) {
    v += __builtin_bit_cast(float, __builtin_amdgcn_update_dpp(0, __builtin_bit_cast(int, v), 0xB1, 0xF, 0xF, true));
    v += __builtin_bit_cast(float, __builtin_amdgcn_update_dpp(0, __builtin_bit_cast(int, v), 0x4E, 0xF, 0xF, true));
    v += __builtin_bit_cast(float, __builtin_amdgcn_update_dpp(0, __builtin_bit_cast(int, v), 0x124, 0xF, 0xF, true));
    v += __builtin_bit_cast(float, __builtin_amdgcn_update_dpp(0, __builtin_bit_cast(int, v), 0x128, 0xF, 0xF, true));
    auto a = __builtin_amdgcn_permlane16_swap(__float_as_uint(v), __float_as_uint(v), false, false); v = __uint_as_float(a[0]) + __uint_as_float(a[1]);
    auto b = __builtin_amdgcn_permlane32_swap(__float_as_uint(v), __float_as_uint(v), false, false); return __uint_as_float(b[0]) + __uint_as_float(b[1]);
}
__device__ __forceinline__ float sigmoidf_(float x) { return 1.0f / (1.0f + __expf(-x)); }
__device__ __forceinline__ float siluf_(float x) { return x / (1.0f + __expf(-x)); }
__device__ __forceinline__ float logsigf_(float z) { return fminf(z, 0.f) - log1pf(__expf(-fabsf(z))); }
__device__ __forceinline__ unsigned pk4_fp8(float a, float b, float c, float d) {
    a = __builtin_amdgcn_fmed3f(a, -448.f, 448.f); b = __builtin_amdgcn_fmed3f(b, -448.f, 448.f); c = __builtin_amdgcn_fmed3f(c, -448.f, 448.f); d = __builtin_amdgcn_fmed3f(d, -448.f, 448.f);
    int w = 0; w = __builtin_amdgcn_cvt_pk_fp8_f32(a, b, w, false); w = __builtin_amdgcn_cvt_pk_fp8_f32(c, d, w, true); return (unsigned)w; }
#define LDS_WAIT() asm volatile("s_waitcnt lgkmcnt(0)" ::: "memory")
#define VM_WAIT() asm volatile("s_waitcnt vmcnt(0)" ::: "memory")

namespace pg {
constexpr int BM = 256, BK = 64, HALF = 128, HTB = HALF * BK * 2, STAGE_BYTES = 8 * HTB, NXCD = 8, WGM = 8;
__host__ __device__ __forceinline__ int lds_byte(int r, int c) { const int st = (r >> 4) * 2 + (c >> 5), rr = r & 15, cc = c & 31, ob = rr * 64 + cc * 2; return st * 1024 + (ob ^ (((ob >> 9) & 1) << 5)); }
__host__ __device__ __forceinline__ void stage_rc(int b, int& R, int& C) { const int st = b / 1024, sb = b % 1024, swz = sb ^ (((sb >> 9) & 1) << 5); R = (st >> 1) * 16 + swz / 64; C = (st & 1) * 32 + (swz % 64) / 2; }
__host__ __device__ __forceinline__ int perm32(int rho) { const int n = rho >> 4, i = rho & 15; return 8 * (i >> 2) + 4 * n + (i & 3); }

struct Unit { int pm, pn, e, pl; };

__device__ __forceinline__ void tile_of(int L, int nM, int nN, int& pm, int& pn) {
    const int nwg = nM * nN; int wgid = L;
    { const int q = nwg / NXCD, r = nwg % NXCD, xcd = wgid % NXCD, off = wgid / NXCD; wgid = (xcd < r ? xcd * (q + 1) : r * (q + 1) + (xcd - r) * q) + off; }
    const int nig = WGM * nN, gid = wgid / nig, fm = gid * WGM, gsz = (nM - fm) < WGM ? (nM - fm) : WGM;
    pm = fm + ((wgid % nig) % gsz); pn = (wgid % nig) / gsz;
}
struct SchedDense {
    static constexpr bool GATHER = false;
    const char* A; const char* Bt; int K, nM, nN, nwg, G, c, nex, sa = 127, sb = 127;
    __device__ __forceinline__ void init(const void* A_, const void* Bt_, int M, int N, int K_, int G_, int c_, int nex_) { A = (const char*)A_; Bt = (const char*)Bt_; K = K_; nM = M / BM; nN = N / BM; nwg = nM * nN; G = G_; c = c_; nex = nex_; }
    __device__ __forceinline__ bool next(int i, Unit& u) const {
        const int L = i * G + c; u.e = 0; u.pl = 0;
        if (L < nwg) { tile_of(L, nM, nN, u.pm, u.pn); return true; }
        if (L < nwg + nex) { const int j = L - nwg, t = j % 15; u.pm = 32 + j / 15; u.pn = t < 12 ? 4 + t : (t < 14 ? 32 + (t - 12) : 50); return true; }
        return false;
    }
    __device__ __forceinline__ const char* a_base(const Unit& u) const { return A + (size_t)u.pm * BM * K * 2; }
    __device__ __forceinline__ const char* b_base(const Unit& u) const { return Bt + (size_t)u.pn * BM * K * 2; }
    __device__ __forceinline__ void a_offs(const Unit&, const int (&)[2], const int (&)[2], unsigned (&)[2][2]) const {}
    __device__ __forceinline__ int nt_of(const Unit&, int nt) const { return nt; }
};
struct SchedCtxSplit {
    static constexpr bool GATHER = false;
    const char* A; const char* Bt; int K, nN, G, c, S, nts, sa = 127, sb = 127;
    __device__ __forceinline__ void init(const void* A_, const void* Bt_, int N, int K_, int G_, int c_, int S_) { A = (const char*)A_; Bt = (const char*)Bt_; K = K_; nN = N / BM; G = G_; c = c_; S = S_; nts = K_ / BK / S_; }
    __device__ __forceinline__ bool next(int i, Unit& u) const {
        const int L = i * G + c, nlat = (ML / BM) * nN; u.pl = 0;
        if (L < nlat) { tile_of(L, ML / BM, nN, u.pm, u.pn); u.e = 0; return true; }
        const int j = L - nlat; if (j >= 2 * nN * S) return false;
        const int jt = j % (2 * nN); u.pm = ML / BM + jt / nN; u.pn = jt % nN; u.e = 1 + j / (2 * nN); return true;
    }
    __device__ __forceinline__ const char* a_base(const Unit& u) const { return A + (size_t)u.pm * BM * K * 2 + (u.e ? (size_t)(u.e - 1) * nts * BK * 2 : 0); }
    __device__ __forceinline__ const char* b_base(const Unit& u) const { return Bt + (size_t)u.pn * BM * K * 2 + (u.e ? (size_t)(u.e - 1) * nts * BK * 2 : 0); }
    __device__ __forceinline__ void a_offs(const Unit&, const int (&)[2], const int (&)[2], unsigned (&)[2][2]) const {}
    __device__ __forceinline__ int nt_of(const Unit& u, int nt) const { return u.e ? nts : nt; }
};
struct SchedBranch {
    static constexpr bool GATHER = false;
    const char *A0, *A1, *B0, *B1; int K, nM, nN, nwg, G, c; static constexpr int sa = 127, sb = 127;
    __device__ __forceinline__ void init(const void* a0, const void* a1, const void* b0, const void* b1, int M, int N, int K_, int G_, int c_) { A0 = (const char*)a0; A1 = (const char*)a1; B0 = (const char*)b0; B1 = (const char*)b1; K = K_; nM = M / BM; nN = N / BM; nwg = nM * nN; G = G_; c = c_; }
    __device__ __forceinline__ bool next(int i, Unit& u) const {
        const int L = (i >> 1) * G + c; if (L >= nwg) return false;
        tile_of(L, nM, nN, u.pm, u.pn); u.e = i & 1; u.pl = 0; return true;
    }
    __device__ __forceinline__ const char* a_base(const Unit& u) const { return (u.e ? A1 : A0) + (size_t)u.pm * BM * K * 2; }
    __device__ __forceinline__ const char* b_base(const Unit& u) const { return (u.e ? B1 : B0) + (size_t)u.pn * BM * K * 2; }
    __device__ __forceinline__ void a_offs(const Unit&, const int (&)[2], const int (&)[2], unsigned (&)[2][2]) const {}
    __device__ __forceinline__ int nt_of(const Unit&, int nt) const { return nt; }
};
template <bool GATHER_> struct SchedMoe {
    static constexpr bool GATHER = GATHER_;
    const char* A; const char* Bt; size_t bstride; const int* list; int K, nN, G, c, sa, sb;
    int cnt[NE], ub[NE + 1], pb[NE + 1];
    __device__ __forceinline__ void init(const void* A_, const void* Bt_, size_t bstride_, const unsigned* cntw, const int* list_, int N, int K_, int G_, int c_) {
        A = (const char*)A_; Bt = (const char*)Bt_; bstride = bstride_; list = list_; K = K_; nN = N / BM; G = G_; c = c_; ub[0] = 0; pb[0] = 0; sa = 127; sb = 127;
#pragma unroll
        for (int e = 0; e < NE; ++e) { int v = __builtin_amdgcn_readfirstlane((int)cntw[e]); v = v > MOE_CAP ? MOE_CAP : v; cnt[e] = v; const int np = (v + 255) >> 8; pb[e + 1] = pb[e] + np; ub[e + 1] = ub[e] + np * nN; }
    }
    __device__ __forceinline__ bool next(int i, Unit& u) const {
        const int L = i * G + c; if (L >= ub[NE]) return false;
        int e = 0, base = 0, pbase = 0, np = 1;
#pragma unroll
        for (int j = 0; j < NE; ++j) if (L >= ub[j] && L < ub[j + 1]) { e = j; base = ub[j]; pbase = pb[j]; np = pb[j + 1] - pb[j]; }
        const int r = L - base; u.e = e; u.pn = r / np; u.pl = r % np; u.pm = pbase + u.pl; return true;
    }
    __device__ __forceinline__ const char* a_base(const Unit& u) const { return GATHER ? A : A + (size_t)u.pm * BM * K * 2; }
    __device__ __forceinline__ const char* b_base(const Unit& u) const { return Bt + (size_t)u.e * bstride + (size_t)u.pn * BM * K * 2; }
    __device__ __forceinline__ int nt_of(const Unit&, int nt) const { return nt; }
    __device__ __forceinline__ void a_offs(const Unit& u, const int (&R)[2], const int (&C)[2], unsigned (&off)[2][2]) const {
        int n = 0;
#pragma unroll
        for (int j = 0; j < NE; ++j) if (u.e == j) n = cnt[j];
#pragma unroll
        for (int h = 0; h < 2; ++h)
#pragma unroll
            for (int i = 0; i < 2; ++i) { const int slot = u.pl * 256 + h * HALF + R[i]; const int tok = slot < n ? list[u.e * MOE_CAP + slot] : 0; off[h][i] = (unsigned)(tok * K + C[i]) * 2u; }
    }
};

struct EpiBf16 {
    static constexpr bool PERM = true;
    bf16* O; int ldc; int skip = 0;
    bf16* O2 = nullptr; int pn2 = -1;
    __device__ __forceinline__ bool keep(const Unit&) const { return false; }
    __device__ __forceinline__ void operator()(f32x4 (&acc)[2][2][4][2], const Unit& u, int wr, int wc, int fr, int fq) const {
        if (skip) { if (skip == 2 && acc[0][0][0][0][0] == 12345.678f) O[0] = 1; return; }
        const int row0 = u.pm * BM + wr * 64 + fr; int col0 = u.pn * BM + wc * 32 + 8 * fq;
        bf16* Ob = O; int ld = ldc;
        if (u.pn == pn2) { Ob = O2; ld = BM; col0 -= pn2 * BM; }
#pragma unroll
        for (int ai = 0; ai < 2; ++ai)
#pragma unroll
            for (int m = 0; m < 4; ++m) { bf16* rowp = Ob + (size_t)(row0 + ai * HALF + m * 16) * ld + col0;
#pragma unroll
                for (int bj = 0; bj < 2; ++bj) { const f32x4 v0 = acc[ai][bj][m][0], v1 = acc[ai][bj][m][1];
                    u32x4 w; w.x = cvt_pk_bf16(v0[0], v0[1]); w.y = cvt_pk_bf16(v0[2], v0[3]); w.z = cvt_pk_bf16(v1[0], v1[1]); w.w = cvt_pk_bf16(v1[2], v1[3]);
                    *(u32x4*)(rowp + bj * HALF) = w; } }
    }
};
struct EpiBf16Ctx {
    static constexpr bool PERM = true;
    bf16* O; float* YP; int ldc;
    __device__ __forceinline__ bool keep(const Unit&) const { return false; }
    __device__ __forceinline__ void operator()(f32x4 (&acc)[2][2][4][2], const Unit& u, int wr, int wc, int fr, int fq) const {
        const int row0 = u.pm * BM + wr * 64 + fr, col0 = u.pn * BM + wc * 32 + 8 * fq;
        if (u.e == 0) {
#pragma unroll
            for (int ai = 0; ai < 2; ++ai)
#pragma unroll
                for (int m = 0; m < 4; ++m) { bf16* rowp = O + (size_t)(row0 + ai * HALF + m * 16) * ldc + col0;
#pragma unroll
                    for (int bj = 0; bj < 2; ++bj) { const f32x4 v0 = acc[ai][bj][m][0], v1 = acc[ai][bj][m][1];
                        u32x4 w; w.x = cvt_pk_bf16(v0[0], v0[1]); w.y = cvt_pk_bf16(v0[2], v0[3]); w.z = cvt_pk_bf16(v1[0], v1[1]); w.w = cvt_pk_bf16(v1[2], v1[3]);
                        *(u32x4*)(rowp + bj * HALF) = w; } }
        } else {
            float* base = YP + (size_t)(u.e - 1) * MC * ldc;
#pragma unroll
            for (int ai = 0; ai < 2; ++ai)
#pragma unroll
                for (int m = 0; m < 4; ++m) { float* rowp = base + (size_t)(row0 - ML + ai * HALF + m * 16) * ldc + col0;
#pragma unroll
                    for (int bj = 0; bj < 2; ++bj) { *(f32x4*)(rowp + bj * HALF) = acc[ai][bj][m][0]; *(f32x4*)(rowp + bj * HALF + 4) = acc[ai][bj][m][1]; } }
        }
    }
};
struct EpiF32 {
    static constexpr bool PERM = false;
    float* Cp; int ldc;
    __device__ __forceinline__ bool keep(const Unit&) const { return false; }
    __device__ __forceinline__ void operator()(f32x4 (&acc)[2][2][4][2], const Unit& u, int wr, int wc, int fr, int fq) const {
        const int row0 = u.pm * BM + wr * 64 + fr, col0 = u.pn * BM + wc * 32 + 4 * fq;
#pragma unroll
        for (int ai = 0; ai < 2; ++ai)
#pragma unroll
            for (int m = 0; m < 4; ++m) { float* rowp = Cp + (size_t)(row0 + ai * HALF + m * 16) * ldc + col0;
#pragma unroll
                for (int bj = 0; bj < 2; ++bj)
#pragma unroll
                    for (int n = 0; n < 2; ++n) *(f32x4*)(rowp + bj * HALF + n * 16) = acc[ai][bj][m][n]; }
    }
};
struct EpiSwiGLU {
    static constexpr bool PERM = true;
    bf16* H; int ldh;
    __device__ __forceinline__ bool keep(const Unit&) const { return false; }
    __device__ __forceinline__ void operator()(f32x4 (&acc)[2][2][4][2], const Unit& u, int wr, int wc, int fr, int fq) const {
        const int row0 = u.pm * BM + wr * 64 + fr, col0 = u.pn * HALF + wc * 32 + 8 * fq;
#pragma unroll
        for (int ai = 0; ai < 2; ++ai)
#pragma unroll
            for (int m = 0; m < 4; ++m) { bf16* rowp = H + (size_t)(row0 + ai * HALF + m * 16) * ldh + col0;
                float o[8];
#pragma unroll
                for (int n = 0; n < 2; ++n)
#pragma unroll
                    for (int j = 0; j < 4; ++j) { const float g = acc[ai][0][m][n][j], up = acc[ai][1][m][n][j]; o[n * 4 + j] = g * __builtin_amdgcn_rcpf(1.0f + __expf(-g)) * up; }
                u32x4 w; w.x = cvt_pk_bf16(o[0], o[1]); w.y = cvt_pk_bf16(o[2], o[3]); w.z = cvt_pk_bf16(o[4], o[5]); w.w = cvt_pk_bf16(o[6], o[7]);
                *(u32x4*)rowp = w; }
    }
};
struct EpiSwiGLU8 {
    static constexpr bool PERM = true;
    unsigned char* H; int ldh; float oscale;
    __device__ __forceinline__ bool keep(const Unit&) const { return false; }
    __device__ __forceinline__ void operator()(f32x4 (&acc)[2][2][4][2], const Unit& u, int wr, int wc, int fr, int fq) const {
        const int row0 = u.pm * BM + wr * 64 + fr, col0 = u.pn * HALF + wc * 32 + 8 * fq;
#pragma unroll
        for (int ai = 0; ai < 2; ++ai)
#pragma unroll
            for (int m = 0; m < 4; ++m) { unsigned char* rowp = H + (size_t)(row0 + ai * HALF + m * 16) * ldh + col0;
                float o[8];
#pragma unroll
                for (int n = 0; n < 2; ++n)
#pragma unroll
                    for (int j = 0; j < 4; ++j) { const float g = acc[ai][0][m][n][j], up = acc[ai][1][m][n][j]; o[n * 4 + j] = g * __builtin_amdgcn_rcpf(1.0f + __expf(-g)) * up * oscale; }
                u32x2 w; w.x = pk4_fp8(o[0], o[1], o[2], o[3]); w.y = pk4_fp8(o[4], o[5], o[6], o[7]);
                *(u32x2*)rowp = w; }
    }
};
struct EpiBranch {
    static constexpr bool PERM = true;
    const bf16* P; bf16* O; int ldc;
    __device__ __forceinline__ bool keep(const Unit& u) const { return u.e == 0; }
    __device__ __forceinline__ void operator()(f32x4 (&acc)[2][2][4][2], const Unit& u, int wr, int wc, int fr, int fq) const {
        const int row0 = u.pm * BM + wr * 64 + fr, col0 = u.pn * BM + wc * 32 + 8 * fq;
#pragma unroll
        for (int ai = 0; ai < 2; ++ai)
#pragma unroll
            for (int m = 0; m < 4; ++m) { const size_t row = (size_t)(row0 + ai * HALF + m * 16);
#pragma unroll
                for (int bj = 0; bj < 2; ++bj) {
                    const u32x4 g10 = *(const u32x4*)(P + row * NP + OG10 + col0 + bj * HALF);
                    float s[8]; s[0] = bflo(g10.x); s[1] = bfhi(g10.x); s[2] = bflo(g10.y); s[3] = bfhi(g10.y); s[4] = bflo(g10.z); s[5] = bfhi(g10.z); s[6] = bflo(g10.w); s[7] = bfhi(g10.w);
                    if (u.e == 0) {
                        const u32x4 g9 = *(const u32x4*)(P + row * NP + OG9 + col0 + bj * HALF);
                        float t[8]; t[0] = bflo(g9.x); t[1] = bfhi(g9.x); t[2] = bflo(g9.y); t[3] = bfhi(g9.y); t[4] = bflo(g9.z); t[5] = bfhi(g9.z); t[6] = bflo(g9.w); t[7] = bfhi(g9.w);
#pragma unroll
                        for (int j = 0; j < 8; ++j) { const float f = (1.0f + __expf(-s[j])) / (1.0f + __expf(-t[j])); acc[ai][bj][m][j >> 2][j & 3] *= f; }
                    } else {
                        float o[8];
#pragma unroll
                        for (int j = 0; j < 8; ++j) o[j] = acc[ai][bj][m][j >> 2][j & 3] / (1.0f + __expf(-s[j]));
                        u32x4 w; w.x = cvt_pk_bf16(o[0], o[1]); w.y = cvt_pk_bf16(o[2], o[3]); w.z = cvt_pk_bf16(o[4], o[5]); w.w = cvt_pk_bf16(o[6], o[7]);
                        *(u32x4*)(O + row * ldc + col0 + bj * HALF) = w;
                    } } }
    }
};

template <class Epi, class Sched, bool ALIGN_EPI, bool FP8 = false, int KC = 0>
__device__ __forceinline__ void gemm_phase(LAS unsigned char* lds, const int tid, const Sched& S, const Epi& E) {
    const int wid = __builtin_amdgcn_readfirstlane(tid >> 6), lane = tid & 63, wr = wid >> 2, wc = wid & 3, fr = lane & 15, fq = lane >> 4;
    const int K = KC ? KC : S.K, nt = K / BK;
    int Rr[2], Cc[2]; unsigned voffA[2], voffB[2];
#pragma unroll
    for (int i = 0; i < 2; ++i) { stage_rc(tid * 16 + i * 8192, Rr[i], Cc[i]); const int Rb = Epi::PERM ? ((Rr[i] & ~31) + perm32(Rr[i] & 31)) : Rr[i];
        voffA[i] = (unsigned)(Rr[i] * K + Cc[i]) * 2u; voffB[i] = (unsigned)(Rb * K + Cc[i]) * 2u; }
    const size_t kstep = (size_t)(BK * 2);
    const size_t hstep = (size_t)HALF * K * 2;
    const unsigned ldsw = (unsigned)wid * 1024u;
    const int aoff = lds_byte(wr * 64 + fr, fq * 8), boff = lds_byte(wc * 32 + fr, fq * 8);
    unsigned gA[2][2] = {{0u, 0u}, {0u, 0u}}, gN[2][2] = {{0u, 0u}, {0u, 0u}};
#define PG_SA(b, h) (((b) * 2 + (h)) * HTB)
#define PG_SB(b, h) ((4 + (b) * 2 + (h)) * HTB)
#define PG_STAGE_B(bufoff, gbase) do { _Pragma("unroll") for (int _i = 0; _i < 2; ++_i) \
        __builtin_amdgcn_global_load_lds((const unsigned*)((const char*)(gbase) + voffB[_i]), (LAS unsigned*)(lds + (bufoff) + ldsw + _i * 8192), 16, 0, 0); } while (0)
#define PG_STAGE_A(bufoff, kptr, h, usenext) do { _Pragma("unroll") for (int _i = 0; _i < 2; ++_i) { \
        const char* _p; if constexpr (Sched::GATHER) _p = (const char*)(kptr) + ((usenext) ? gN[h][_i] : gA[h][_i]); else _p = (const char*)(kptr) + (h) * hstep + voffA[_i]; \
        __builtin_amdgcn_global_load_lds((const unsigned*)_p, (LAS unsigned*)(lds + (bufoff) + ldsw + _i * 8192), 16, 0, 0); } } while (0)
#define PG_LDA(dst, b, h) do { if constexpr (FP8) { _Pragma("unroll") for (int m = 0; m < 4; ++m) { const v4i_t lo_ = *(const LAS v4i_t*)(lds + PG_SA(b, h) + aoff + m * 2048), hi_ = *(const LAS v4i_t*)(lds + PG_SA(b, h) + aoff + m * 2048 + 1024); \
            dst##8[m] = __builtin_shufflevector(lo_, hi_, 0, 1, 2, 3, 4, 5, 6, 7); } } \
        else { _Pragma("unroll") for (int m = 0; m < 4; ++m) _Pragma("unroll") for (int k = 0; k < 2; ++k) dst[m][k] = *(const LAS bf16x8*)(lds + PG_SA(b, h) + aoff + m * 2048 + k * 1024); } } while (0)
#define PG_LDB(dst, b, h) do { if constexpr (FP8) { _Pragma("unroll") for (int n = 0; n < 2; ++n) { const v4i_t lo_ = *(const LAS v4i_t*)(lds + PG_SB(b, h) + boff + n * 2048), hi_ = *(const LAS v4i_t*)(lds + PG_SB(b, h) + boff + n * 2048 + 1024); \
            dst##8[n] = __builtin_shufflevector(lo_, hi_, 0, 1, 2, 3, 4, 5, 6, 7); } } \
        else { _Pragma("unroll") for (int n = 0; n < 2; ++n) _Pragma("unroll") for (int k = 0; k < 2; ++k) dst[n][k] = *(const LAS bf16x8*)(lds + PG_SB(b, h) + boff + n * 2048 + k * 1024); } } while (0)
#define PG_MMA(ai, bj, At, Bt) do { __builtin_amdgcn_s_setprio(1); _Pragma("unroll") for (int m = 0; m < 4; ++m) _Pragma("unroll") for (int n = 0; n < 2; ++n) { \
        if constexpr (FP8) { asm volatile("v_mfma_scale_f32_16x16x128_f8f6f4 %0, %1, %2, %0, %3, %4 op_sel_hi:[0,0,0]" : "+v"(acc[ai][bj][m][n]) : "v"(Bt##8[n]), "v"(At##8[m]), "v"(vsb), "v"(vsa)); } \
        else { _Pragma("unroll") for (int k = 0; k < 2; ++k) acc[ai][bj][m][n] = __builtin_amdgcn_mfma_f32_16x16x32_bf16(Bt[n][k], At[m][k], acc[ai][bj][m][n], 0, 0, 0); } } \
        __builtin_amdgcn_s_setprio(0); } while (0)
#define PG_WAIT_V(n) asm volatile("s_waitcnt vmcnt(" #n ")" ::: "memory")
#define PG_WAIT_L(n) asm volatile("s_waitcnt lgkmcnt(" #n ")" ::: "memory")
#define PG_BAR __builtin_amdgcn_s_barrier()
#define PG_SCHED __builtin_amdgcn_sched_barrier(0)
    Unit cur, nxt; int ui = 0;
    if (!S.next(0, cur)) return;
    f32x4 acc[2][2][4][2];
#pragma unroll
    for (int a = 0; a < 2; ++a)
#pragma unroll
        for (int b = 0; b < 2; ++b)
#pragma unroll
            for (int m = 0; m < 4; ++m)
#pragma unroll
                for (int n = 0; n < 2; ++n) acc[a][b][m][n] = (f32x4){0.f, 0.f, 0.f, 0.f};
    bf16x8 At[4][2], B0[2][2], B1[2][2]; v8i_t At8[4], B08[2], B18[2];
    const int vsa = S.sa, vsb = S.sb; (void)vsa; (void)vsb;
    const char* cA = S.a_base(cur); const char* cB = S.b_base(cur);
    if constexpr (Sched::GATHER) S.a_offs(cur, Rr, Cc, gA);
    PG_STAGE_B(PG_SB(0, 0), cB); PG_STAGE_B(PG_SB(0, 1), cB + hstep); PG_STAGE_A(PG_SA(0, 0), cA, 0, false); PG_STAGE_A(PG_SA(0, 1), cA, 1, false);
    if (wr == 1) PG_BAR;
    PG_WAIT_V(2); PG_BAR;
    PG_STAGE_B(PG_SB(1, 0), cB + kstep); PG_STAGE_A(PG_SA(1, 0), cA + kstep, 0, false); PG_STAGE_B(PG_SB(1, 1), cB + hstep + kstep);
    PG_WAIT_V(6); PG_BAR;
    for (;;) {
        const bool has_next = S.next(ui + 1, nxt);
        const char* nA = has_next ? S.a_base(nxt) : cA; const char* nB = has_next ? S.b_base(nxt) : cB;
        if constexpr (Sched::GATHER) { if (has_next) S.a_offs(nxt, Rr, Cc, gN); else { gN[0][0] = gA[0][0]; gN[0][1] = gA[0][1]; gN[1][0] = gA[1][0]; gN[1][1] = gA[1][1]; } }
        const int ntc = S.nt_of(cur, nt);
        for (int t = 0; t < ntc; t += 2) {
            const bool last = (t == ntc - 2);
            const char* a1 = cA + (size_t)(t + 1) * kstep;
            const char* a2 = last ? nA : cA + (size_t)(t + 2) * kstep; const char* b2 = last ? nB : cB + (size_t)(t + 2) * kstep;
            const char* a3 = a2 + kstep; const char* b3 = b2 + kstep;
            PG_LDB(B0, 0, 0); PG_LDB(B1, 0, 1); PG_SCHED; PG_LDA(At, 0, 0); PG_STAGE_A(PG_SA(1, 1), a1, 1, false);
            PG_WAIT_V(8); PG_WAIT_L(0); PG_BAR; PG_MMA(0, 0, At, B0); PG_MMA(0, 1, At, B1); PG_BAR; PG_SCHED;
            PG_LDA(At, 0, 1); PG_STAGE_B(PG_SB(0, 0), b2); PG_STAGE_B(PG_SB(0, 1), b2 + hstep); PG_STAGE_A(PG_SA(0, 0), a2, 0, last);
            PG_WAIT_V(8); PG_WAIT_L(0); PG_BAR; PG_MMA(1, 0, At, B0); PG_MMA(1, 1, At, B1); PG_BAR; PG_SCHED;
            PG_LDB(B0, 1, 0); PG_LDB(B1, 1, 1); PG_SCHED; PG_LDA(At, 1, 0); PG_STAGE_A(PG_SA(0, 1), a2, 1, last);
            PG_WAIT_V(8); PG_WAIT_L(0); PG_BAR; PG_MMA(0, 0, At, B0); PG_MMA(0, 1, At, B1); PG_BAR; PG_SCHED;
            PG_LDA(At, 1, 1); PG_STAGE_B(PG_SB(1, 0), b3); PG_STAGE_B(PG_SB(1, 1), b3 + hstep); PG_STAGE_A(PG_SA(1, 0), a3, 0, last);
            PG_WAIT_V(8); PG_WAIT_L(0); PG_BAR; PG_MMA(1, 0, At, B0); PG_MMA(1, 1, At, B1); PG_BAR; PG_SCHED;
        }
        if constexpr (ALIGN_EPI) { if (wr == 0) PG_BAR; }
        if constexpr (FP8) asm volatile("s_nop 15\n\ts_nop 15\n\ts_nop 15\n\ts_nop 15" ::: "memory");
        E(acc, cur, wr, wc, fr, fq);
        if (!has_next) break;
        if (!E.keep(cur)) {
#pragma unroll
            for (int a = 0; a < 2; ++a)
#pragma unroll
                for (int b = 0; b < 2; ++b)
#pragma unroll
                    for (int m = 0; m < 4; ++m)
#pragma unroll
                        for (int n = 0; n < 2; ++n) acc[a][b][m][n] = (f32x4){0.f, 0.f, 0.f, 0.f};
        }
        cur = nxt; cA = nA; cB = nB; ++ui;
        if constexpr (Sched::GATHER) { gA[0][0] = gN[0][0]; gA[0][1] = gN[0][1]; gA[1][0] = gN[1][0]; gA[1][1] = gN[1][1]; }
        if constexpr (ALIGN_EPI) { if (wr == 1) PG_BAR; }
    }
    PG_WAIT_V(0);
    if constexpr (!ALIGN_EPI) { if (wr == 0) PG_BAR; }
    PG_BAR;
#undef PG_SA
#undef PG_SB
#undef PG_STAGE_A
#undef PG_STAGE_B
#undef PG_LDA
#undef PG_LDB
#undef PG_MMA
#undef PG_WAIT_V
#undef PG_WAIT_L
#undef PG_BAR
#undef PG_SCHED
}
}

#define XB_TMO      128
#define XB_XCNT(j)  (256  + 64 * (j))
#define XB_XSUB(j)  (1280 + 64 * (j))
#define XB_XGEN(j)  (2304 + 64 * (j))
#define XB_TOP      3328
#define XB_TOPGEN   3392
#define XCD_BAR_WORDS 3456
#define XB_SPIN_CAP (1u << 18)
__device__ __forceinline__ unsigned xb_ld(unsigned* p)              { return __hip_atomic_load(p, __ATOMIC_RELAXED, __HIP_MEMORY_SCOPE_AGENT); }
__device__ __forceinline__ unsigned xb_add(unsigned* p, unsigned v) { return __hip_atomic_fetch_add(p, v, __ATOMIC_RELAXED, __HIP_MEMORY_SCOPE_AGENT); }
__device__ __forceinline__ unsigned xb_xcc_id() { return (unsigned)__builtin_amdgcn_s_getreg((3 << 11) | 20) & 0xFu; }
#define XB_SPIN(cond, bar) do { unsigned _sp = 0; while (cond) { __builtin_amdgcn_s_sleep(1); \
    if ((++_sp & 255u) == 0u) { if (xb_ld(&(bar)[XB_TMO])) break; if (_sp > XB_SPIN_CAP) { atomicAdd(&(bar)[XB_TMO], 1u); break; } } } } while (0)
struct XcdBarrier { unsigned* bar; unsigned x; volatile LAS unsigned* st; };
__device__ __forceinline__ XcdBarrier xcd_barrier_post(unsigned* bar, volatile LAS unsigned* st) {
    XcdBarrier b; b.bar = bar; b.x = xb_xcc_id(); b.st = st;
    if (threadIdx.x == 0) (void)xb_add(&bar[XB_XCNT(b.x)], 1u);
    return b;
}
__device__ __forceinline__ void xcd_barrier_complete(unsigned* bar, unsigned x, unsigned& nloc, unsigned& nx) {
    const unsigned G = gridDim.x * gridDim.y * gridDim.z;
    unsigned sum, cnt, mine, sp = 0u;
    for (;;) {
        sum = 0u; cnt = 0u; mine = 0u;
#pragma unroll
        for (unsigned j = 0; j < 16; ++j) { const unsigned c = xb_ld(&bar[XB_XCNT(j)]); sum += c; cnt += (c > 0u) ? 1u : 0u; mine = (j == x) ? c : mine; }
        if (sum == G) break;
        __builtin_amdgcn_s_sleep(1);
        if ((++sp & 255u) == 0u) { if (xb_ld(&bar[XB_TMO])) break; if (sp > XB_SPIN_CAP) { atomicAdd(&bar[XB_TMO], 1u); break; } }
    }
    nloc = mine > 0u ? mine : 1u; nx = cnt > 0u ? cnt : 1u;
}
__device__ __forceinline__ void xcd_barrier(const XcdBarrier& b) {
    asm volatile("s_waitcnt vmcnt(0)" ::: "memory");
    __syncthreads();
    if (threadIdx.x == 0) {
        unsigned* bar = b.bar;
        __builtin_amdgcn_s_waitcnt(0);
        unsigned nloc = b.st[0], nx = b.st[1];
        if (nloc == 0u) { xcd_barrier_complete(bar, b.x, nloc, nx); b.st[0] = nloc; b.st[1] = nx; }
        const unsigned old = xb_add(&bar[XB_XSUB(b.x)], 1u);
        const unsigned gen = old / nloc;
        if (old + 1u == (gen + 1u) * nloc) {
            __builtin_amdgcn_fence(__ATOMIC_RELEASE, "agent");
            asm volatile("s_waitcnt vmcnt(0)" ::: "memory");
            const unsigned og = xb_add(&bar[XB_TOP], 1u);
            const unsigned tg = og / nx;
            if (og + 1u == (tg + 1u) * nx) xb_add(&bar[XB_TOPGEN], 1u);
            else XB_SPIN(xb_ld(&bar[XB_TOPGEN]) == tg, bar);
            __builtin_amdgcn_fence(__ATOMIC_ACQUIRE, "agent");
            xb_add(&bar[XB_XGEN(b.x)], 1u);
            asm volatile("s_waitcnt vmcnt(0)" ::: "memory");
        } else {
            XB_SPIN(xb_ld(&bar[XB_XGEN(b.x)]) == gen, bar);
            __builtin_amdgcn_fence(__ATOMIC_ACQUIRE, "agent");
            asm volatile("s_waitcnt vmcnt(0)" ::: "memory");
        }
    }
    __syncthreads();
}

typedef const float* cfp_t; typedef const __attribute__((address_space(4))) cfp_t* in_table_t;
#define INP(i) ((const float*)(const GAS float*)F.in[i])
struct Frame {
    LAS unsigned char* lds;
    unsigned* ctl;
    int tid, lane, wave, vcu, G, bid;
    in_table_t in;
    float* out; unsigned char* ws;
};
enum { I_X = 0, I_C, I_CTX, I_CCTX, I_WMOD, I_BMOD, I_GPREMIX, I_GPOSTMIX, I_GPREFFN, I_GPOSTFFN, I_WIN, I_WLRF, I_BLRF, I_WLRB, I_BLRB, I_GGLA, I_SINK, I_WBRG, I_WBRA, I_WOUT,
       I_WFG, I_WFU, I_WFD, I_WROUTER, I_BROUTER, I_WEG, I_WEU, I_WED };

__device__ __forceinline__ void tr_item(const float* src  , int ldw, bf16* dst  , int K, LAS float* scr, int lane, bool zero) {
    if (zero) {
#pragma unroll
        for (int j = 0; j < 4; ++j) { const int n = (lane >> 3) + 8 * j; *(GAS u32x4*)(dst + (size_t)n * K + 8 * (lane & 7)) = (u32x4){0u, 0u, 0u, 0u}; }
        return;
    }
#pragma unroll
    for (int i = 0; i < 32; ++i) { const int kk = 2 * i + (lane >> 5); scr[kk * 33 + (lane & 31)] = __builtin_nontemporal_load(src + (size_t)kk * ldw + (lane & 31)); }
    LDS_WAIT(); asm volatile("" ::: "memory");
    const int c = lane & 7;
#pragma unroll
    for (int j = 0; j < 4; ++j) { const int n = (lane >> 3) + 8 * j; const LAS float* s = scr + (8 * c) * 33 + n;
        u32x4 o; o.x = cvt_pk_bf16(s[0 * 33], s[1 * 33]); o.y = cvt_pk_bf16(s[2 * 33], s[3 * 33]); o.z = cvt_pk_bf16(s[4 * 33], s[5 * 33]); o.w = cvt_pk_bf16(s[6 * 33], s[7 * 33]);
        *(GAS u32x4*)(dst + (size_t)n * K + 8 * c) = o; }
    LDS_WAIT(); asm volatile("" ::: "memory");
}
__device__ __forceinline__ void tr_plain(const float* W, int K, int N, bf16* WT, LAS float* scr, int item, int lane) {
    const int nblk = N / 32, kb = item / nblk, nb = item % nblk;
    tr_item(W + (size_t)(64 * kb) * N + 32 * nb, N, WT + (size_t)(32 * nb) * K + 64 * kb, K, scr, lane, false);
}
__device__ __forceinline__ void tr_win(const float* W, bf16* WT, LAS float* scr, int item, int lane) {
    const int nblk = NP / 32, kb = item / nblk, nb = item % nblk, n0 = 32 * nb;
    int ns; bool zero = false;
    if (n0 < 6144) ns = n0; else if (n0 < 12800) ns = n0 + 32; else if (n0 == 12800) ns = 6144; else { ns = 0; zero = true; }
    tr_item(W + (size_t)(64 * kb) * DIN + ns, DIN, WT + (size_t)n0 * D + 64 * kb, D, scr, lane, zero);
}
__device__ __forceinline__ void tr_gu(const float* Wg, const float* Wu, bf16* WT, LAS float* scr, int item, int lane) {
    const int nblk = NGU / 32, kb = item / nblk, nb = item % nblk, n0 = 32 * nb, tile = n0 >> 8, w = n0 & 255;
    const float* W = (w < 128) ? Wg : Wu; const int ns = tile * 128 + (w & 127);
    tr_item(W + (size_t)(64 * kb) * DFF + ns, DFF, WT + (size_t)n0 * D + 64 * kb, D, scr, lane, false);
}
__device__ __forceinline__ void tr_item8(const float* src, int ldw, unsigned char* dst  , int Kb, LAS float* scr, int lane, float scale) {
#pragma unroll
    for (int i = 0; i < 32; ++i) { const int kk = 2 * i + (lane >> 5); scr[kk * 33 + (lane & 31)] = __builtin_nontemporal_load(src + (size_t)kk * ldw + (lane & 31)); }
    LDS_WAIT(); asm volatile("" ::: "memory");
    const int c = lane & 3;
#pragma unroll
    for (int j = 0; j < 2; ++j) { const int n = (lane >> 2) + 16 * j; const LAS float* sp = scr + (16 * c) * 33 + n;
        u32x4 o; o.x = pk4_fp8(sp[0 * 33] * scale, sp[1 * 33] * scale, sp[2 * 33] * scale, sp[3 * 33] * scale); o.y = pk4_fp8(sp[4 * 33] * scale, sp[5 * 33] * scale, sp[6 * 33] * scale, sp[7 * 33] * scale);
        o.z = pk4_fp8(sp[8 * 33] * scale, sp[9 * 33] * scale, sp[10 * 33] * scale, sp[11 * 33] * scale); o.w = pk4_fp8(sp[12 * 33] * scale, sp[13 * 33] * scale, sp[14 * 33] * scale, sp[15 * 33] * scale);
        *(GAS u32x4*)(dst + (size_t)n * Kb + 16 * c) = o; }
    LDS_WAIT(); asm volatile("" ::: "memory");
}
__device__ __forceinline__ void tr_plain8(const float* W, int K, int N, unsigned char* WT, LAS float* scr, int item, int lane, float scale) {
    const int nblk = N / 32, kb = item / nblk, nb = item % nblk;
    tr_item8(W + (size_t)(64 * kb) * N + 32 * nb, N, WT + (size_t)(32 * nb) * K + 64 * kb, K, scr, lane, scale);
}
__device__ __forceinline__ void tr_gu8(const float* Wg, const float* Wu, unsigned char* WT, LAS float* scr, int item, int lane, float scale) {
    const int nblk = NGU / 32, kb = item / nblk, nb = item % nblk, n0 = 32 * nb, tile = n0 >> 8, w = n0 & 255;
    const float* W = (w < 128) ? Wg : Wu; const int ns = tile * 128 + (w & 127);
    tr_item8(W + (size_t)(64 * kb) * DFF + ns, DFF, WT + (size_t)n0 * D + 64 * kb, D, scr, lane, scale);
}
constexpr int IT_WIN = (D / 64) * (NP / 32), IT_SQ = (D / 64) * (D / 32), IT_GU = (D / 64) * (NGU / 32), IT_DN = (DFF / 64) * (D / 32);
constexpr int CV_A = 0, CV_B = CV_A + IT_WIN, CV_C = CV_B + 3 * IT_SQ, CV_D = CV_C + IT_GU + IT_DN, CV_E = CV_D + IT_WIN, CV_F = CV_E + 3 * IT_SQ, CV_END = CV_F + NE * (IT_GU + IT_DN);
constexpr int CVQ_MIX = 220;
constexpr int CV_MIX0 = CV_B, CV_MIX0_N = 192 * CVQ_MIX;
static_assert(CV_MIX0 + CV_MIX0_N >= CV_C && CV_MIX0 + CV_MIX0_N <= CV_F, "MIX(l0) covers B");
constexpr int CVQ_MIX1 = 300;
constexpr int CV_MIX1 = CV_F, CV_MIX1_N = 192 * CVQ_MIX1;
constexpr int CVX_MIX0 = 80;
constexpr int CV_MIX0X = CV_MIX1 + CV_MIX1_N, CV_MIX0X_N = 192 * CVX_MIX0;
constexpr int CVQ_G2 = 0;
constexpr int CV_G2 = CV_MIX0X + CV_MIX0X_N, CV_G2_N = 240 * CVQ_G2;
constexpr int CV_P0X = CV_MIX0 + CV_MIX0_N, CV_P0F = CV_G2 + CV_G2_N;
static_assert(CV_P0F <= CV_END, "conversion plan");

#define INPX(i) ((const float*)(const GAS float*)in[i])
__device__ __noinline__ void tr_dispatch_nl(in_table_t in, GAS unsigned char* wsg, int lane, int it, LAS float* scr) {
    unsigned char* ws = (unsigned char*)wsg; int r = it;
    if (r < CV_B) { tr_win(INPX(I_WIN), (bf16*)(ws + WS_WIN), scr, r, lane); return; }
    if (r < CV_C) { r -= CV_B; const int which = r / IT_SQ; const float* srcw = which == 0 ? INPX(I_WBRG) : (which == 1 ? INPX(I_WBRA) : INPX(I_WOUT)); const size_t wso = which == 0 ? WS_WBG : (which == 1 ? WS_WBA : WS_WO);
        tr_plain(srcw, D, D, (bf16*)(ws + wso), scr, r % IT_SQ, lane); return; }
#if DENSE_FP8 == 1
    if (r < CV_D) { r -= CV_C; if (r < IT_GU) tr_gu8(INPX(I_WFG), INPX(I_WFU), ws + WS_FGU, scr, r, lane, W8_SCALE); else tr_plain8(INPX(I_WFD), DFF, D, ws + WS_FDN, scr, r - IT_GU, lane, W8_SCALE); return; }
#elif DENSE_FP8 == 2
    if (r < CV_D) { r -= CV_C; if (r < IT_GU) tr_gu8(INPX(I_WFG), INPX(I_WFU), ws + WS_FGU, scr, r, lane, W8_SCALE); else tr_plain(INPX(I_WFD), DFF, D, (bf16*)(ws + WS_FDN), scr, r - IT_GU, lane); return; }
#else
    if (r < CV_D) { r -= CV_C; if (r < IT_GU) tr_gu(INPX(I_WFG), INPX(I_WFU), (bf16*)(ws + WS_FGU), scr, r, lane); else tr_plain(INPX(I_WFD), DFF, D, (bf16*)(ws + WS_FDN), scr, r - IT_GU, lane); return; }
#endif
    if (r < CV_E) { tr_win(INPX(I_WIN) + (size_t)D * DIN, (bf16*)(ws + WS_WIN + SZ_WIN), scr, r - CV_D, lane); return; }
    if (r < CV_F) { r -= CV_E; const int which = r / IT_SQ; const float* srcw = (which == 0 ? INPX(I_WBRG) : (which == 1 ? INPX(I_WBRA) : INPX(I_WOUT))) + (size_t)D * D; const size_t wso = (which == 0 ? WS_WBG : (which == 1 ? WS_WBA : WS_WO)) + SZ_WSQ;
        tr_plain(srcw, D, D, (bf16*)(ws + wso), scr, r % IT_SQ, lane); return; }
    { r -= CV_F; const int per = IT_GU + IT_DN, e = r / per, q = r % per;
#if MOE_FP8
        if (q < IT_GU) tr_gu8(INPX(I_WEG) + (size_t)e * D * DFF, INPX(I_WEU) + (size_t)e * D * DFF, ws + WS_EGU + e * (SZ_GU / 2), scr, q, lane, W8_SCALE);
        else tr_plain8(INPX(I_WED) + (size_t)e * DFF * D, DFF, D, ws + WS_EDN + e * (SZ_DN / 2), scr, q - IT_GU, lane, W8_SCALE); }
#else
        if (q < IT_GU) tr_gu(INPX(I_WEG) + (size_t)e * D * DFF, INPX(I_WEU) + (size_t)e * D * DFF, (bf16*)(ws + WS_EGU + e * SZ_GU), scr, q, lane);
        else tr_plain(INPX(I_WED) + (size_t)e * DFF * D, DFF, D, (bf16*)(ws + WS_EDN + e * SZ_DN), scr, q - IT_GU, lane); }
#endif
}
#undef INPX
__device__ __forceinline__ void tr_dispatch(Frame& F, int it, LAS float* scr) { tr_dispatch_nl(F.in, (GAS unsigned char*)F.ws, F.lane, it, scr); }
__device__ __forceinline__ void convert_range(Frame& F, int first, int n) {
    LAS float* scr = (LAS float*)(F.lds + F.wave * 16384);
    for (int i = F.wave; i < n; i += 8) tr_dispatch(F, first + i, scr);
}
__device__ __forceinline__ void p0_weights(Frame& F) {
    LAS float* scr = (LAS float*)(F.lds + F.wave * 16384);
    const int gw = F.vcu * 8 + F.wave, NGW = F.G * 8;
    if (F.G != 256) { for (int i = gw; i < CV_END; i += NGW) tr_dispatch(F, i, scr); return; }
    const int n1 = CV_B - CV_A, n2 = CV_F - CV_P0X, n3 = CV_END - CV_P0F;
    for (int i = gw; i < n1 + n2 + n3; i += NGW) tr_dispatch(F, i < n1 ? i : (i < n1 + n2 ? CV_P0X + (i - n1) : CV_P0F + (i - n1 - n2)), scr);
}
__device__ __forceinline__ void p0_mod(Frame& F) {
    LAS float* sc = (LAS float*)F.lds;
    LAS float* red = (LAS float*)(F.lds + 3 * D * 4);
    __syncthreads();
    for (int i = F.tid; i < 3 * D; i += 512) { const int r = i / D, k = i % D; const float v = r < 2 ? INP(I_C)[r * D + k] : INP(I_CCTX)[k]; sc[i] = siluf_(v); }
    __syncthreads();
    float* MOD = (float*)(F.ws + WS_MOD);
    const int col = F.lane & 31, kp = F.lane >> 5;
    for (int it = F.vcu; it < 2 * (6 * D / 32); it += F.G) {
        const int l = it / (6 * D / 32), n0 = (it % (6 * D / 32)) * 32;
        const float* W = INP(I_WMOD) + (size_t)l * D * 6 * D + n0 + col;
        float a0 = 0.f, a1 = 0.f, a2 = 0.f;
        const int kbase = F.wave * 256 + kp;
#pragma unroll 8
        for (int j = 0; j < 128; ++j) { const int k = kbase + 2 * j; const float w = W[(size_t)k * 6 * D]; a0 += sc[k] * w; a1 += sc[D + k] * w; a2 += sc[2 * D + k] * w; }
        const int slot = F.wave * 2 + kp;
        red[(slot * 3 + 0) * 32 + col] = a0; red[(slot * 3 + 1) * 32 + col] = a1; red[(slot * 3 + 2) * 32 + col] = a2;
        __syncthreads();
        if (F.tid < 96) { const int r = F.tid / 32, cc = F.tid % 32; float s = 0.f;
#pragma unroll
            for (int q = 0; q < 16; ++q) s += red[(q * 3 + r) * 32 + cc];
            MOD[((size_t)l * 3 + r) * 6 * D + n0 + cc] = s + INP(I_BMOD)[(size_t)l * 6 * D + n0 + cc]; }
        __syncthreads();
    }
}

struct Row { f32x4 v[8]; };
__device__ __forceinline__ void row_load(Row& r, const float* p, int lane) {
#pragma unroll
    for (int j = 0; j < 8; ++j) r.v[j] = *(const f32x4*)(p + 4 * lane + 256 * j);
}
__device__ __forceinline__ void row_load_bf16(Row& r, const bf16* p, int lane) {
#pragma unroll
    for (int j = 0; j < 8; ++j) { const u32x2 w = *(const u32x2*)(p + 4 * lane + 256 * j); r.v[j] = (f32x4){bflo(w.x), bfhi(w.x), bflo(w.y), bfhi(w.y)}; }
}
struct RowH { u32x2 v[8]; };
__device__ __forceinline__ void rowh_load(RowH& r, const bf16* p, int lane) {
#pragma unroll
    for (int j = 0; j < 8; ++j) r.v[j] = *(const u32x2*)(p + 4 * lane + 256 * j);
}
__device__ __forceinline__ void rowh_cvt(Row& o, const RowH& r) {
#pragma unroll
    for (int j = 0; j < 8; ++j) o.v[j] = (f32x4){bflo(r.v[j].x), bfhi(r.v[j].x), bflo(r.v[j].y), bfhi(r.v[j].y)};
}
__device__ __forceinline__ void row_touch(Row& r) { asm volatile("" : "+v"(r.v[0]), "+v"(r.v[1]), "+v"(r.v[2]), "+v"(r.v[3]), "+v"(r.v[4]), "+v"(r.v[5]), "+v"(r.v[6]), "+v"(r.v[7])); }
__device__ __forceinline__ void rowh_touch(RowH& r) { asm volatile("" : "+v"(r.v[0]), "+v"(r.v[1]), "+v"(r.v[2]), "+v"(r.v[3]), "+v"(r.v[4]), "+v"(r.v[5]), "+v"(r.v[6]), "+v"(r.v[7])); }
template <int S> __device__ __forceinline__ void row_sum_slices(Row& o, const float* p, size_t stride, int lane) {
    row_load(o, p, lane);
#pragma unroll
    for (int s0 = 1; s0 < S; s0 += 2) { Row t[2];
#pragma unroll
        for (int q = 0; q < 2; ++q) if (s0 + q < S) row_load(t[q], p + (size_t)(s0 + q) * stride, lane);
#pragma unroll
        for (int q = 0; q < 2; ++q) if (s0 + q < S) {
#pragma unroll
            for (int j = 0; j < 8; ++j) o.v[j] = o.v[j] + t[q].v[j]; } }
}
__device__ __forceinline__ float row_ss(const Row& r) {
    float s = 0.f;
#pragma unroll
    for (int j = 0; j < 8; ++j) s += (r.v[j][0] * r.v[j][0] + r.v[j][1] * r.v[j][1]) + (r.v[j][2] * r.v[j][2] + r.v[j][3] * r.v[j][3]);
    return wave_sum(s);
}
__device__ __forceinline__ int mod_row(int r) { return r < ML ? r / SEQ : 2; }
__device__ __forceinline__ void prenorm_store(const Row& x, Row& h, const float* g, const float* sc, const float* sh, bf16* hx, int lane, bool store = true) {
    const float rs = 1.0f / sqrtf(row_ss(x) * (1.0f / D) + RMS_EPS);
#pragma unroll
    for (int j = 0; j < 8; ++j) { const int o = 4 * lane + 256 * j; const f32x4 gg = *(const f32x4*)(g + o), s1 = *(const f32x4*)(sc + o), s0 = *(const f32x4*)(sh + o);
        h.v[j] = x.v[j] * rs * gg * (s1 + 1.0f) + s0;
        if (store) { u32x2 w; w.x = cvt_pk_bf16(h.v[j][0], h.v[j][1]); w.y = cvt_pk_bf16(h.v[j][2], h.v[j][3]); *(u32x2*)(hx + o) = w; } }
}
__device__ __forceinline__ const float* x_in_row(Frame& F, int r) { return r < ML ? INP(I_X) + (size_t)r * D : INP(I_CTX) + (size_t)(r - ML) * D; }

#define LV(i) ((const LAS float*)(F.lds) + (size_t)(i) * D)
__device__ __forceinline__ void stage_vec(Frame& F, int slot, const float* src) {
    LAS float* dst = (LAS float*)(F.lds) + (size_t)slot * D;
    *(LAS f32x4*)(dst + 4 * F.tid) = *(const f32x4*)(src + 4 * F.tid);
}
__device__ __forceinline__ void prenorm_store_l(const Row& x, Row& h, const LAS float* g, const LAS float* sc, const LAS float* sh, bf16* hx, int lane, bool store = true) {
    const float rs = 1.0f / sqrtf(row_ss(x) * (1.0f / D) + RMS_EPS);
#pragma unroll
    for (int j = 0; j < 8; ++j) { const int o = 4 * lane + 256 * j; const f32x4 gg = *(const LAS f32x4*)(g + o), s1 = *(const LAS f32x4*)(sc + o), s0 = *(const LAS f32x4*)(sh + o);
        h.v[j] = x.v[j] * rs * gg * (s1 + 1.0f) + s0;
        if (store) { u32x2 w; w.x = cvt_pk_bf16(h.v[j][0], h.v[j][1]); w.y = cvt_pk_bf16(h.v[j][2], h.v[j][3]); *(u32x2*)(hx + o) = w; } }
}
__device__ __forceinline__ void t1_phase(Frame& F) {
    const int gw = F.vcu * 8 + F.wave, NGW = F.G * 8;
    const float* MOD = (const float*)(F.ws + WS_MOD); bf16* HX = (bf16*)(F.ws + WS_HX);
    __syncthreads(); stage_vec(F, 0, INP(I_GPREMIX));
#pragma unroll
    for (int m = 0; m < 3; ++m) { stage_vec(F, 1 + 2 * m, MOD + (size_t)m * 6 * D + D); stage_vec(F, 2 + 2 * m, MOD + (size_t)m * 6 * D); }
    __syncthreads();
    Row xn; if (gw < MT) row_load(xn, x_in_row(F, gw), F.lane);
    for (int r = gw; r < MT; r += NGW) { Row x, h; row_touch(xn); x = xn; if (r + NGW < MT) row_load(xn, x_in_row(F, r + NGW), F.lane);
        const int m = mod_row(r);
        prenorm_store_l(x, h, LV(0), LV(1 + 2 * m), LV(2 + 2 * m), HX + (size_t)r * D, F.lane); }
}
__device__ __forceinline__ void t3_phase(Frame& F, int l) {
    const int gw = F.vcu * 8 + F.wave, NGW = F.G * 8, rows = (l == 0) ? MT : ML;
    const float* MODL = (const float*)(F.ws + WS_MOD) + (size_t)l * 3 * 6 * D; bf16* HX = (bf16*)(F.ws + WS_HX); float* XS = (float*)(F.ws + WS_XS); const bf16* Y = (const bf16*)(F.ws + WS_Y);
    const float* gpost = INP(I_GPOSTMIX) + l * D; const float* gpre = INP(I_GPREFFN) + l * D;
    volatile LAS unsigned* lcnt = (volatile LAS unsigned*)(F.lds + MISC_OFF + 64); volatile LAS unsigned* lbase = lcnt + 8; LAS int* rinfo = (LAS int*)(F.lds + 131072 + F.wave * 1024);
    __syncthreads();
    stage_vec(F, 0, gpost); stage_vec(F, 1, gpre);
#pragma unroll
    for (int m = 0; m < 3; ++m) if (l == 0 || m < 2) { stage_vec(F, 2 + 3 * m, MODL + (size_t)m * 6 * D + 2 * D); stage_vec(F, 3 + 3 * m, MODL + (size_t)m * 6 * D + 4 * D); stage_vec(F, 4 + 3 * m, MODL + (size_t)m * 6 * D + 3 * D); }
    if (l == 1) { if (F.tid < 16) lcnt[F.tid] = 0u;
        const float* wr = INP(I_WROUTER); LAS float* wt = (LAS float*)(F.lds) + (size_t)8 * D;
#pragma unroll
        for (int q = 0; q < 8; ++q) { const int i4 = (F.tid + 512 * q) * 4; const f32x4 v = *(const f32x4*)(wr + i4); const int d = i4 >> 3, e0 = i4 & 7;
            wt[(e0 + 0) * D + d] = v[0]; wt[(e0 + 1) * D + d] = v[1]; wt[(e0 + 2) * D + d] = v[2]; wt[(e0 + 3) * D + d] = v[3]; } }
    __syncthreads();
    int krow = 0;
    Row xn; RowH yn;
    if (gw < rows) { row_load(xn, l == 0 ? x_in_row(F, gw) : XS + (size_t)gw * D, F.lane); rowh_load(yn, Y + (size_t)gw * D, F.lane); }
    for (int r = gw; r < rows; r += NGW, ++krow) {
        Row x, y, h; RowH yh;
        row_touch(xn); rowh_touch(yn); x = xn; yh = yn;
        if (r + NGW < rows) { const int rn = r + NGW; row_load(xn, l == 0 ? x_in_row(F, rn) : XS + (size_t)rn * D, F.lane); rowh_load(yn, Y + (size_t)rn * D, F.lane); }
        if (CTX_SPLIT && l == 0 && r >= ML) row_sum_slices<YP_S3>(y, (const float*)(F.ws + WS_YP) + (size_t)(r - ML) * D, (size_t)MC * D, F.lane);
        else rowh_cvt(y, yh);
        const int m = mod_row(r);
        const float rs = 1.0f / sqrtf(row_ss(y) * (1.0f / D) + RMS_EPS);
#pragma unroll
        for (int j = 0; j < 8; ++j) { const int o = 4 * F.lane + 256 * j; const f32x4 gg = *(const LAS f32x4*)(LV(0) + o), gt = *(const LAS f32x4*)(LV(2 + 3 * m) + o);
            x.v[j] = x.v[j] + gt * (y.v[j] * rs * gg); *(f32x4*)(XS + (size_t)r * D + o) = x.v[j]; }
        prenorm_store_l(x, h, LV(1), LV(3 + 3 * m), LV(4 + 3 * m), HX + (size_t)r * D, F.lane, !(MOE_FP8 && l == 1) && !(DENSE_FP8 && l == 0));
#if MOE_FP8
        if (l == 1 || DENSE_FP8) {
            unsigned char* h8 = F.ws + WS_HX8 + (size_t)r * D;
#pragma unroll
            for (int j = 0; j < 8; ++j) *(unsigned*)(h8 + 4 * F.lane + 256 * j) = pk4_fp8(h.v[j][0] * X8_SCALE, h.v[j][1] * X8_SCALE, h.v[j][2] * X8_SCALE, h.v[j][3] * X8_SCALE);
        }
#endif
        if (l == 1) {
            float lg[NE];
#pragma unroll
            for (int e = 0; e < NE; ++e) { float a_ = 0.f;
#pragma unroll
                for (int j = 0; j < 8; ++j) { const f32x4 w4 = *(const LAS f32x4*)(LV(8 + e) + 4 * F.lane + 256 * j); a_ += (h.v[j][0] * w4[0] + h.v[j][1] * w4[1]) + (h.v[j][2] * w4[2] + h.v[j][3] * w4[3]); }
                lg[e] = a_; }
#pragma unroll
            for (int e = 0; e < NE; ++e) lg[e] = wave_sum(lg[e]) + INP(I_BROUTER)[e];
            int e1 = 0; float v1 = lg[0];
#pragma unroll
            for (int e = 1; e < NE; ++e) if (lg[e] > v1) { v1 = lg[e]; e1 = e; }
            int e2 = -1; float v2 = -INFINITY;
#pragma unroll
            for (int e = 0; e < NE; ++e) if (e != e1 && lg[e] > v2) { v2 = lg[e]; e2 = e; }
            if (F.lane == 0) {
                const float w1 = 1.0f / (1.0f + __expf(v2 - v1)), w2 = 1.0f - w1;
                int* ti = (int*)(F.ws + WS_TINFO) + (size_t)r * 8;
                const int s1 = (int)__hip_atomic_fetch_add((LAS unsigned*)lcnt + e1, 1u, __ATOMIC_RELAXED, __HIP_MEMORY_SCOPE_WORKGROUP), s2 = (int)__hip_atomic_fetch_add((LAS unsigned*)lcnt + e2, 1u, __ATOMIC_RELAXED, __HIP_MEMORY_SCOPE_WORKGROUP);
                if (krow < 64) { rinfo[krow * 4 + 0] = e1; rinfo[krow * 4 + 1] = s1; rinfo[krow * 4 + 2] = e2; rinfo[krow * 4 + 3] = s2; }
                ti[0] = e1; ti[2] = e2; ti[4] = (int)__float_as_uint(w1); ti[5] = (int)__float_as_uint(w2);
            }
        }
    }
    if (l == 1) {
        __syncthreads();
        if (F.tid < NE) lbase[F.tid] = atomicAdd(F.ctl + CW_CNT + F.tid, lcnt[F.tid]);
        __syncthreads();
        if (F.lane == 0) { int* list = (int*)(F.ws + WS_LIST); int k = 0;
            for (int r = gw; r < rows; r += NGW, ++k) { if (k >= 64) break;
                const int e1 = rinfo[k * 4 + 0], s1 = (int)lbase[e1] + rinfo[k * 4 + 1], e2 = rinfo[k * 4 + 2], s2 = (int)lbase[e2] + rinfo[k * 4 + 3];
                int* ti = (int*)(F.ws + WS_TINFO) + (size_t)r * 8;
                list[e1 * MOE_CAP + s1] = r; list[e2 * MOE_CAP + s2] = r; ti[1] = s1; ti[3] = s2; } }
    }
}
__device__ __forceinline__ void t5_phase(Frame& F, int l) {
    const int gw = F.vcu * 8 + F.wave, NGW = F.G * 8, rows = (l == 0) ? MT : ML;
    const float* MODL = (const float*)(F.ws + WS_MOD) + (size_t)l * 3 * 6 * D; bf16* HX = (bf16*)(F.ws + WS_HX); float* XS = (float*)(F.ws + WS_XS);
    const float* gpost = INP(I_GPOSTFFN) + l * D;
    float chk_scale = 1.0f;
#if MIXCHECK
    { const float* acc = (const float*)(F.ctl + CW_CHK); const float tol = MIXCHECK_TOL; bool badg = false, bada = false;
      for (int q = 0; q < 2; ++q) { if (!(acc[4 * q + 0] <= tol * acc[4 * q + 1])) badg = true; if (!(acc[4 * q + 2] <= tol * acc[4 * q + 3])) bada = true; }
      chk_scale = 1.0f + (badg ? 2.0f : 0.f) + (bada ? 1.0f : 0.f); }
#endif
    int pb[NE + 1]; pb[0] = 0;
    if (l == 1) {
#pragma unroll
        for (int e = 0; e < NE; ++e) { int v = __builtin_amdgcn_readfirstlane((int)F.ctl[CW_CNT + e]); v = v > MOE_CAP ? MOE_CAP : v; pb[e + 1] = pb[e] + ((v + 255) >> 8); }
    }
    __syncthreads();
    stage_vec(F, 0, gpost);
#pragma unroll
    for (int m = 0; m < 3; ++m) { stage_vec(F, 1 + m, MODL + (size_t)m * 6 * D + 5 * D);
        if (l == 0) { stage_vec(F, 5 + 2 * m, MODL + (size_t)(3 + m) * 6 * D + D); stage_vec(F, 6 + 2 * m, MODL + (size_t)(3 + m) * 6 * D); } }
    if (l == 0) stage_vec(F, 4, INP(I_GPREMIX) + D);
    __syncthreads();
    Row xn; RowH fa_n, fb_n; int tin[6] = {0, 0, 0, 0, 0, 0}, tin2[6] = {0, 0, 0, 0, 0, 0};
    const bf16* YMb = (const bf16*)(F.ws + WS_LAF); const int* TI = (const int*)(F.ws + WS_TINFO);
#define T5_YM_ADDR(ti, which) (YMb + (size_t)(({ int p_ = 0; _Pragma("unroll") for (int e = 0; e < NE; ++e) if (e == (ti)[2 * (which)]) p_ = pb[e]; p_; }) * 256 + (ti)[2 * (which) + 1]) * D)
    if (gw < rows) { row_load(xn, XS + (size_t)gw * D, F.lane);
        if (l == 0) rowh_load(fa_n, (const bf16*)(F.ws + WS_Y) + (size_t)gw * D, F.lane);
        else {
#pragma unroll
            for (int q = 0; q < 6; ++q) tin[q] = TI[(size_t)gw * 8 + q];
            if (gw + NGW < rows) {
#pragma unroll
                for (int q = 0; q < 6; ++q) tin2[q] = TI[(size_t)(gw + NGW) * 8 + q]; }
            rowh_load(fa_n, T5_YM_ADDR(tin, 0), F.lane); rowh_load(fb_n, T5_YM_ADDR(tin, 1), F.lane); } }
    for (int r = gw; r < rows; r += NGW) {
        Row x, f, h; RowH fa, fb; int tic[6];
        row_touch(xn); rowh_touch(fa_n); if (l == 1) { rowh_touch(fb_n); asm volatile("" : "+v"(tin2[0]), "+v"(tin2[1]), "+v"(tin2[2]), "+v"(tin2[3]), "+v"(tin2[4]), "+v"(tin2[5])); }
        x = xn; fa = fa_n; fb = fb_n;
#pragma unroll
        for (int q = 0; q < 6; ++q) tic[q] = tin[q];
        if (r + NGW < rows) { const int rn = r + NGW;
            if (l == 1) {
#pragma unroll
                for (int q = 0; q < 6; ++q) tin[q] = tin2[q];
                if (rn + NGW < rows) {
#pragma unroll
                    for (int q = 0; q < 6; ++q) tin2[q] = TI[(size_t)(rn + NGW) * 8 + q]; } }
            row_load(xn, XS + (size_t)rn * D, F.lane);
            if (l == 0) rowh_load(fa_n, (const bf16*)(F.ws + WS_Y) + (size_t)rn * D, F.lane);
            else { rowh_load(fa_n, T5_YM_ADDR(tin, 0), F.lane); rowh_load(fb_n, T5_YM_ADDR(tin, 1), F.lane); } }
        if (CTX_SPLIT && DENSE_FP8 != 1 && l == 0 && r >= ML) row_sum_slices<YP_S5>(f, (const float*)(F.ws + WS_YP) + (size_t)(r - ML) * D, (size_t)MC * D, F.lane);
        else if (l == 0) rowh_cvt(f, fa);
        else { const float w1 = __uint_as_float((unsigned)tic[4]), w2 = __uint_as_float((unsigned)tic[5]); Row a, b; rowh_cvt(a, fa); rowh_cvt(b, fb);
#pragma unroll
            for (int j = 0; j < 8; ++j) f.v[j] = a.v[j] * w1 + b.v[j] * w2; }
        const int m = mod_row(r);
        const float rs = 1.0f / sqrtf(row_ss(f) * (1.0f / D) + RMS_EPS);
#pragma unroll
        for (int j = 0; j < 8; ++j) { const int o = 4 * F.lane + 256 * j; const f32x4 gg = *(const LAS f32x4*)(LV(0) + o), gt = *(const LAS f32x4*)(LV(1 + m) + o);
            x.v[j] = x.v[j] + gt * (f.v[j] * rs * gg);
            if (l == 0) *(f32x4*)(XS + (size_t)r * D + o) = x.v[j]; else *(f32x4*)(F.out + (size_t)r * D + o) = x.v[j] * chk_scale; }
        if (l == 0) prenorm_store_l(x, h, LV(4), LV(5 + 2 * m), LV(6 + 2 * m), HX + (size_t)r * D, F.lane);
    }
#undef T5_YM_ADDR
}

__device__ __forceinline__ void prep_phase(Frame& F, int l) {
    const bf16* P = (const bf16*)(F.ws + WS_P);
    const size_t gt = (size_t)F.vcu * 512 + F.tid, NT = (size_t)F.G * 512;
    {
        float* LAF = (float*)(F.ws + WS_LAF); float* LAB = (float*)(F.ws + WS_LAB);
        const float* wf = INP(I_WLRF) + (size_t)l * 16 * 1024; const float* wb = INP(I_WLRB) + (size_t)l * 16 * 1024; const float* bfv = INP(I_BLRF) + l * 1024; const float* bbv = INP(I_BLRB) + l * 1024;
        for (size_t idx = gt; idx < (size_t)MT * 1024; idx += NT) { const int r = (int)(idx >> 10), d = (int)(idx & 1023);
            const u32x4* lr = (const u32x4*)((const bf16*)(F.ws + WS_LRB + (size_t)l * SZ_LRB) + (size_t)r * 256); const u32x4 a0 = lr[0], a1 = lr[1], b0 = lr[2], b1 = lr[3];
            const unsigned fa[8] = {a0.x, a0.y, a0.z, a0.w, a1.x, a1.y, a1.z, a1.w}, fb[8] = {b0.x, b0.y, b0.z, b0.w, b1.x, b1.y, b1.z, b1.w};
            float zf = bfv[d], zb = bbv[d];
#pragma unroll
            for (int j = 0; j < 8; ++j) { zf += bflo(fa[j]) * wf[(2 * j) * 1024 + d] + bfhi(fa[j]) * wf[(2 * j + 1) * 1024 + d]; zb += bflo(fb[j]) * wb[(2 * j) * 1024 + d] + bfhi(fb[j]) * wb[(2 * j + 1) * 1024 + d]; }
            LAF[idx] = logsigf_(zf) * (1.0f / 16.0f); LAB[idx] = logsigf_(zb) * (1.0f / 16.0f); }
    }
    {
        bf16* QR = (bf16*)(F.ws + WS_QR); bf16* KR = (bf16*)(F.ws + WS_KR);
        for (size_t idx = gt; idx < (size_t)MT * 1152; idx += NT) { const int r = (int)(idx / 1152), p = (int)(idx % 1152);
            const bool isq = p < 1024; const int hp = isq ? p : p - 1024, head = hp >> 5, pp = hp & 31, half = pp >> 4, i = pp & 15, d0 = half * 32 + i, d1 = d0 + 16;
            const bf16* src = P + (size_t)r * NP + (isq ? OAQ : OAK) + head * 64; float x0 = bf2f(src[d0]), x1 = bf2f(src[d1]);
            float o0 = x0, o1 = x1;
            if (r < ML) { const int t = r % SEQ; const float pos = (float)(half == 0 ? (t >> 6) : (t & 63)); const float inv = exp2f(-(float)i * (13.287712379549449f / 16.0f));
                float sn, cs; sincosf(pos * inv, &sn, &cs); o0 = x0 * cs - x1 * sn; o1 = x1 * cs + x0 * sn; }
            if (isq) { o0 *= 0.18033688011112042f; o1 *= 0.18033688011112042f; QR[(size_t)r * D + head * 64 + d0] = f2bf(o0); QR[(size_t)r * D + head * 64 + d1] = f2bf(o1); }
            else { KR[(size_t)r * 256 + head * 64 + d0] = f2bf(o0); KR[(size_t)r * 256 + head * 64 + d1] = f2bf(o1); } }
    }
}

__device__ __forceinline__ int gla_row(int b, int dir, int s) { if (s < CTXL) { const int p = dir ? CTXL - 1 - s : s; return ML + b * CTXL + p; } const int q = s - CTXL; const int p = dir ? SEQ - 1 - q : q; return b * SEQ + p; }
__device__ __forceinline__ void mix_simple_gla(Frame& F, int wg, size_t ws_of, size_t ws_ob) {
    const bf16* P = (const bf16*)(F.ws + WS_P);
    const int seq = wg >> 2, dvb = wg & 3, b = seq >> 3, h = (seq >> 1) & 3, dir = seq & 1;
    const float* LA = (const float*)(F.ws + (dir ? WS_LAB : WS_LAF)); float* O = (float*)(F.ws + (dir ? ws_ob : ws_of));
    LAS float* sa = (LAS float*)F.lds; LAS float* sq = sa + 32 * 256; LAS float* sk = sq + 32 * 256; LAS float* sv = sk + 32 * 256;
    const int qd = F.tid & 3, jl = F.tid >> 2;
    float S[64];
#pragma unroll
    for (int i = 0; i < 64; ++i) S[i] = 0.f;
    for (int c0 = 0; c0 < CTXL + SEQ; c0 += 32) {
        __syncthreads();
        for (int idx = F.tid; idx < 32 * 256; idx += 512) { const int st = idx >> 8, dk = idx & 255; const int row = gla_row(b, dir, c0 + st);
            sa[idx] = __expf(LA[(size_t)row * 1024 + h * 256 + dk]); sq[idx] = bf2f(P[(size_t)row * NP + OQ + h * 256 + dk]) * 0.0625f; sk[idx] = bf2f(P[(size_t)row * NP + OKK + h * 256 + dk]); }
        for (int idx = F.tid; idx < 32 * 128; idx += 512) { const int st = idx >> 7, j = idx & 127; const int row = gla_row(b, dir, c0 + st); sv[idx] = bf2f(P[(size_t)row * NP + OV + h * 512 + dvb * 128 + j]); }
        __syncthreads();
        for (int st = 0; st < 32; ++st) {
            const float v = sv[st * 128 + jl]; float o = 0.f;
            const LAS f32x4* pa = (const LAS f32x4*)(sa + st * 256 + qd * 64); const LAS f32x4* pq = (const LAS f32x4*)(sq + st * 256 + qd * 64); const LAS f32x4* pk = (const LAS f32x4*)(sk + st * 256 + qd * 64);
#pragma unroll
            for (int i4 = 0; i4 < 16; ++i4) { const f32x4 a = pa[i4], q = pq[i4], k = pk[i4];
#pragma unroll
                for (int e = 0; e < 4; ++e) { const float s = a[e] * S[i4 * 4 + e] + k[e] * v; S[i4 * 4 + e] = s; o += q[e] * s; } }
            o += __shfl_xor(o, 1); o += __shfl_xor(o, 2);
            if (qd == 0) ((bf16*)O)[(size_t)gla_row(b, dir, c0 + st) * D + h * 512 + dvb * 128 + jl] = f2bf(o);
        }
    }
}
__device__ __forceinline__ void mix_simple_attn(Frame& F, int l, int wg, int nwg, size_t ws_ax) {
    const bf16* P = (const bf16*)(F.ws + WS_P); const bf16* QR = (const bf16*)(F.ws + WS_QR); const bf16* KR = (const bf16*)(F.ws + WS_KR); bf16* AX = (bf16*)(F.ws + ws_ax);
    const int rows = (l == 0) ? MT : ML;
    for (size_t idx = (size_t)wg * 512 + F.tid; idx < (size_t)rows * AHQ; idx += (size_t)nwg * 512) {
        const int r = (int)(idx >> 5), hq = (int)(idx & 31), kvh = hq >> 3;
        float q[64], o[64];
        { const u32x4* qp = (const u32x4*)(QR + (size_t)r * D + hq * 64);
#pragma unroll
            for (int j = 0; j < 8; ++j) { const u32x4 w = qp[j]; q[8 * j] = bflo(w.x); q[8 * j + 1] = bfhi(w.x); q[8 * j + 2] = bflo(w.y); q[8 * j + 3] = bfhi(w.y); q[8 * j + 4] = bflo(w.z); q[8 * j + 5] = bfhi(w.z); q[8 * j + 6] = bflo(w.w); q[8 * j + 7] = bfhi(w.w); } }
#pragma unroll
        for (int d = 0; d < 64; ++d) o[d] = 0.f;
        float m = INP(I_SINK)[l * AHQ + hq] * 1.4426950408889634f, lsum = 1.0f;
        int b, k0 = 0, k1 = 0;
        if (r < ML) { b = r / SEQ; const int t = r % SEQ; k0 = t - AWIN < 0 ? 0 : t - AWIN; k1 = t + AWIN > SEQ - 1 ? SEQ - 1 : t + AWIN; k1 += 1; } else b = (r - ML) / CTXL;
        const int nloc = k1 - k0, ntot = nloc + CTXL;
        for (int kk = 0; kk < ntot; ++kk) {
            const int kr = kk < nloc ? b * SEQ + k0 + kk : ML + b * CTXL + (kk - nloc);
            const u32x4* kp = (const u32x4*)(KR + (size_t)kr * 256 + kvh * 64); float s = 0.f;
#pragma unroll
            for (int j = 0; j < 8; ++j) { const u32x4 w = kp[j]; s += q[8 * j] * bflo(w.x) + q[8 * j + 1] * bfhi(w.x) + q[8 * j + 2] * bflo(w.y) + q[8 * j + 3] * bfhi(w.y) + q[8 * j + 4] * bflo(w.z) + q[8 * j + 5] * bfhi(w.z) + q[8 * j + 6] * bflo(w.w) + q[8 * j + 7] * bfhi(w.w); }
            float p;
            if (s > m) { const float sc = __builtin_amdgcn_exp2f(m - s); lsum *= sc;
#pragma unroll
                for (int d = 0; d < 64; ++d) o[d] *= sc;
                m = s; p = 1.0f; } else p = __builtin_amdgcn_exp2f(s - m);
            lsum += p;
            const u32x4* vp = (const u32x4*)(P + (size_t)kr * NP + OAV + kvh * 64);
#pragma unroll
            for (int j = 0; j < 8; ++j) { const u32x4 w = vp[j]; o[8 * j] += p * bflo(w.x); o[8 * j + 1] += p * bfhi(w.x); o[8 * j + 2] += p * bflo(w.y); o[8 * j + 3] += p * bfhi(w.y); o[8 * j + 4] += p * bflo(w.z); o[8 * j + 5] += p * bfhi(w.z); o[8 * j + 6] += p * bflo(w.w); o[8 * j + 7] += p * bfhi(w.w); }
        }
        const float il = 1.0f / lsum; u32x4* op = (u32x4*)(AX + (size_t)r * D + hq * 64);
#pragma unroll
        for (int j = 0; j < 8; ++j) { u32x4 w; w.x = cvt_pk_bf16(o[8 * j] * il, o[8 * j + 1] * il); w.y = cvt_pk_bf16(o[8 * j + 2] * il, o[8 * j + 3] * il); w.z = cvt_pk_bf16(o[8 * j + 4] * il, o[8 * j + 5] * il); w.w = cvt_pk_bf16(o[8 * j + 6] * il, o[8 * j + 7] * il); op[j] = w; }
    }
}
__device__ __forceinline__ void ro_phase(Frame& F, int l) {
    const int gw = F.vcu * 8 + F.wave, NGW = F.G * 8, rows = (l == 0) ? MT : ML;
    const bf16* P = (const bf16*)(F.ws + WS_P); const bf16* OF = (const bf16*)(F.ws + WS_OF); const bf16* OB = (const bf16*)(F.ws + WS_OB); bf16* GX = (bf16*)(F.ws + WS_GX);
    const float* gg = INP(I_GGLA) + l * GDV;
    const f32x4 gla0 = *(const f32x4*)(gg + 4 * F.lane), gla1 = *(const f32x4*)(gg + 4 * F.lane + 256);
    RowH an, bn, gn;
    if (gw < rows) { rowh_load(an, OF + (size_t)gw * D, F.lane); rowh_load(bn, OB + (size_t)gw * D, F.lane); rowh_load(gn, P + (size_t)gw * NP + ORG, F.lane); }
    for (int r = gw; r < rows; r += NGW) {
        Row a, b; RowH ah, bh, gh; rowh_touch(an); rowh_touch(bn); rowh_touch(gn); ah = an; bh = bn; gh = gn;
        if (r + NGW < rows) { const int rn = r + NGW; rowh_load(an, OF + (size_t)rn * D, F.lane); rowh_load(bn, OB + (size_t)rn * D, F.lane); rowh_load(gn, P + (size_t)rn * NP + ORG, F.lane); }
        rowh_cvt(a, ah); rowh_cvt(b, bh);
#pragma unroll
        for (int j = 0; j < 8; ++j) a.v[j] = a.v[j] + b.v[j];
#pragma unroll
        for (int hh = 0; hh < 4; ++hh) {
            float s = 0.f;
#pragma unroll
            for (int j = 2 * hh; j < 2 * hh + 2; ++j) s += (a.v[j][0] * a.v[j][0] + a.v[j][1] * a.v[j][1]) + (a.v[j][2] * a.v[j][2] + a.v[j][3] * a.v[j][3]);
            const float rs = 1.0f / sqrtf(wave_sum(s) * (1.0f / GDV) + RMS_EPS);
#pragma unroll
            for (int j = 2 * hh; j < 2 * hh + 2; ++j) { const int o = 4 * F.lane + 256 * j; const f32x4 g4 = (j & 1) ? gla1 : gla0;
                const u32x2 rw = gh.v[j]; const float r0 = bflo(rw.x), r1 = bfhi(rw.x), r2 = bflo(rw.y), r3 = bfhi(rw.y);
                u32x2 w; w.x = cvt_pk_bf16(a.v[j][0] * rs * g4[0] * siluf_(r0), a.v[j][1] * rs * g4[1] * siluf_(r1)); w.y = cvt_pk_bf16(a.v[j][2] * rs * g4[2] * siluf_(r2), a.v[j][3] * rs * g4[3] * siluf_(r3));
                *(u32x2*)(GX + (size_t)r * D + o) = w; }
        }
    }
}

__device__ __forceinline__ int swzQ(int row, int bytecol) { return row * 512 + ((((bytecol >> 4) ^ (row & 15)) << 4) | (bytecol & 15)); }
__device__ __forceinline__ int swz64(int row, int bytecol) { return row * 128 + ((((bytecol >> 4) ^ ((row >> 1) & 7)) << 4) | (bytecol & 15)); }
__device__ __forceinline__ void glds16(const void* gsrc, LAS unsigned char* dst_uniform) { __builtin_amdgcn_global_load_lds((const unsigned*)gsrc, (LAS unsigned*)dst_uniform, 16, 0, 0); }
typedef short s16x4 __attribute__((ext_vector_type(4)));
__device__ __forceinline__ bf16x8 cat8(s16x4 a, s16x4 b) { return (bf16x8){a[0], a[1], a[2], a[3], b[0], b[1], b[2], b[3]}; }
typedef __bf16 bf16x2_t __attribute__((ext_vector_type(2)));
__device__ __forceinline__ unsigned cvt_pk_bf16_b(float lo, float hi) { const f32x2 v = {lo, hi}; const bf16x2_t b = __builtin_convertvector(v, bf16x2_t); return __builtin_bit_cast(unsigned, b); }
__device__ __forceinline__ bf16x8 pack8b(const f32x4& a, const f32x4& b) { u32x4 w; w.x = cvt_pk_bf16_b(a[0], a[1]); w.y = cvt_pk_bf16_b(a[2], a[3]); w.z = cvt_pk_bf16_b(b[0], b[1]); w.w = cvt_pk_bf16_b(b[2], b[3]); return __builtin_bit_cast(bf16x8, w); }
__device__ __forceinline__ bf16x8 pack8(const f32x4& a, const f32x4& b) { u32x4 w; w.x = cvt_pk_bf16(a[0], a[1]); w.y = cvt_pk_bf16(a[2], a[3]); w.z = cvt_pk_bf16(b[0], b[1]); w.w = cvt_pk_bf16(b[2], b[3]);
    return __builtin_bit_cast(bf16x8, w); }
__device__ __forceinline__ int gla_item_row0(int it) { const int c = it % 68, bh = it / 68, b = bh >> 2; return c < 4 ? ML + b * CTXL + 64 * c : b * SEQ + 64 * (c - 4); }

typedef unsigned u32x8 __attribute__((ext_vector_type(8)));
#define CAS __attribute__((address_space(4)))
__device__ __forceinline__ void gla_prep_item(Frame& F, int l, int it) {
    const bf16* P = (const bf16*)(F.ws + WS_P);
    const int bh = it / 68, h = bh & 3, r0 = gla_item_row0(it);
    LAS unsigned char* Qs = F.lds; LAS unsigned char* Ks = F.lds + 65536;
    const int tid = F.tid, d = tid & 255, dir = __builtin_amdgcn_readfirstlane(tid >> 8);
    __syncthreads();
#pragma unroll
    for (int m = 0; m < 4; ++m) { const int ci = tid + 512 * m, row = ci >> 5, c = ci & 31, off = row * 512 + ((c ^ (row & 15)) << 4);
        const u32x4 qv = *(const u32x4*)(P + (size_t)(r0 + row) * NP + OQ + h * 256 + 8 * c), kv = *(const u32x4*)(P + (size_t)(r0 + row) * NP + OKK + h * 256 + 8 * c);
        *(LAS u32x4*)(Qs + off) = qv; *(LAS u32x4*)(Qs + 32768 + off) = qv; *(LAS u32x4*)(Ks + off) = kv; *(LAS u32x4*)(Ks + 32768 + off) = kv; }
    const float* wl = (dir ? INP(I_WLRB) : INP(I_WLRF)) + (size_t)l * 16 * 1024 + h * 256 + d;
    float w[16];
#pragma unroll
    for (int j = 0; j < 16; ++j) w[j] = wl[j * 1024];
    const float bias = (dir ? INP(I_BLRB) : INP(I_BLRF))[l * 1024 + h * 256 + d];
    bf16* QIN = (bf16*)(F.ws + WS_QIN + dir * SZ_QIN);
    const CAS unsigned* lrp = (const CAS unsigned*)(const GAS unsigned*)((const bf16*)(F.ws + WS_LRB + (size_t)l * SZ_LRB) + (size_t)r0 * 256 + dir * 16);
    const int qoff = dir * 32768 + ((d * 2) & 15), cblk = d >> 3;
    __syncthreads();
    float bsum = 0.f;
#define LR_LOAD(dst, s0_) _Pragma("unroll") for (int u = 0; u < 4; ++u) { const int i_ = dir ? 63 - ((s0_) + u) : (s0_) + u; dst[u] = *(const CAS u32x8*)(lrq + (size_t)i_ * 128); }
    const CAS unsigned* lrq = lrp;
    u32x8 cur[4]; LR_LOAD(cur, 0)
#pragma unroll 2
    for (int s0 = 0; s0 < 64; s0 += 4) {
        u32x8 nxt[4];
        asm volatile("" : "+s"(cur[0]), "+s"(cur[1]), "+s"(cur[2]), "+s"(cur[3]), "+s"(lrq));
        { const int sn = (s0 + 4) & 63; LR_LOAD(nxt, sn) }
        float e[4], ie[4]; int off[4];
#pragma unroll
        for (int u = 0; u < 4; ++u) {
            const int i = dir ? 63 - (s0 + u) : s0 + u;
            const u32x8 lv = cur[u];
            float z0 = bias, z1 = 0.f;
#pragma unroll
            for (int j = 0; j < 8; ++j) { z0 += bflo(lv[j]) * w[2 * j]; z1 += bfhi(lv[j]) * w[2 * j + 1]; }
            const float z = z0 + z1;
            bsum += fminf(z, 0.f) * (1.4426950408889634f / 16.0f) - __builtin_amdgcn_logf(1.0f + __builtin_amdgcn_exp2f(-1.4426950408889634f * fabsf(z))) * (1.0f / 16.0f);
            e[u] = __builtin_amdgcn_exp2f(bsum - 4.0f); ie[u] = __builtin_amdgcn_exp2f(-bsum);
            off[u] = qoff + i * 512 + ((cblk ^ (i & 15)) << 4);
        }
        unsigned short qr[4], kr[4];
#pragma unroll
        for (int u = 0; u < 4; ++u) { qr[u] = *(const LAS unsigned short*)(Qs + off[u]); kr[u] = *(const LAS unsigned short*)(Ks + off[u]); }
#pragma unroll
        for (int u = 0; u < 4; ++u) { const int i = dir ? 63 - (s0 + u) : s0 + u;
            const bf16 qb = f2bf(__builtin_bit_cast(float, (unsigned)qr[u] << 16) * e[u]); const bf16 kb = f2bf(__builtin_bit_cast(float, (unsigned)kr[u] << 16) * ie[u]);
            *(LAS bf16*)(Qs + off[u]) = qb; *(LAS bf16*)(Ks + off[u]) = kb;
            QIN[(size_t)(r0 + i) * 1024 + h * 256 + d] = qb; }
#pragma unroll
        for (int u = 0; u < 4; ++u) cur[u] = nxt[u];
    }
#undef LR_LOAD
    {
        const float eb = __builtin_amdgcn_exp2f(bsum);
        ((float*)(F.ws + WS_DEC + dir * SZ_DEC))[(size_t)it * 256 + d] = eb;
        u32x4* kt = (u32x4*)((bf16*)(F.ws + WS_KTO + dir * SZ_KTO) + ((size_t)it * 256 + d) * 64);
#pragma unroll
        for (int t8 = 0; t8 < 8; ++t8) { float v[8];
#pragma unroll
            for (int j = 0; j < 8; ++j) v[j] = bf2f(*(const LAS bf16*)(Ks + dir * 32768 + swzQ(t8 * 8 + j, d * 2))) * eb;
            u32x4 wv; wv.x = cvt_pk_bf16(v[0], v[1]); wv.y = cvt_pk_bf16(v[2], v[3]); wv.z = cvt_pk_bf16(v[4], v[5]); wv.w = cvt_pk_bf16(v[6], v[7]); kt[t8] = wv; }
    }
    u32x4 vreg[8];
#pragma unroll
    for (int m = 0; m < 8; ++m) { const int ci = tid + 512 * m, row = ci >> 6, c = ci & 63; vreg[m] = *(const u32x4*)(P + (size_t)(r0 + row) * NP + OV + h * 512 + 8 * c); }
    __syncthreads();
    {
        const int wv = F.wave, dw = wv >> 2, itile = wv & 3, r = F.lane & 15, g = F.lane >> 4;
        bf16x8 af[8];
#pragma unroll
        for (int kk = 0; kk < 8; ++kk) af[kk] = *(const LAS bf16x8*)(Qs + dw * 32768 + swzQ(16 * itile + r, (32 * kk + 8 * g) * 2));
        bf16* AO = (bf16*)(F.ws + WS_AIN + dw * SZ_AIN) + (size_t)it * 4096;
#pragma unroll
        for (int jt = 0; jt < 4; ++jt) {
            f32x4 acc = (f32x4){0.f, 0.f, 0.f, 0.f};
            const bool live = dw == 0 ? (jt <= itile) : (jt >= itile);
            if (live) {
#pragma unroll
                for (int kk = 0; kk < 8; ++kk) { const bf16x8 bq = *(const LAS bf16x8*)(Ks + dw * 32768 + swzQ(16 * jt + r, (32 * kk + 8 * g) * 2)); acc = __builtin_amdgcn_mfma_f32_16x16x32_bf16(af[kk], bq, acc, 0, 0, 0); }
            }
#pragma unroll
            for (int q = 0; q < 4; ++q) { const int i = 16 * itile + 4 * g + q, j = 16 * jt + r; const bool keep = dw == 0 ? (j <= i) : (j >= i); AO[i * 64 + j] = f2bf(keep ? acc[q] : 0.f); }
        }
    }
    __syncthreads();
#pragma unroll
    for (int m = 0; m < 8; ++m) { const int ci = tid + 512 * m; *(LAS u32x4*)(Qs + ci * 16) = vreg[m]; }
    __syncthreads();
    {
        const int dv = tid;
        u32x4* vt = (u32x4*)((bf16*)(F.ws + WS_VT) + ((size_t)it * 512 + dv) * 64);
#pragma unroll
        for (int t8 = 0; t8 < 8; ++t8) { unsigned wd[4];
#pragma unroll
            for (int p = 0; p < 4; ++p) { const unsigned lo = *(const LAS unsigned short*)(Qs + (8 * t8 + 2 * p) * 1024 + 2 * dv), hi = *(const LAS unsigned short*)(Qs + (8 * t8 + 2 * p + 1) * 1024 + 2 * dv); wd[p] = lo | (hi << 16); }
            u32x4 wv; wv.x = wd[0]; wv.y = wd[1]; wv.z = wd[2]; wv.w = wd[3]; vt[t8] = wv; }
    }
}
__device__ __forceinline__ void prep_fast_phase(Frame& F, int l, int parts) {
    if (parts & 1) for (int it = F.vcu; it < NIT; it += F.G) gla_prep_item(F, l, it);
    const bf16* P = (const bf16*)(F.ws + WS_P);
    const size_t gt = (size_t)F.vcu * 512 + F.tid, NT = (size_t)F.G * 512;
    if (parts & 2) {
        bf16* QR = (bf16*)(F.ws + WS_QR); bf16* KR = (bf16*)(F.ws + WS_KR);
        LAS float* tcs = (LAS float*)(F.lds + 131072); LAS float* tsn = tcs + 1024;
        for (int idx = F.tid; idx < 1024; idx += 512) { const float ang = (float)(idx >> 4) * __builtin_amdgcn_exp2f(-(float)(idx & 15) * (13.287712379549449f / 16.0f)) * 0.15915494309189535f;
            tcs[idx] = __builtin_amdgcn_cosf(ang); tsn[idx] = __builtin_amdgcn_sinf(ang); }
        __syncthreads();
        const int nfull = NIT - 2 * F.G, nwv = (F.G - nfull) * 8, tpw = (MT * 144 + nwv - 1) / nwv;
        const int wv_ = (F.vcu - nfull) * 8 + F.wave, tbeg = wv_ * tpw, tend = (F.vcu < nfull) ? 0 : min(MT * 144, tbeg + tpw);
#pragma unroll 3
        for (int t_ = (F.vcu < nfull ? MT * 144 : tbeg) + F.lane; t_ < tend; t_ += 64) { const int r = t_ / 144, p = t_ % 144;
                const bool isq = p < 128; const int hp = isq ? p : p - 128, head = hp >> 2, half = (hp >> 1) & 1, sub = hp & 1, d0 = half * 32 + sub * 8;
                const bf16* src = P + (size_t)r * NP + (isq ? OAQ : OAK) + head * 64 + d0;
                const u32x4 a = *(const u32x4*)src, bq = *(const u32x4*)(src + 16);
                float x0[8] = {bflo(a.x), bfhi(a.x), bflo(a.y), bfhi(a.y), bflo(a.z), bfhi(a.z), bflo(a.w), bfhi(a.w)}, x1[8] = {bflo(bq.x), bfhi(bq.x), bflo(bq.y), bfhi(bq.y), bflo(bq.z), bfhi(bq.z), bflo(bq.w), bfhi(bq.w)};
                float o0[8], o1[8];
                const float sc = isq ? 0.18033688011112042f : 1.0f;
                if (r < ML) { const int t = r % SEQ, pos = half == 0 ? (t >> 6) : (t & 63);
                    const LAS f32x4* pc = (const LAS f32x4*)(tcs + pos * 16 + sub * 8); const LAS f32x4* ps = (const LAS f32x4*)(tsn + pos * 16 + sub * 8);
                    const f32x4 c0 = pc[0], c1 = pc[1], s0 = ps[0], s1 = ps[1];
#pragma unroll
                    for (int j = 0; j < 8; ++j) { const float cs = j < 4 ? c0[j & 3] : c1[j & 3], sn = j < 4 ? s0[j & 3] : s1[j & 3]; o0[j] = (x0[j] * cs - x1[j] * sn) * sc; o1[j] = (x1[j] * cs + x0[j] * sn) * sc; } }
                else {
#pragma unroll
                    for (int j = 0; j < 8; ++j) { o0[j] = x0[j] * sc; o1[j] = x1[j] * sc; } }
                bf16* dst = (isq ? QR + (size_t)r * D : KR + (size_t)r * 256) + head * 64 + d0;
                u32x4 w0, w1; w0.x = cvt_pk_bf16(o0[0], o0[1]); w0.y = cvt_pk_bf16(o0[2], o0[3]); w0.z = cvt_pk_bf16(o0[4], o0[5]); w0.w = cvt_pk_bf16(o0[6], o0[7]);
                w1.x = cvt_pk_bf16(o1[0], o1[1]); w1.y = cvt_pk_bf16(o1[2], o1[3]); w1.z = cvt_pk_bf16(o1[4], o1[5]); w1.w = cvt_pk_bf16(o1[6], o1[7]);
                *(u32x4*)dst = w0; *(u32x4*)(dst + 16) = w1; }
    }
    if (parts & 4) {   bf16* VAT = (bf16*)(F.ws + WS_VAT);
        LAS unsigned char* Ts = F.lds;
        for (int ch = F.G - 1 - F.vcu; ch < MT / 64; ch += F.G) {
            u32x4 vr[4];
#pragma unroll
            for (int m = 0; m < 4; ++m) { const int ci = F.tid + 512 * m, row = ci >> 5, c = ci & 31; vr[m] = *(const u32x4*)(P + (size_t)(ch * 64 + row) * NP + OAV + 8 * c); }
            __syncthreads();
#pragma unroll
            for (int m = 0; m < 4; ++m) { const int ci = F.tid + 512 * m; *(LAS u32x4*)(Ts + ci * 16) = vr[m]; }
            __syncthreads();
            const int kd = F.tid & 255, hf = F.tid >> 8;
            u32x4* vt = (u32x4*)(VAT + ((size_t)ch * 256 + kd) * 64) + hf * 4;
#pragma unroll
            for (int t8 = 0; t8 < 4; ++t8) { unsigned wd[4];
#pragma unroll
                for (int p = 0; p < 4; ++p) { const int tk = hf * 32 + 8 * t8 + 2 * p; const unsigned lo = *(const LAS unsigned short*)(Ts + tk * 512 + 2 * kd), hi = *(const LAS unsigned short*)(Ts + (tk + 1) * 512 + 2 * kd); wd[p] = lo | (hi << 16); }
                u32x4 wv; wv.x = wd[0]; wv.y = wd[1]; wv.z = wd[2]; wv.w = wd[3]; vt[t8] = wv; }
        }
    }
}

constexpr int SC_STAGE = 73728, SC_Q = 0, SC_KT = 32768, SC_A = 65536, SC_DEC = 147712;
constexpr int SC_FLAGS = MISC_OFF + 64;
__device__ __forceinline__ void sc_wait4(const volatile LAS unsigned* w4, unsigned need) {
    for (unsigned spins = 0; spins < (1u << 22); ++spins) {
        const unsigned a = w4[0], b = w4[1], c = w4[2], d = w4[3];
        const unsigned m = min(min(a, b), min(c, d));
        if (__builtin_amdgcn_readfirstlane(m) >= need) return;
        __builtin_amdgcn_s_sleep(1);
    }
}
template <int VAR> __device__ __forceinline__ void gla_scan(Frame& F, int wg) {
    const int seq = wg >> 2, dvb = wg & 3, b = seq >> 3, h = (seq >> 1) & 3, dir = seq & 1;
    const int w = F.wave, lane = F.lane, r = lane & 15, g = lane >> 4;
    const unsigned char* QIN = F.ws + WS_QIN + dir * SZ_QIN; const unsigned char* KTO = F.ws + WS_KTO + dir * SZ_KTO; const unsigned char* AIN = F.ws + WS_AIN + dir * SZ_AIN;
    const unsigned char* DEC = F.ws + WS_DEC + dir * SZ_DEC; const bf16* VT = (const bf16*)(F.ws + WS_VT);
    bf16* O = (bf16*)(F.ws + (dir ? WS_OB : WS_OF));
    const int itb = (b * 4 + h) * 68;
    LAS unsigned char* lds = F.lds;
    volatile LAS unsigned* flags = (volatile LAS unsigned*)(lds + SC_FLAGS);
    __syncthreads();
    if (F.tid < 16) flags[F.tid] = 0u;
    __syncthreads();
#define SC_CHUNK(n) (dir == 0 ? (n) : ((n) < 4 ? 3 - (n) : 71 - (n)))
    if (w >= 4) {
        const int hl = w - 4;
        for (int m = 0; m < 68; ++m) {
            const int it_ = itb + SC_CHUNK(m), r0_ = gla_item_row0(it_); LAS unsigned char* st_ = lds + (m & 1) * SC_STAGE;
            if (m >= 2) sc_wait4(flags + 8, (unsigned)(m - 1));
            if (VAR != 2) {
#pragma unroll
                for (int qi = 0; qi < 8; ++qi) { const int q_ = 8 * hl + qi, row_ = 2 * q_ + (lane >> 5), cc_ = (lane & 31) ^ (row_ & 15);
                    glds16(QIN + (size_t)(r0_ + row_) * 2048 + h * 512 + cc_ * 16, st_ + SC_Q + q_ * 1024); }
#pragma unroll
                for (int qi = 0; qi < 2; ++qi) { const int q_ = 2 * hl + qi, row_ = 8 * q_ + (lane >> 3), cc_ = (lane & 7) ^ ((row_ >> 1) & 7);
                    glds16(AIN + (size_t)it_ * 8192 + row_ * 128 + cc_ * 16, st_ + SC_A + q_ * 1024); }
            }
            if (m >= 1) { asm volatile("s_waitcnt vmcnt(10)" ::: "memory"); if (lane == 0) flags[4 + hl] = (unsigned)m; }
            if (m >= 2) sc_wait4(flags + 12, (unsigned)(m - 1));
            if (VAR != 2) {
#pragma unroll
                for (int qi = 0; qi < 8; ++qi) { const int q_ = 8 * hl + qi, row_ = 8 * q_ + (lane >> 3), cc_ = (lane & 7) ^ ((row_ >> 1) & 7);
                    glds16(KTO + (size_t)it_ * 32768 + row_ * 128 + cc_ * 16, st_ + SC_KT + q_ * 1024); }
                __builtin_amdgcn_global_load_lds((const unsigned*)(DEC + (size_t)it_ * 1024 + hl * 256 + lane * 4), (LAS unsigned*)(lds + SC_DEC + (m & 1) * 1024 + hl * 256), 4, 0, 0);
            }
            asm volatile("s_waitcnt vmcnt(9)" ::: "memory"); if (lane == 0) flags[hl] = (unsigned)(m + 1);
        }
        asm volatile("s_waitcnt vmcnt(0)" ::: "memory"); if (lane == 0) flags[4 + hl] = 68u;
    } else {
        const int c = w;
        f32x4 S[16][2];
#pragma unroll
        for (int t = 0; t < 16; ++t) { S[t][0] = (f32x4){0.f, 0.f, 0.f, 0.f}; S[t][1] = (f32x4){0.f, 0.f, 0.f, 0.f}; }
        bf16x8 vt[2][2];
        int k64off[2];
        const int qoff0 = r * 512 + ((((g >> 1) ^ r) & 15) << 4) + 8 * (g & 1);
#pragma unroll
        for (int ks = 0; ks < 2; ++ks) k64off[ks] = r * 128 + (((4 * ks + g) ^ ((r >> 1) & 7)) << 4);
#define SC_LOADVT(n) do { const int it_ = itb + SC_CHUNK(n); _Pragma("unroll") for (int ks = 0; ks < 2; ++ks) _Pragma("unroll") for (int nt = 0; nt < 2; ++nt) \
            vt[ks][nt] = *(const bf16x8*)(VT + ((size_t)it_ * 512 + dvb * 128 + 32 * c + 16 * nt + r) * 64 + 32 * ks + 8 * g); } while (0)
        SC_LOADVT(0);
        for (int n = 0; n < 68; ++n) {
            const LAS unsigned char* st = lds + (n & 1) * SC_STAGE; const LAS unsigned char* dec = lds + SC_DEC + (n & 1) * 1024 + 16 * g;
            const int row0 = gla_item_row0(itb + SC_CHUNK(n));
            const LAS unsigned char* kp0 = st + SC_KT + k64off[0]; const LAS unsigned char* kp1 = st + SC_KT + k64off[1];
            const LAS unsigned char* ap0 = st + SC_A + k64off[0]; const LAS unsigned char* ap1 = st + SC_A + k64off[1];
            sc_wait4(flags + 0, (unsigned)(n + 1));
            asm volatile("" ::: "memory");
#pragma unroll
            for (int mh = 0; mh < 2; ++mh) {
                f32x4 o[2][2];
#pragma unroll
                for (int mt = 0; mt < 2; ++mt) { o[mt][0] = (f32x4){0.f, 0.f, 0.f, 0.f}; o[mt][1] = (f32x4){0.f, 0.f, 0.f, 0.f}; }
                if (VAR != 1) {
                s16x4 qa[3][2][2];
#define SC_LOADQ(buf, ks_) do { _Pragma("unroll") for (int mt = 0; mt < 2; ++mt) { \
                    qa[buf][mt][0] = *(const LAS s16x4*)(st + SC_Q + (qoff0 ^ ((4 * ((ks_) & 3)) << 4)) + ((ks_) >> 2) * 256 + (2 * mh + mt) * 8192); \
                    qa[buf][mt][1] = *(const LAS s16x4*)(st + SC_Q + (qoff0 ^ ((4 * ((ks_) & 3) + 2) << 4)) + ((ks_) >> 2) * 256 + (2 * mh + mt) * 8192); } } while (0)
                SC_LOADQ(0, 0); SC_LOADQ(1, 1); __builtin_amdgcn_sched_barrier(0);
#pragma unroll
                for (int ks = 0; ks < 8; ++ks) {
                    if (ks < 6) SC_LOADQ((ks + 2) % 3, ks + 2);
                    __builtin_amdgcn_sched_barrier(0);
                    const bf16x8 sb0 = pack8(S[2 * ks][0], S[2 * ks + 1][0]), sb1 = pack8(S[2 * ks][1], S[2 * ks + 1][1]);
#pragma unroll
                    for (int mt = 0; mt < 2; ++mt) { const bf16x8 a_ = cat8(qa[ks % 3][mt][0], qa[ks % 3][mt][1]);
                        o[mt][0] = __builtin_amdgcn_mfma_f32_16x16x32_bf16(a_, sb0, o[mt][0], 0, 0, 0); o[mt][1] = __builtin_amdgcn_mfma_f32_16x16x32_bf16(a_, sb1, o[mt][1], 0, 0, 0); }
                    __builtin_amdgcn_sched_barrier(0);
                }
#undef SC_LOADQ
#pragma unroll
                for (int ks = 0; ks < 2; ++ks) { bf16x8 aa[2];
#pragma unroll
                    for (int mt = 0; mt < 2; ++mt) aa[mt] = *(const LAS bf16x8*)((ks ? ap1 : ap0) + (2 * mh + mt) * 2048);
                    __builtin_amdgcn_sched_barrier(0);
#pragma unroll
                    for (int mt = 0; mt < 2; ++mt) { o[mt][0] = __builtin_amdgcn_mfma_f32_16x16x32_bf16(aa[mt], vt[ks][0], o[mt][0], 0, 0, 0); o[mt][1] = __builtin_amdgcn_mfma_f32_16x16x32_bf16(aa[mt], vt[ks][1], o[mt][1], 0, 0, 0); }
                    __builtin_amdgcn_sched_barrier(0); }
                }
                if (mh == 1) { asm volatile("s_waitcnt lgkmcnt(0)" ::: "memory"); if (lane == 0) flags[8 + c] = (unsigned)(n + 1); }
                { int lo_ = (4 * g) * D + r; asm volatile("" : "+v"(lo_));
                  bf16* ob = O + (size_t)(row0 + 32 * mh) * D + h * 512 + dvb * 128 + 32 * c + lo_;
#pragma unroll
                  for (int mt = 0; mt < 2; ++mt)
#pragma unroll
                    for (int q = 0; q < 4; ++q) { ob[(16 * mt + q) * D] = f2bf(o[mt][0][q]); ob[(16 * mt + q) * D + 16] = f2bf(o[mt][1][q]); } }
            }
            sc_wait4(flags + 4, (unsigned)(n + 1));
            asm volatile("" ::: "memory");
            if (VAR != 1) {
            bf16x8 ka[3][2]; f32x4 dcv[3][2];
#define SC_LOADK(buf, bi) do { _Pragma("unroll") for (int t4 = 0; t4 < 2; ++t4) { const int ks_ = (bi) >> 3, t_ = 2 * ((bi) & 7) + t4; \
                ka[buf][t4] = *(const LAS bf16x8*)((ks_ ? kp1 : kp0) + t_ * 2048); \
                if ((bi) < 8) dcv[buf][t4] = *(const LAS f32x4*)(dec + t_ * 64); } } while (0)
            SC_LOADK(0, 0); SC_LOADK(1, 1); __builtin_amdgcn_sched_barrier(0);
#pragma unroll
            for (int bi = 0; bi < 16; ++bi) {
                if (bi < 14) SC_LOADK((bi + 2) % 3, bi + 2);
                __builtin_amdgcn_sched_barrier(0);
#pragma unroll
                for (int t4 = 0; t4 < 2; ++t4) { const int ks = bi >> 3, t = 2 * (bi & 7) + t4;
                    if (bi < 8) { S[t][0] = S[t][0] * dcv[bi % 3][t4]; S[t][1] = S[t][1] * dcv[bi % 3][t4]; }
                    S[t][0] = __builtin_amdgcn_mfma_f32_16x16x32_bf16(ka[bi % 3][t4], vt[ks][0], S[t][0], 0, 0, 0); S[t][1] = __builtin_amdgcn_mfma_f32_16x16x32_bf16(ka[bi % 3][t4], vt[ks][1], S[t][1], 0, 0, 0); }
                __builtin_amdgcn_sched_barrier(0);
            }
#undef SC_LOADK
            }
            asm volatile("s_waitcnt lgkmcnt(0)" ::: "memory");
            if (lane == 0) flags[12 + c] = (unsigned)(n + 1);
            if (n + 1 < 68) SC_LOADVT(n + 1);
        }
#undef SC_LOADVT
    }
    asm volatile("s_waitcnt vmcnt(0) lgkmcnt(0)" ::: "memory");
    __syncthreads();
#undef SC_CHUNK
}

__device__ __forceinline__ float xg_max(float x) {
    auto a = __builtin_amdgcn_permlane16_swap(__float_as_uint(x), __float_as_uint(x), false, false); x = fmaxf(__uint_as_float(a[0]), __uint_as_float(a[1]));
    auto b = __builtin_amdgcn_permlane32_swap(__float_as_uint(x), __float_as_uint(x), false, false); return fmaxf(__uint_as_float(b[0]), __uint_as_float(b[1]));
}
__device__ __forceinline__ float xg_sum(float x) {
    auto a = __builtin_amdgcn_permlane16_swap(__float_as_uint(x), __float_as_uint(x), false, false); x = __uint_as_float(a[0]) + __uint_as_float(a[1]);
    auto b = __builtin_amdgcn_permlane32_swap(__float_as_uint(x), __float_as_uint(x), false, false); return __uint_as_float(b[0]) + __uint_as_float(b[1]);
}
template <int AVAR> __device__ __forceinline__ void attn_unit(Frame& F, int l, int u, size_t ws_ax) {
    const bf16* QR = (const bf16*)(F.ws + WS_QR); const unsigned char* KR = F.ws + WS_KR; const unsigned char* VAT = F.ws + WS_VAT; bf16* AX = (bf16*)(F.ws + ws_ax);
    int b, kvh, qb, qrow0; bool lat;
    if (u < 512) { lat = true; b = u >> 8; kvh = (u >> 6) & 3; qb = u & 63; qrow0 = b * SEQ + 64 * qb; } else { const int v = u - 512; lat = false; b = v >> 4; kvh = (v >> 2) & 3; qb = v & 3; qrow0 = ML + b * CTXL + 64 * qb; }
    const int w = F.wave, lane = F.lane, r = lane & 15, g = lane >> 4, hq = kvh * 8 + w;
    LAS unsigned char* lds = F.lds;
    asm volatile("s_waitcnt lgkmcnt(0)\n\ts_barrier" ::: "memory");
    for (int idx = w; idx < 144; idx += 8) { const int j = idx >> 4, kind = (idx >> 3) & 1, q = idx & 7;
        int krow;
        if (j < 5) { const int t0 = 64 * qb - 128 + 64 * j; krow = (lat && t0 >= 0 && t0 < SEQ) ? b * SEQ + t0 : -1; } else krow = ML + b * CTXL + 64 * (j - 5);
        if (krow < 0 || AVAR == 1) continue;
        const int row = 8 * q + (lane >> 3), cc = (lane & 7) ^ ((row >> 1) & 7);
        if (kind == 0) glds16(KR + (size_t)(krow + row) * 512 + kvh * 128 + cc * 16, lds + j * 8192 + q * 1024);
        else glds16(VAT + ((size_t)(krow >> 6) * 4 + kvh) * 8192 + row * 128 + cc * 16, lds + 73728 + j * 8192 + q * 1024);
    }
    bf16x8 qf[4][2];
#pragma unroll
    for (int qt = 0; qt < 4; ++qt)
#pragma unroll
        for (int ks = 0; ks < 2; ++ks) qf[qt][ks] = *(const bf16x8*)(QR + (size_t)(qrow0 + 16 * qt + r) * D + hq * 64 + 32 * ks + 8 * g);
    int k64off[2], v64off[2][2];
#pragma unroll
    for (int ks = 0; ks < 2; ++ks) { k64off[ks] = r * 128 + (((4 * ks + g) ^ ((r >> 1) & 7)) << 4);
#pragma unroll
        for (int hs = 0; hs < 2; ++hs) v64off[ks][hs] = r * 128 + (((4 * ks + 2 * hs + (g >> 1)) ^ ((r >> 1) & 7)) << 4) + 8 * (g & 1); }
    const float sink = INP(I_SINK)[l * AHQ + hq] * 1.4426950408889634f;
    float mrow[4]; f32x4 lacc[4]; f32x4 O[4][4];
    const bf16x8 ones8 = (bf16x8){0x3F80, 0x3F80, 0x3F80, 0x3F80, 0x3F80, 0x3F80, 0x3F80, 0x3F80};
#pragma unroll
    for (int qt = 0; qt < 4; ++qt) { mrow[qt] = sink; lacc[qt] = (f32x4){1.f, 1.f, 1.f, 1.f};
#pragma unroll
        for (int dt = 0; dt < 4; ++dt) O[dt][qt] = (f32x4){0.f, 0.f, 0.f, 0.f}; }
    asm volatile("s_waitcnt vmcnt(0)\n\ts_barrier" ::: "memory");
    for (int j = 0; j < 9; ++j) {
        if (j < 5) { const int t0 = 64 * qb - 128 + 64 * j; if (!(lat && t0 >= 0 && t0 < SEQ)) continue; }
        const LAS unsigned char* Kt = lds + j * 8192; const LAS unsigned char* Vt = lds + 73728 + j * 8192;
        f32x4 Sc[4][4];
#pragma unroll
        for (int kk = 0; kk < 4; ++kk)
#pragma unroll
            for (int qt = 0; qt < 4; ++qt) Sc[kk][qt] = (f32x4){0.f, 0.f, 0.f, 0.f};
        { bf16x8 kaf[2][4];
#pragma unroll
            for (int kk = 0; kk < 4; ++kk) kaf[0][kk] = *(const LAS bf16x8*)(Kt + k64off[0] + kk * 2048);
        __builtin_amdgcn_sched_barrier(0);
#pragma unroll
        for (int ks = 0; ks < 2; ++ks) {
            if (ks == 0) {
#pragma unroll
                for (int kk = 0; kk < 4; ++kk) kaf[1][kk] = *(const LAS bf16x8*)(Kt + k64off[1] + kk * 2048);
            }
            __builtin_amdgcn_sched_barrier(0);
#pragma unroll
            for (int kk = 0; kk < 4; ++kk)
#pragma unroll
                for (int qt = 0; qt < 4; ++qt) { if (AVAR == 3) Sc[kk][qt][0] += __builtin_bit_cast(f32x4, kaf[ks][kk])[0]; else Sc[kk][qt] = __builtin_amdgcn_mfma_f32_16x16x32_bf16(kaf[ks][kk], qf[qt][ks], Sc[kk][qt], 0, 0, 0); }
            __builtin_amdgcn_sched_barrier(0); } }
        if (j == 0 || j == 4) {
#pragma unroll
            for (int kk = 0; kk < 4; ++kk)
#pragma unroll
                for (int qt = 0; qt < 4; ++qt)
#pragma unroll
                    for (int q = 0; q < 4; ++q) { const int ki = 16 * kk + 4 * g + q, qi = 16 * qt + r; const bool ok = (j == 0) ? (ki >= qi) : (ki <= qi); if (!ok) Sc[kk][qt][q] = -1e30f; }
        }
        bf16x8 pf[2][4];
        if (AVAR == 2) {
#pragma unroll
            for (int qt = 0; qt < 4; ++qt) { pf[0][qt] = pack8b(Sc[0][qt], Sc[1][qt]); pf[1][qt] = pack8b(Sc[2][qt], Sc[3][qt]); }
        } else {
            float mx[4]; bool grow = false;
#pragma unroll
            for (int qt = 0; qt < 4; ++qt) { float v = -1e30f;
#pragma unroll
                for (int kk = 0; kk < 4; ++kk) v = fmaxf(v, fmaxf(fmaxf(Sc[kk][qt][0], Sc[kk][qt][1]), fmaxf(Sc[kk][qt][2], Sc[kk][qt][3])));
                mx[qt] = xg_max(v); grow |= (mx[qt] > mrow[qt] + 8.0f); }
            if (__any(grow)) {
#pragma unroll
                for (int qt = 0; qt < 4; ++qt) { const float mn = fmaxf(mrow[qt], mx[qt]), sc = __builtin_amdgcn_exp2f(mrow[qt] - mn); mrow[qt] = mn; lacc[qt] = lacc[qt] * sc;
#pragma unroll
                    for (int dt = 0; dt < 4; ++dt) O[dt][qt] = O[dt][qt] * sc; }
            }
#pragma unroll
            for (int qt = 0; qt < 4; ++qt) { const float mn = mrow[qt];
#pragma unroll
                for (int kk = 0; kk < 4; ++kk)
#pragma unroll
                    for (int q = 0; q < 4; ++q) Sc[kk][qt][q] = __builtin_amdgcn_exp2f(Sc[kk][qt][q] - mn);
                pf[0][qt] = pack8b(Sc[0][qt], Sc[1][qt]); pf[1][qt] = pack8b(Sc[2][qt], Sc[3][qt]); }
        }
#pragma unroll
        for (int ks = 0; ks < 2; ++ks)
#pragma unroll
            for (int qt = 0; qt < 4; ++qt) lacc[qt] = __builtin_amdgcn_mfma_f32_16x16x32_bf16(ones8, pf[ks][qt], lacc[qt], 0, 0, 0);
        s16x4 vaf[2][4][2];
#pragma unroll
        for (int dt = 0; dt < 4; ++dt) { vaf[0][dt][0] = *(const LAS s16x4*)(Vt + v64off[0][0] + dt * 2048); vaf[0][dt][1] = *(const LAS s16x4*)(Vt + v64off[0][1] + dt * 2048); }
        __builtin_amdgcn_sched_barrier(0);
#pragma unroll
        for (int ks = 0; ks < 2; ++ks) {
            if (ks == 0) {
#pragma unroll
                for (int dt = 0; dt < 4; ++dt) { vaf[1][dt][0] = *(const LAS s16x4*)(Vt + v64off[1][0] + dt * 2048); vaf[1][dt][1] = *(const LAS s16x4*)(Vt + v64off[1][1] + dt * 2048); }
            }
            __builtin_amdgcn_sched_barrier(0);
#pragma unroll
            for (int dt = 0; dt < 4; ++dt)
#pragma unroll
                for (int qt = 0; qt < 4; ++qt) { if (AVAR == 3) O[dt][qt][0] += __builtin_bit_cast(f32x4, pf[ks][qt])[0] + (float)vaf[ks][dt][0][0]; else O[dt][qt] = __builtin_amdgcn_mfma_f32_16x16x32_bf16(cat8(vaf[ks][dt][0], vaf[ks][dt][1]), pf[ks][qt], O[dt][qt], 0, 0, 0); }
            __builtin_amdgcn_sched_barrier(0); }
    }
    { int lo_ = r * D + 4 * g; asm volatile("" : "+v"(lo_));
      bf16* ab = AX + (size_t)qrow0 * D + hq * 64 + lo_;
#pragma unroll
      for (int qt = 0; qt < 4; ++qt) { const float il = 1.0f / lacc[qt][0];
#pragma unroll
        for (int dt = 0; dt < 4; ++dt) { u32x2 wv; wv.x = cvt_pk_bf16(O[dt][qt][0] * il, O[dt][qt][1] * il); wv.y = cvt_pk_bf16(O[dt][qt][2] * il, O[dt][qt][3] * il);
            *(u32x2*)(ab + (size_t)(16 * qt) * D + 16 * dt) = wv; } } }
}
__device__ __forceinline__ void mix_fast_phase(Frame& F, int l, size_t ws_ax, int parts) {
    if (F.bid < 64) { if (parts & 1) { if (parts & 16) gla_scan<1>(F, F.bid); else if (parts & 32) gla_scan<2>(F, F.bid); else gla_scan<0>(F, F.bid); } return; }
    const int nu = (l == 0) ? 544 : 512;
    if (parts & 2) { if (parts & 64) { for (int u = F.bid - 64; u < nu; u += F.G - 64) attn_unit<1>(F, l, u, ws_ax); }
                     else if (parts & 128) { for (int u = F.bid - 64; u < nu; u += F.G - 64) attn_unit<2>(F, l, u, ws_ax); }
                     else if (parts & 256) { for (int u = F.bid - 64; u < nu; u += F.G - 64) attn_unit<3>(F, l, u, ws_ax); }
                     else { for (int u = F.bid - 64; u < nu; u += F.G - 64) attn_unit<0>(F, l, u, ws_ax); } }
    asm volatile("s_waitcnt vmcnt(0) lgkmcnt(0)\n\ts_barrier" ::: "memory");
    if ((parts & 3) == 3 && F.G == 256) { convert_range(F, l == 0 ? CV_MIX0 + (F.bid - 64) * CVQ_MIX : CV_MIX1 + (F.bid - 64) * CVQ_MIX1, l == 0 ? CVQ_MIX : CVQ_MIX1);
        if (l == 0 && CVX_MIX0 > 0) convert_range(F, CV_MIX0X + (F.bid - 64) * CVX_MIX0, CVX_MIX0); }
}
#if MIXCHECK
__device__ __forceinline__ void mixcheck_phase(Frame& F, int l) {
    const size_t gt = (size_t)F.vcu * 512 + F.tid, NT = (size_t)F.G * 512; const size_t n = (size_t)((l == 0) ? MT : ML) * D;
    const bf16* OFa = (const bf16*)(F.ws + WS_OF); const bf16* OBa = (const bf16*)(F.ws + WS_OB);
    const bf16* OF2 = (const bf16*)(F.ws + WS_OF2); const bf16* OB2 = (const bf16*)(F.ws + WS_OB2);
    const bf16* AXa = (const bf16*)(F.ws + WS_AX); const bf16* AX2 = (const bf16*)(F.ws + WS_AX2);
    float dg = 0.f, ng = 0.f, da = 0.f, na = 0.f;
    for (size_t i = gt; i < n; i += NT) { const float a = bf2f(OFa[i]) + bf2f(OBa[i]), b = bf2f(OF2[i]) + bf2f(OB2[i]); dg += (a - b) * (a - b); ng += b * b; const float c = bf2f(AXa[i]), e = bf2f(AX2[i]); da += (c - e) * (c - e); na += e * e; }
    dg = wave_sum(dg); ng = wave_sum(ng); da = wave_sum(da); na = wave_sum(na);
    if (F.lane == 0) { float* acc = (float*)(F.ctl + CW_CHK) + 4 * l; atomicAdd(acc + 0, dg); atomicAdd(acc + 1, ng); atomicAdd(acc + 2, da); atomicAdd(acc + 3, na); }
}
#endif

constexpr int NPH = 22;
struct Args { const float* in[28]; float* out; unsigned char* ws; int ph_lo, ph_hi; };
__device__ __forceinline__ void make_frame(Frame& F, const Args& args, unsigned char* lds_raw) {
    int tid = threadIdx.x; asm volatile("" : "+v"(tid));
    int G = gridDim.x, bx = blockIdx.x; asm volatile("" : "+s"(G), "+s"(bx));
    GAS unsigned char* ws = (GAS unsigned char*)args.ws; asm volatile("" : "+s"(ws));
    F.lds = (LAS unsigned char*)lds_raw;
    F.tid = tid; F.lane = tid & 63; F.wave = __builtin_amdgcn_readfirstlane(tid >> 6);
    F.G = G; F.bid = bx; F.vcu = (G % 8 == 0) ? (bx % 8) * (G / 8) + bx / 8 : bx;
    const __attribute__((address_space(4))) void* ka = (const __attribute__((address_space(4))) void*)__builtin_amdgcn_kernarg_segment_ptr(); asm volatile("" : "+s"(ka));
    F.in = (in_table_t)ka; F.out = args.out; F.ws = (unsigned char*)ws; F.ctl = (unsigned*)(F.ws + WS_CTL);
}
__global__ void __launch_bounds__(512, 2) fwd_kernel(Args args) {
    extern __shared__ __attribute__((aligned(16))) unsigned char lds_raw[];
    volatile LAS unsigned* MISC = (volatile LAS unsigned*)((LAS unsigned char*)lds_raw + MISC_OFF);
    if (threadIdx.x < 32) MISC[threadIdx.x] = 0u;
    __syncthreads();
    XcdBarrier bar; bar.bar = (unsigned*)(args.ws + WS_CTL) + CW_BAR; bar.x = 0; bar.st = MISC + 8;
    const int lo = args.ph_lo, hi = args.ph_hi;
    if (hi - lo > 1) bar = xcd_barrier_post((unsigned*)(args.ws + WS_CTL) + CW_BAR, MISC + 8);
#ifndef PHMASK
#define PHMASK 0xFFFFFFFFu
#endif
#define IN(k) (((PHMASK >> (k)) & 1u) && lo <= (k) && (k) < hi)
#define SEAM(k) do { if (lo <= (k) && (k) + 1 < hi) xcd_barrier(bar); } while (0)
#define REP(k) for (int rep_ = 0; rep_ < (((PROBE_MASK >> (k)) & 1u) ? 2 : 1); ++rep_)
#define REPBAR(k) do { if (((PROBE_MASK >> (k)) & 1u) && rep_ == 0) xcd_barrier(bar); } while (0)
#define PHASE_BEGIN Frame F; make_frame(F, args, lds_raw); unsigned char* ws = F.ws; int l = l_; asm volatile("" : "+s"(l)); (void)ws; (void)l;

    { const int l_ = 0; REP(0) { if (IN(0)) { PHASE_BEGIN p0_weights(F); p0_mod(F); } REPBAR(0); } SEAM(0); }
    { const int l_ = 0; REP(1) { if (IN(1)) { PHASE_BEGIN t1_phase(F); } REPBAR(1); } SEAM(1); }
    for (int l_ = 0; l_ < 2; ++l_) {
        const int pb = 2 + 10 * l_;
        REP(pb + 0) { if (IN(pb + 0)) { PHASE_BEGIN
            pg::SchedDense S; S.init(ws + WS_HX, ws + WS_WIN + l * SZ_WIN, l == 0 ? MT : ML, NP, D, F.G, F.bid, l == 0 ? 0 : 30);
            pg::EpiBf16 E{(bf16*)(ws + WS_P), NP, 0, (bf16*)(ws + WS_LRB + (size_t)l * SZ_LRB), OLR / 256};
            if (((PROBE_MASK >> (pb + 0)) & 1u) && rep_ == 0) E.skip = PROBE_PARTS;
            pg::gemm_phase<pg::EpiBf16, pg::SchedDense, true>(F.lds, F.tid, S, E);
        } REPBAR(pb + 0); } SEAM(pb + 0);
#if MIXCHECK
        REP(pb + 1) { if (IN(pb + 1)) { PHASE_BEGIN prep_phase(F, l); __syncthreads(); prep_fast_phase(F, l, 7); } REPBAR(pb + 1); } SEAM(pb + 1);
        REP(pb + 2) { if (IN(pb + 2)) { PHASE_BEGIN if (F.bid < 64) mix_simple_gla(F, F.bid, WS_OF2, WS_OB2); else mix_simple_attn(F, l, F.bid - 64, F.G - 64, WS_AX2);
            __syncthreads(); mix_fast_phase(F, l, WS_AX, 3); } REPBAR(pb + 2); } SEAM(pb + 2);
#elif FAST_MIX
        REP(pb + 1) { if (IN(pb + 1)) { PHASE_BEGIN if (rep_ == 0) prep_fast_phase(F, l, 7); else prep_fast_phase(F, l, PROBE_PARTS); } REPBAR(pb + 1); } SEAM(pb + 1);
        REP(pb + 2) { if (IN(pb + 2)) { PHASE_BEGIN if (((PROBE_MASK >> (pb + 2)) & 1u) && rep_ == 0) mix_fast_phase(F, l, WS_AX, PROBE_PARTS); else mix_fast_phase(F, l, WS_AX, 3); } REPBAR(pb + 2); } SEAM(pb + 2);
#else
        REP(pb + 1) { if (IN(pb + 1)) { PHASE_BEGIN prep_phase(F, l); } REPBAR(pb + 1); } SEAM(pb + 1);
        REP(pb + 2) { if (IN(pb + 2)) { PHASE_BEGIN if (F.bid < 64) mix_simple_gla(F, F.bid, WS_OF, WS_OB); else mix_simple_attn(F, l, F.bid - 64, F.G - 64, WS_AX); } REPBAR(pb + 2); } SEAM(pb + 2);
#endif
#if MIXCHECK
        REP(pb + 3) { if (IN(pb + 3)) { PHASE_BEGIN mixcheck_phase(F, l); ro_phase(F, l); } REPBAR(pb + 3); } SEAM(pb + 3);
#else
        REP(pb + 3) { if (IN(pb + 3)) { PHASE_BEGIN ro_phase(F, l); } REPBAR(pb + 3); } SEAM(pb + 3);
#endif
        REP(pb + 4) { if (IN(pb + 4)) { PHASE_BEGIN
            pg::SchedBranch S; S.init(ws + WS_GX, ws + WS_AX, ws + WS_WBG + l * SZ_WSQ, ws + WS_WBA + l * SZ_WSQ, l == 0 ? MT : ML, D, D, F.G, F.bid);
            pg::EpiBranch E{(const bf16*)(ws + WS_P), (bf16*)(ws + WS_O1), D};
            pg::gemm_phase<pg::EpiBranch, pg::SchedBranch, true>(F.lds, F.tid, S, E);
            if (CVQ_G2 > 0 && l == 0 && F.G == 256 && F.bid >= 16) convert_range(F, CV_G2 + (F.bid - 16) * CVQ_G2, CVQ_G2);
        } REPBAR(pb + 4); } SEAM(pb + 4);
        REP(pb + 5) { if (IN(pb + 5)) { PHASE_BEGIN
            if (CTX_SPLIT && l == 0) {
                pg::SchedCtxSplit S; S.init(ws + WS_O1, ws + WS_WO, D, D, F.G, F.bid, YP_S3);
                pg::EpiBf16Ctx E{(bf16*)(ws + WS_Y), (float*)(ws + WS_YP), D};
                pg::gemm_phase<pg::EpiBf16Ctx, pg::SchedCtxSplit, true>(F.lds, F.tid, S, E);
            } else {
            pg::SchedDense S; S.init(ws + WS_O1, ws + WS_WO + l * SZ_WSQ, l == 0 ? MT : ML, D, D, F.G, F.bid, 0);
            pg::EpiBf16 E{(bf16*)(ws + WS_Y), D};
            pg::gemm_phase<pg::EpiBf16, pg::SchedDense, true>(F.lds, F.tid, S, E);
            }
        } REPBAR(pb + 5); } SEAM(pb + 5);
        REP(pb + 6) { if (IN(pb + 6)) { PHASE_BEGIN t3_phase(F, l); } REPBAR(pb + 6); } SEAM(pb + 6);
        if (l_ == 0) {
            REP(pb + 7) { if (IN(pb + 7)) { PHASE_BEGIN
#if DENSE_FP8 == 1
                pg::SchedDense S; S.init(ws + WS_HX8, ws + WS_FGU, MT, NGU, D / 2, F.G, F.bid, 0); S.sa = X8_E; S.sb = W8_E;
                pg::EpiSwiGLU8 E{ws + WS_P, DFF, H8_SCALE};
                pg::gemm_phase<pg::EpiSwiGLU8, pg::SchedDense, true, true, D / 2>(F.lds, F.tid, S, E);
#elif DENSE_FP8 == 2
                pg::SchedDense S; S.init(ws + WS_HX8, ws + WS_FGU, MT, NGU, D / 2, F.G, F.bid, 0); S.sa = X8_E; S.sb = W8_E;
                pg::EpiSwiGLU E{(bf16*)(ws + WS_P), DFF};
                pg::gemm_phase<pg::EpiSwiGLU, pg::SchedDense, true, true, D / 2>(F.lds, F.tid, S, E);
#else
                pg::SchedDense S; S.init(ws + WS_HX, ws + WS_FGU, MT, NGU, D, F.G, F.bid, 0);
                pg::EpiSwiGLU E{(bf16*)(ws + WS_P), DFF};
                pg::gemm_phase<pg::EpiSwiGLU, pg::SchedDense, true>(F.lds, F.tid, S, E);
#endif
            } REPBAR(pb + 7); } SEAM(pb + 7);
            REP(pb + 8) { if (IN(pb + 8)) { PHASE_BEGIN
#if DENSE_FP8 == 1
                pg::SchedDense S; S.init(ws + WS_P, ws + WS_FDN, MT, D, DFF / 2, F.G, F.bid, 0); S.sa = H8_E; S.sb = W8_E;
                pg::EpiBf16 E{(bf16*)(ws + WS_Y), D};
                pg::gemm_phase<pg::EpiBf16, pg::SchedDense, true, true, DFF / 2>(F.lds, F.tid, S, E);
#else
#if CTX_SPLIT
                pg::SchedCtxSplit S; S.init(ws + WS_P, ws + WS_FDN, D, DFF, F.G, F.bid, YP_S5);
                pg::EpiBf16Ctx E{(bf16*)(ws + WS_Y), (float*)(ws + WS_YP), D};
                pg::gemm_phase<pg::EpiBf16Ctx, pg::SchedCtxSplit, true>(F.lds, F.tid, S, E);
#else
                pg::SchedDense S; S.init(ws + WS_P, ws + WS_FDN, MT, D, DFF, F.G, F.bid, 0);
                pg::EpiBf16 E{(bf16*)(ws + WS_Y), D};
                pg::gemm_phase<pg::EpiBf16, pg::SchedDense, true>(F.lds, F.tid, S, E);
#endif
#endif
            } REPBAR(pb + 8); } SEAM(pb + 8);
        } else {
            REP(pb + 7) { if (IN(pb + 7)) { PHASE_BEGIN
#if MOE_FP8
                pg::SchedMoe<true> S; S.init(ws + WS_HX8, ws + WS_EGU, SZ_GU / 2, F.ctl + CW_CNT, (const int*)(ws + WS_LIST), NGU, D / 2, F.G, F.bid); S.sa = X8_E; S.sb = W8_E;
                pg::EpiSwiGLU8 E{ws + WS_P, DFF, H8_SCALE};
                pg::gemm_phase<pg::EpiSwiGLU8, pg::SchedMoe<true>, true, true, D / 2>(F.lds, F.tid, S, E);
#else
                pg::SchedMoe<true> S; S.init(ws + WS_HX, ws + WS_EGU, SZ_GU, F.ctl + CW_CNT, (const int*)(ws + WS_LIST), NGU, D, F.G, F.bid);
                pg::EpiSwiGLU E{(bf16*)(ws + WS_P), DFF};
                pg::gemm_phase<pg::EpiSwiGLU, pg::SchedMoe<true>, true>(F.lds, F.tid, S, E);
#endif
            } REPBAR(pb + 7); } SEAM(pb + 7);
            REP(pb + 8) { if (IN(pb + 8)) { PHASE_BEGIN
#if MOE_FP8
                pg::SchedMoe<false> S; S.init(ws + WS_P, ws + WS_EDN, SZ_DN / 2, F.ctl + CW_CNT, (const int*)(ws + WS_LIST), D, DFF / 2, F.G, F.bid); S.sa = H8_E; S.sb = W8_E;
                pg::EpiBf16 E{(bf16*)(ws + WS_LAF), D};
                pg::gemm_phase<pg::EpiBf16, pg::SchedMoe<false>, true, true, DFF / 2>(F.lds, F.tid, S, E);
#else
                pg::SchedMoe<false> S; S.init(ws + WS_P, ws + WS_EDN, SZ_DN, F.ctl + CW_CNT, (const int*)(ws + WS_LIST), D, DFF, F.G, F.bid);
                pg::EpiBf16 E{(bf16*)(ws + WS_LAF), D};
                pg::gemm_phase<pg::EpiBf16, pg::SchedMoe<false>, true>(F.lds, F.tid, S, E);
#endif
            } REPBAR(pb + 8); } SEAM(pb + 8);
        }
        REP(pb + 9) { if (IN(pb + 9)) { PHASE_BEGIN t5_phase(F, l); } REPBAR(pb + 9); } SEAM(pb + 9);
    }
#undef IN
#undef SEAM
}

extern "C" void kernel_launch(void* const* d_in, const int* in_sizes, int n_in, void* d_out, int out_size, void* d_ws, size_t ws_size, hipStream_t stream) {
    static int grid = 0;
    if (grid == 0) {
        if (n_in != 28 || in_sizes[0] != ML * D || out_size != ML * D || ws_size < WS_END) { fprintf(stderr, "kernel_launch: unexpected problem (n_in %d, in0 %d, out %d, ws %zu < %zu); nothing launched\n", n_in, n_in > 0 ? in_sizes[0] : -1, out_size, ws_size, (size_t)WS_END); grid = -1; return; }
        int dev = 0, cus = 0, per_cu = 0;
        if (hipGetDevice(&dev) != hipSuccess || hipDeviceGetAttribute(&cus, hipDeviceAttributeMultiprocessorCount, dev) != hipSuccess) { grid = -1; return; }
        if (hipFuncSetAttribute((const void*)fwd_kernel, hipFuncAttributeMaxDynamicSharedMemorySize, LDS_BYTES) != hipSuccess) { fprintf(stderr, "kernel_launch: hipFuncSetAttribute failed\n"); grid = -1; return; }
        if (hipOccupancyMaxActiveBlocksPerMultiprocessor(&per_cu, (const void*)fwd_kernel, 512, LDS_BYTES) != hipSuccess || per_cu < 1) fprintf(stderr, "kernel_launch: occupancy query reports %d\n", per_cu);
        (void)hipGetLastError();
        grid = cus;
    }
    if (grid < 0) return;
    if (hipMemsetAsync((char*)d_ws + WS_CTL, 0, CTL_ZERO_BYTES, stream) != hipSuccess) return;
    Args a{};
    for (int i = 0; i < 28; ++i) a.in[i] = (const float*)d_in[i];
    a.out = (float*)d_out; a.ws = (unsigned char*)d_ws;
#if MK_N_LAUNCHES == 1
    a.ph_lo = 0; a.ph_hi = NPH;
    hipLaunchKernelGGL(fwd_kernel, dim3(grid), dim3(512), LDS_BYTES, stream, a);
#else
    for (int p = 0; p < NPH; ++p) { a.ph_lo = p; a.ph_hi = p + 1; hipLaunchKernelGGL(fwd_kernel, dim3(grid), dim3(512), LDS_BYTES, stream, a); }
#endif
}
```

```cpp
#include <hip/hip_runtime.h>
#include <cstdio>
#include <cstdint>

#ifndef FAST_MIX
#define FAST_MIX 1
#endif
#ifndef MIXCHECK
#define MIXCHECK 0
#endif
#ifndef MIXCHECK_TOL
#define MIXCHECK_TOL 1e-3f
#endif
#ifndef PROBE_PARTS
#define PROBE_PARTS 3
#endif
#ifndef PROBE_MASK
#define PROBE_MASK 0u
#endif
#ifndef MOE_FP8
#define MOE_FP8 1
#endif
#ifndef DENSE_FP8
#define DENSE_FP8 2
#endif
#ifndef CTX_SPLIT
#define CTX_SPLIT 1
#endif
#ifndef MK_N_LAUNCHES
#define MK_N_LAUNCHES 1
#endif

#define LAS __attribute__((address_space(3)))
#define GAS __attribute__((address_space(1)))
typedef unsigned short bf16;
typedef short bf16x8 __attribute__((ext_vector_type(8)));
typedef float f32x4 __attribute__((ext_vector_type(4)));
typedef float f32x2 __attribute__((ext_vector_type(2)));
typedef unsigned u32x4 __attribute__((ext_vector_type(4)));
typedef unsigned u32x2 __attribute__((ext_vector_type(2)));
typedef int v4i_t __attribute__((ext_vector_type(4)));
typedef int v8i_t __attribute__((ext_vector_type(8)));

constexpr int D = 2048, NB = 2, SEQ = 4096, CTXL = 256, ML = NB * SEQ, MC = NB * CTXL, MT = ML + MC;
constexpr int DIN = 12832, NP = 13056;
constexpr int OQ = 0, OKK = 1024, OV = 2048, ORG = 4096, OAQ = 6144, OAK = 8192, OAV = 8448, OG9 = 8704, OG10 = 10752, OLR = 12800;
constexpr int DFF = 5632, NE = 8, NGU = 2 * DFF;
constexpr int GH = 4, GDK = 256, GDV = 512;
constexpr int AHQ = 32, AHKV = 4, AHD = 64, AWIN = 128;
constexpr float RMS_EPS = 1e-6f;
constexpr float W8_SCALE = 64.0f, X8_SCALE = 16.0f, H8_SCALE = 8.0f; constexpr int W8_E = 127 - 6, X8_E = 127 - 4, H8_E = 127 - 3;
constexpr int MOE_CAP = 8192;
constexpr int MOE_ROWS = 2 * ML + NE * 256;

constexpr size_t MiB = 1u << 20;
constexpr size_t WS_CTL = 0, CTL_ZERO_BYTES = 1 * MiB;
constexpr size_t WS_MOD = 1 * MiB;
constexpr size_t SZ_WIN = (size_t)NP * D * 2, SZ_WSQ = (size_t)D * D * 2, SZ_GU = (size_t)NGU * D * 2, SZ_DN = (size_t)D * DFF * 2;
constexpr size_t WS_WIN = 2 * MiB;
constexpr size_t WS_WBG = WS_WIN + 2 * SZ_WIN, WS_WBA = WS_WBG + 2 * SZ_WSQ, WS_WO = WS_WBA + 2 * SZ_WSQ;
constexpr size_t WS_FGU = WS_WO + 2 * SZ_WSQ, WS_FDN = WS_FGU + SZ_GU;
constexpr size_t WS_EGU = WS_FDN + SZ_DN, WS_EDN = WS_EGU + NE * SZ_GU;
constexpr size_t WS_WEND = WS_EDN + NE * SZ_DN;
constexpr size_t alignup(size_t x) { return (x + MiB - 1) / MiB * MiB; }
constexpr size_t WS_XS = alignup(WS_WEND);
constexpr size_t WS_HX = WS_XS + alignup((size_t)MT * D * 4);
constexpr size_t WS_P = WS_HX + alignup((size_t)MT * D * 2);
constexpr size_t SZ_P = alignup((size_t)MT * NP * 2);
static_assert((size_t)MOE_ROWS * DFF * 2 <= SZ_P, "H_moe overlays P");
constexpr size_t WS_LAF = WS_P + SZ_P;
constexpr size_t WS_LAB = WS_LAF + alignup((size_t)MT * 1024 * 4);
constexpr size_t WS_OF = WS_LAB + alignup((size_t)MT * 1024 * 4);
constexpr size_t WS_OB = WS_OF + alignup((size_t)MT * D * 4);
constexpr size_t WS_QR = WS_OB + alignup((size_t)MT * D * 4);
static_assert((size_t)MOE_ROWS * D * 4 <= WS_QR - WS_LAF, "YM overlays LA/OF/OB");
constexpr size_t WS_KR = WS_QR + alignup((size_t)MT * D * 2);
constexpr size_t WS_GX = WS_KR + alignup((size_t)MT * 256 * 2);
constexpr size_t WS_AX = WS_GX + alignup((size_t)MT * D * 2);
constexpr size_t WS_O1 = WS_AX + alignup((size_t)MT * D * 2);
constexpr size_t WS_Y = WS_O1 + alignup((size_t)MT * D * 2);
constexpr size_t WS_YP = WS_OF;
constexpr int YP_S3 = 8, YP_S5 = 11, YP_S2 = 4;
constexpr size_t WS_YP2 = WS_OB;
static_assert((size_t)2 * YP_S2 * MC * D * 4 <= (size_t)MT * D * 4 && (size_t)YP_S3 * MC * D * 4 <= (size_t)MT * D * 4, "YP2 fits OB, G3's YP fits OF");
static_assert((size_t)YP_S5 * MC * D * 4 <= 2 * ((size_t)MT * D * 4), "YP fits OF|OB");
constexpr size_t WS_HX8 = WS_O1;
constexpr size_t WS_LIST = WS_Y + alignup((size_t)MT * D * 4);
constexpr size_t WS_TINFO = WS_LIST + (size_t)NE * MOE_CAP * 4;
constexpr int NIT = NB * GH * 68;
constexpr size_t WS_QIN = alignup(WS_TINFO + (size_t)ML * 8 * 4);
constexpr size_t SZ_QIN = (size_t)MT * 1024 * 2;
constexpr size_t WS_KTO = WS_QIN + alignup(2 * SZ_QIN);
constexpr size_t SZ_KTO = (size_t)NIT * 256 * 64 * 2;
constexpr size_t WS_AIN = WS_KTO + alignup(2 * SZ_KTO);
constexpr size_t SZ_AIN = (size_t)NIT * 64 * 64 * 2;
constexpr size_t WS_DEC = WS_AIN + alignup(2 * SZ_AIN);
constexpr size_t SZ_DEC = (size_t)NIT * 256 * 4;
constexpr size_t WS_VT = WS_DEC + alignup(2 * SZ_DEC);
constexpr size_t WS_VAT = WS_VT + alignup((size_t)NIT * 512 * 64 * 2);
constexpr size_t WS_CHK = WS_VAT + alignup((size_t)(MT / 64) * 4 * 64 * 64 * 2);
constexpr size_t WS_LRB = WS_CHK;
constexpr size_t SZ_LRB = (size_t)MT * 256 * 2;
constexpr size_t WS_END = WS_LRB + alignup(2 * SZ_LRB);
constexpr size_t WS_OF2 = WS_Y, WS_OB2 = WS_Y + alignup((size_t)MT * D * 2), WS_AX2 = WS_O1;
constexpr int CW_CNT = 64;
constexpr int CW_G2RED = 160;
constexpr int CW_ROPE = 96;
constexpr int CW_CHK = 128;
constexpr int CW_BAR = 4096;

constexpr int RING_BYTES = 131072;
constexpr int MISC_OFF = 147456;
constexpr int LDS_BYTES = 151552;

__device__ __forceinline__ unsigned cvt_pk_bf16(float lo, float hi) { unsigned r; asm volatile("v_cvt_pk_bf16_f32 %0, %1, %2" : "=v"(r) : "v"(lo), "v"(hi)); return r; }
__device__ __forceinline__ bf16 f2bf(float f) { return (bf16)(cvt_pk_bf16(f, 0.f) & 0xffffu); }
__device__ __forceinline__ float bf2f(bf16 b) { return __uint_as_float(((unsigned)b) << 16); }
__device__ __forceinline__ float bflo(unsigned w) { return __uint_as_float(w << 16); }
__device__ __forceinline__ float bfhi(unsigned w) { return __uint_as_float(w & 0xffff0000u); }
__device__ __forceinline__ float wave_sum(float v) {
    v += __builtin_bit_cast(float, __builtin_amdgcn_update_dpp(0, __builtin_bit_cast(int, v), 0xB1, 0xF, 0xF, true));
    v += __builtin_bit_cast(float, __builtin_amdgcn_update_dpp(0, __builtin_bit_cast(int, v), 0x4E, 0xF, 0xF, true));
    v += __builtin_bit_cast(float, __builtin_amdgcn_update_dpp(0, __builtin_bit_cast(int, v), 0x124, 0xF, 0xF, true));
    v += __builtin_bit_cast(float, __builtin_amdgcn_update_dpp(0, __builtin_bit_cast(int, v), 0x128, 0xF, 0xF, true));
    auto a = __builtin_amdgcn_permlane16_swap(__float_as_uint(v), __float_as_uint(v), false, false); v = __uint_as_float(a[0]) + __uint_as_float(a[1]);
    auto b = __builtin_amdgcn_permlane32_swap(__float_as_uint(v), __float_as_uint(v), false, false); return __uint_as_float(b[0]) + __uint_as_float(b[1]);
}
__device__ __forceinline__ float sigmoidf_(float x) { return 1.0f / (1.0f + __expf(-x)); }
__device__ __forceinline__ float siluf_(float x) { return x / (1.0f + __expf(-x)); }
__device__ __forceinline__ float logsigf_(float z) { return fminf(z, 0.f) - log1pf(__expf(-fabsf(z))); }
__device__ __forceinline__ unsigned pk4_fp8(float a, float b, float c, float d) {
    a = __builtin_amdgcn_fmed3f(a, -448.f, 448.f); b = __builtin_amdgcn_fmed3f(b, -448.f, 448.f); c = __builtin_amdgcn_fmed3f(c, -448.f, 448.f); d = __builtin_amdgcn_fmed3f(d, -448.f, 448.f);
    int w = 0; w = __builtin_amdgcn_cvt_pk_fp8_f32(a, b, w, false); w = __builtin_amdgcn_cvt_pk_fp8_f32(c, d, w, true); return (unsigned)w; }
#define LDS_WAIT() asm volatile("s_waitcnt lgkmcnt(0)" ::: "memory")
#define VM_WAIT() asm volatile("s_waitcnt vmcnt(0)" ::: "memory")

namespace pg {
constexpr int BM = 256, BK = 64, HALF = 128, HTB = HALF * BK * 2, STAGE_BYTES = 8 * HTB, NXCD = 8, WGM = 8;
__host__ __device__ __forceinline__ int lds_byte(int r, int c) { const int st = (r >> 4) * 2 + (c >> 5), rr = r & 15, cc = c & 31, ob = rr * 64 + cc * 2; return st * 1024 + (ob ^ (((ob >> 9) & 1) << 5)); }
__host__ __device__ __forceinline__ void stage_rc(int b, int& R, int& C) { const int st = b / 1024, sb = b % 1024, swz = sb ^ (((sb >> 9) & 1) << 5); R = (st >> 1) * 16 + swz / 64; C = (st & 1) * 32 + (swz % 64) / 2; }
__host__ __device__ __forceinline__ int perm32(int rho) { const int n = rho >> 4, i = rho & 15; return 8 * (i >> 2) + 4 * n + (i & 3); }

struct Unit { int pm, pn, e, pl; };

__device__ __forceinline__ void tile_of(int L, int nM, int nN, int& pm, int& pn) {
    const int nwg = nM * nN; int wgid = L;
    { const int q = nwg / NXCD, r = nwg % NXCD, xcd = wgid % NXCD, off = wgid / NXCD; wgid = (xcd < r ? xcd * (q + 1) : r * (q + 1) + (xcd - r) * q) + off; }
    const int nig = WGM * nN, gid = wgid / nig, fm = gid * WGM, gsz = (nM - fm) < WGM ? (nM - fm) : WGM;
    pm = fm + ((wgid % nig) % gsz); pn = (wgid % nig) / gsz;
}
struct SchedDense {
    static constexpr bool GATHER = false;
    const char* A; const char* Bt; int K, nM, nN, nwg, G, c, nex, sa = 127, sb = 127;
    __device__ __forceinline__ void init(const void* A_, const void* Bt_, int M, int N, int K_, int G_, int c_, int nex_) { A = (const char*)A_; Bt = (const char*)Bt_; K = K_; nM = M / BM; nN = N / BM; nwg = nM * nN; G = G_; c = c_; nex = nex_; }
    __device__ __forceinline__ bool next(int i, Unit& u) const {
        const int L = i * G + c; u.e = 0; u.pl = 0;
        if (L < nwg) { tile_of(L, nM, nN, u.pm, u.pn); return true; }
        if (L < nwg + nex) { const int j = L - nwg, t = j % 15; u.pm = 32 + j / 15; u.pn = t < 12 ? 4 + t : (t < 14 ? 32 + (t - 12) : 50); return true; }
        return false;
    }
    __device__ __forceinline__ const char* a_base(const Unit& u) const { return A + (size_t)u.pm * BM * K * 2; }
    __device__ __forceinline__ const char* b_base(const Unit& u) const { return Bt + (size_t)u.pn * BM * K * 2; }
    __device__ __forceinline__ void a_offs(const Unit&, const int (&)[2], const int (&)[2], unsigned (&)[2][2]) const {}
    __device__ __forceinline__ int nt_of(const Unit&, int nt) const { return nt; }
};
struct SchedCtxSplit {
    static constexpr bool GATHER = false;
    const char* A; const char* Bt; int K, nN, G, c, S, nts, sa = 127, sb = 127;
    unsigned* flag = nullptr;
    __device__ __forceinline__ void init(const void* A_, const void* Bt_, int N, int K_, int G_, int c_, int S_) { A = (const char*)A_; Bt = (const char*)Bt_; K = K_; nN = N / BM; G = G_; c = c_; S = S_; nts = K_ / BK / S_; }
    __device__ __forceinline__ bool next(int i, Unit& u) const {
        const int L = i * G + c, nlat = (ML / BM) * nN; u.pl = 0;
        if (L < nlat) { tile_of(L, ML / BM, nN, u.pm, u.pn); u.e = 0; return true; }
        const int j = L - nlat; if (j >= 2 * nN * S) return false;
        if (flag) { if (threadIdx.x == 0) { unsigned sp = 0; while (__hip_atomic_load(flag, __ATOMIC_RELAXED, __HIP_MEMORY_SCOPE_AGENT) < (unsigned)G && ++sp < (1u << 22)) __builtin_amdgcn_s_sleep(2);
                __builtin_amdgcn_fence(__ATOMIC_ACQUIRE, "agent"); }
            __syncthreads(); }
        const int jt = j % (2 * nN); u.pm = ML / BM + jt / nN; u.pn = jt % nN; u.e = 1 + j / (2 * nN); return true;
    }
    __device__ __forceinline__ const char* a_base(const Unit& u) const { return A + (size_t)u.pm * BM * K * 2 + (u.e ? (size_t)(u.e - 1) * nts * BK * 2 : 0); }
    __device__ __forceinline__ const char* b_base(const Unit& u) const { return Bt + (size_t)u.pn * BM * K * 2 + (u.e ? (size_t)(u.e - 1) * nts * BK * 2 : 0); }
    __device__ __forceinline__ void a_offs(const Unit&, const int (&)[2], const int (&)[2], unsigned (&)[2][2]) const {}
    __device__ __forceinline__ int nt_of(const Unit& u, int nt) const { return u.e ? nts : nt; }
};
struct SchedBranch {
    static constexpr bool GATHER = false;
    const char *A0, *A1, *B0, *B1; int K, nM, nN, nwg, G, c; static constexpr int sa = 127, sb = 127;
    __device__ __forceinline__ void init(const void* a0, const void* a1, const void* b0, const void* b1, int M, int N, int K_, int G_, int c_) { A0 = (const char*)a0; A1 = (const char*)a1; B0 = (const char*)b0; B1 = (const char*)b1; K = K_; nM = M / BM; nN = N / BM; nwg = nM * nN; G = G_; c = c_; }
    __device__ __forceinline__ bool next(int i, Unit& u) const {
        const int L = (i >> 1) * G + c; if (L >= nwg) return false;
        tile_of(L, nM, nN, u.pm, u.pn); u.e = i & 1; u.pl = 0; return true;
    }
    __device__ __forceinline__ const char* a_base(const Unit& u) const { return (u.e ? A1 : A0) + (size_t)u.pm * BM * K * 2; }
    __device__ __forceinline__ const char* b_base(const Unit& u) const { return (u.e ? B1 : B0) + (size_t)u.pn * BM * K * 2; }
    __device__ __forceinline__ void a_offs(const Unit&, const int (&)[2], const int (&)[2], unsigned (&)[2][2]) const {}
    __device__ __forceinline__ int nt_of(const Unit&, int nt) const { return nt; }
};
struct SchedBranchSplit {
    static constexpr bool GATHER = false;
    const char *A0, *A1, *B0, *B1; int K, nN, G, c, S, nts; static constexpr int sa = 127, sb = 127;
    __device__ __forceinline__ void init(const void* a0, const void* a1, const void* b0, const void* b1, int N, int K_, int G_, int c_, int S_) { A0 = (const char*)a0; A1 = (const char*)a1; B0 = (const char*)b0; B1 = (const char*)b1; K = K_; nN = N / BM; G = G_; c = c_; S = S_; nts = K_ / BK / S_; }
    __device__ __forceinline__ bool next(int i, Unit& u) const {
        const int nlat = (ML / BM) * nN, nl = c < nlat ? (nlat - c + G - 1) / G : 0; u.pl = 0;
        if (i < 2 * nl) { tile_of((i >> 1) * G + c, ML / BM, nN, u.pm, u.pn); u.e = i & 1; return true; }
        const int j = (i - 2 * nl) * G + c; if (j >= 2 * nN * 2 * S) return false;
        const int tl = j % (2 * nN); u.pm = ML / BM + tl / nN; u.pn = tl % nN; u.e = 2 + j / (2 * nN); return true;
    }
    __device__ __forceinline__ const char* a_base(const Unit& u) const { const int q = u.e - 2; return u.e < 2 ? (u.e ? A1 : A0) + (size_t)u.pm * BM * K * 2 : (q >= S ? A1 : A0) + (size_t)u.pm * BM * K * 2 + (size_t)(q >= S ? q - S : q) * nts * BK * 2; }
    __device__ __forceinline__ const char* b_base(const Unit& u) const { const int q = u.e - 2; return u.e < 2 ? (u.e ? B1 : B0) + (size_t)u.pn * BM * K * 2 : (q >= S ? B1 : B0) + (size_t)u.pn * BM * K * 2 + (size_t)(q >= S ? q - S : q) * nts * BK * 2; }
    __device__ __forceinline__ void a_offs(const Unit&, const int (&)[2], const int (&)[2], unsigned (&)[2][2]) const {}
    __device__ __forceinline__ int nt_of(const Unit& u, int nt) const { return u.e >= 2 ? nts : nt; }
};
template <bool GATHER_> struct SchedMoe {
    static constexpr bool GATHER = GATHER_;
    const char* A; const char* Bt; size_t bstride; const int* list; int K, nN, G, c, sa, sb;
    int cnt[NE], ub[NE + 1], pb[NE + 1];
    __device__ __forceinline__ void init(const void* A_, const void* Bt_, size_t bstride_, const unsigned* cntw, const int* list_, int N, int K_, int G_, int c_) {
        A = (const char*)A_; Bt = (const char*)Bt_; bstride = bstride_; list = list_; K = K_; nN = N / BM; G = G_; c = c_; ub[0] = 0; pb[0] = 0; sa = 127; sb = 127;
#pragma unroll
        for (int e = 0; e < NE; ++e) { int v = __builtin_amdgcn_readfirstlane((int)cntw[e]); v = v > MOE_CAP ? MOE_CAP : v; cnt[e] = v; const int np = (v + 255) >> 8; pb[e + 1] = pb[e] + np; ub[e + 1] = ub[e] + np * nN; }
    }
    __device__ __forceinline__ bool next(int i, Unit& u) const {
        const int L = i * G + c; if (L >= ub[NE]) return false;
        int e = 0, base = 0, pbase = 0, np = 1;
#pragma unroll
        for (int j = 0; j < NE; ++j) if (L >= ub[j] && L < ub[j + 1]) { e = j; base = ub[j]; pbase = pb[j]; np = pb[j + 1] - pb[j]; }
        const int r = L - base; u.e = e; u.pn = r / np; u.pl = r % np; u.pm = pbase + u.pl; return true;
    }
    __device__ __forceinline__ const char* a_base(const Unit& u) const { return GATHER ? A : A + (size_t)u.pm * BM * K * 2; }
    __device__ __forceinline__ const char* b_base(const Unit& u) const { return Bt + (size_t)u.e * bstride + (size_t)u.pn * BM * K * 2; }
    __device__ __forceinline__ int nt_of(const Unit&, int nt) const { return nt; }
    __device__ __forceinline__ void a_offs(const Unit& u, const int (&R)[2], const int (&C)[2], unsigned (&off)[2][2]) const {
        int n = 0;
#pragma unroll
        for (int j = 0; j < NE; ++j) if (u.e == j) n = cnt[j];
#pragma unroll
        for (int h = 0; h < 2; ++h)
#pragma unroll
            for (int i = 0; i < 2; ++i) { const int slot = u.pl * 256 + h * HALF + R[i]; const int tok = slot < n ? list[u.e * MOE_CAP + slot] : 0; off[h][i] = (unsigned)(tok * K + C[i]) * 2u; }
    }
};

struct EpiBf16 {
    static constexpr bool PERM = true;
    bf16* O; int ldc; int skip = 0;
    bf16* O2 = nullptr; int pn2 = -1;
    __device__ __forceinline__ bool keep(const Unit&) const { return false; }
    __device__ __forceinline__ void operator()(f32x4 (&acc)[2][2][4][2], const Unit& u, int wr, int wc, int fr, int fq) const {
        if (skip) { if (skip == 2 && acc[0][0][0][0][0] == 12345.678f) O[0] = 1; return; }
        const int row0 = u.pm * BM + wr * 64 + fr; int col0 = u.pn * BM + wc * 32 + 8 * fq;
        bf16* Ob = O; int ld = ldc;
        if (u.pn == pn2) { Ob = O2; ld = BM; col0 -= pn2 * BM; }
#pragma unroll
        for (int ai = 0; ai < 2; ++ai)
#pragma unroll
            for (int m = 0; m < 4; ++m) { bf16* rowp = Ob + (size_t)(row0 + ai * HALF + m * 16) * ld + col0;
#pragma unroll
                for (int bj = 0; bj < 2; ++bj) { const f32x4 v0 = acc[ai][bj][m][0], v1 = acc[ai][bj][m][1];
                    u32x4 w; w.x = cvt_pk_bf16(v0[0], v0[1]); w.y = cvt_pk_bf16(v0[2], v0[3]); w.z = cvt_pk_bf16(v1[0], v1[1]); w.w = cvt_pk_bf16(v1[2], v1[3]);
                    *(u32x4*)(rowp + bj * HALF) = w; } }
    }
};
struct EpiBf16Ctx {
    static constexpr bool PERM = true;
    bf16* O; float* YP; int ldc;
    __device__ __forceinline__ bool keep(const Unit&) const { return false; }
    __device__ __forceinline__ void operator()(f32x4 (&acc)[2][2][4][2], const Unit& u, int wr, int wc, int fr, int fq) const {
        const int row0 = u.pm * BM + wr * 64 + fr, col0 = u.pn * BM + wc * 32 + 8 * fq;
        if (u.e == 0) {
#pragma unroll
            for (int ai = 0; ai < 2; ++ai)
#pragma unroll
                for (int m = 0; m < 4; ++m) { bf16* rowp = O + (size_t)(row0 + ai * HALF + m * 16) * ldc + col0;
#pragma unroll
                    for (int bj = 0; bj < 2; ++bj) { const f32x4 v0 = acc[ai][bj][m][0], v1 = acc[ai][bj][m][1];
                        u32x4 w; w.x = cvt_pk_bf16(v0[0], v0[1]); w.y = cvt_pk_bf16(v0[2], v0[3]); w.z = cvt_pk_bf16(v1[0], v1[1]); w.w = cvt_pk_bf16(v1[2], v1[3]);
                        *(u32x4*)(rowp + bj * HALF) = w; } }
        } else {
            float* base = YP + (size_t)(u.e - 1) * MC * ldc;
#pragma unroll
            for (int ai = 0; ai < 2; ++ai)
#pragma unroll
                for (int m = 0; m < 4; ++m) { float* rowp = base + (size_t)(row0 - ML + ai * HALF + m * 16) * ldc + col0;
#pragma unroll
                    for (int bj = 0; bj < 2; ++bj) { *(f32x4*)(rowp + bj * HALF) = acc[ai][bj][m][0]; *(f32x4*)(rowp + bj * HALF + 4) = acc[ai][bj][m][1]; } }
        }
    }
};
struct EpiF32 {
    static constexpr bool PERM = false;
    float* Cp; int ldc;
    __device__ __forceinline__ bool keep(const Unit&) const { return false; }
    __device__ __forceinline__ void operator()(f32x4 (&acc)[2][2][4][2], const Unit& u, int wr, int wc, int fr, int fq) const {
        const int row0 = u.pm * BM + wr * 64 + fr, col0 = u.pn * BM + wc * 32 + 4 * fq;
#pragma unroll
        for (int ai = 0; ai < 2; ++ai)
#pragma unroll
            for (int m = 0; m < 4; ++m) { float* rowp = Cp + (size_t)(row0 + ai * HALF + m * 16) * ldc + col0;
#pragma unroll
                for (int bj = 0; bj < 2; ++bj)
#pragma unroll
                    for (int n = 0; n < 2; ++n) *(f32x4*)(rowp + bj * HALF + n * 16) = acc[ai][bj][m][n]; }
    }
};
struct EpiSwiGLU {
    static constexpr bool PERM = true;
    bf16* H; int ldh;
    __device__ __forceinline__ bool keep(const Unit&) const { return false; }
    __device__ __forceinline__ void operator()(f32x4 (&acc)[2][2][4][2], const Unit& u, int wr, int wc, int fr, int fq) const {
        const int row0 = u.pm * BM + wr * 64 + fr, col0 = u.pn * HALF + wc * 32 + 8 * fq;
#pragma unroll
        for (int ai = 0; ai < 2; ++ai)
#pragma unroll
            for (int m = 0; m < 4; ++m) { bf16* rowp = H + (size_t)(row0 + ai * HALF + m * 16) * ldh + col0;
                float o[8];
#pragma unroll
                for (int n = 0; n < 2; ++n)
#pragma unroll
                    for (int j = 0; j < 4; ++j) { const float g = acc[ai][0][m][n][j], up = acc[ai][1][m][n][j]; o[n * 4 + j] = g * __builtin_amdgcn_rcpf(1.0f + __expf(-g)) * up; }
                u32x4 w; w.x = cvt_pk_bf16(o[0], o[1]); w.y = cvt_pk_bf16(o[2], o[3]); w.z = cvt_pk_bf16(o[4], o[5]); w.w = cvt_pk_bf16(o[6], o[7]);
                *(u32x4*)rowp = w; }
    }
};
struct EpiSwiGLU8 {
    static constexpr bool PERM = true;
    unsigned char* H; int ldh; float oscale;
    __device__ __forceinline__ bool keep(const Unit&) const { return false; }
    __device__ __forceinline__ void operator()(f32x4 (&acc)[2][2][4][2], const Unit& u, int wr, int wc, int fr, int fq) const {
        const int row0 = u.pm * BM + wr * 64 + fr, col0 = u.pn * HALF + wc * 32 + 8 * fq;
#pragma unroll
        for (int ai = 0; ai < 2; ++ai)
#pragma unroll
            for (int m = 0; m < 4; ++m) { unsigned char* rowp = H + (size_t)(row0 + ai * HALF + m * 16) * ldh + col0;
                float o[8];
#pragma unroll
                for (int n = 0; n < 2; ++n)
#pragma unroll
                    for (int j = 0; j < 4; ++j) { const float g = acc[ai][0][m][n][j], up = acc[ai][1][m][n][j]; o[n * 4 + j] = g * __builtin_amdgcn_rcpf(1.0f + __expf(-g)) * up * oscale; }
                u32x2 w; w.x = pk4_fp8(o[0], o[1], o[2], o[3]); w.y = pk4_fp8(o[4], o[5], o[6], o[7]);
                *(u32x2*)rowp = w; }
    }
};
struct EpiBranch {
    static constexpr bool PERM = true;
    const bf16* P; bf16* O; int ldc; float* YP = nullptr; int S = 1;
    __device__ __forceinline__ bool keep(const Unit& u) const { return u.e == 0; }
    __device__ __forceinline__ void operator()(f32x4 (&acc)[2][2][4][2], const Unit& u, int wr, int wc, int fr, int fq) const {
        const int row0 = u.pm * BM + wr * 64 + fr, col0 = u.pn * BM + wc * 32 + 8 * fq;
        const int og = (u.e == 0 || (u.e >= 2 && u.e - 2 < S)) ? OG9 : OG10;
        float* ypb = YP + (size_t)(u.e >= 2 ? u.e - 2 : 0) * MC * ldc - (size_t)ML * ldc;
#pragma unroll
        for (int ai = 0; ai < 2; ++ai)
#pragma unroll
            for (int m = 0; m < 4; ++m) { const size_t row = (size_t)(row0 + ai * HALF + m * 16);
#pragma unroll
                for (int bj = 0; bj < 2; ++bj) {
                    const u32x4 gq = *(const u32x4*)(P + row * NP + og + col0 + bj * HALF);
                    float t[8]; t[0] = bflo(gq.x); t[1] = bfhi(gq.x); t[2] = bflo(gq.y); t[3] = bfhi(gq.y); t[4] = bflo(gq.z); t[5] = bfhi(gq.z); t[6] = bflo(gq.w); t[7] = bfhi(gq.w);
                    if (u.e == 0) {
                        const u32x4 g10 = *(const u32x4*)(P + row * NP + OG10 + col0 + bj * HALF);
                        float s[8]; s[0] = bflo(g10.x); s[1] = bfhi(g10.x); s[2] = bflo(g10.y); s[3] = bfhi(g10.y); s[4] = bflo(g10.z); s[5] = bfhi(g10.z); s[6] = bflo(g10.w); s[7] = bfhi(g10.w);
#pragma unroll
                        for (int j = 0; j < 8; ++j) { const float f = (1.0f + __expf(-s[j])) / (1.0f + __expf(-t[j])); acc[ai][bj][m][j >> 2][j & 3] *= f; }
                    } else {
                        float o[8];
#pragma unroll
                        for (int j = 0; j < 8; ++j) o[j] = acc[ai][bj][m][j >> 2][j & 3] / (1.0f + __expf(-t[j]));
                        if (u.e == 1) { u32x4 w; w.x = cvt_pk_bf16(o[0], o[1]); w.y = cvt_pk_bf16(o[2], o[3]); w.z = cvt_pk_bf16(o[4], o[5]); w.w = cvt_pk_bf16(o[6], o[7]);
                            *(u32x4*)(O + row * ldc + col0 + bj * HALF) = w; }
                        else { float* rp = ypb + row * ldc + col0 + bj * HALF; *(f32x4*)rp = (f32x4){o[0], o[1], o[2], o[3]}; *(f32x4*)(rp + 4) = (f32x4){o[4], o[5], o[6], o[7]}; }
                    } } }
    }
};

template <class Epi, class Sched, bool ALIGN_EPI, bool FP8 = false, int KC = 0>
__device__ __forceinline__ void gemm_phase(LAS unsigned char* lds, const int tid, const Sched& S, const Epi& E) {
    const int wid = __builtin_amdgcn_readfirstlane(tid >> 6), lane = tid & 63, wr = wid >> 2, wc = wid & 3, fr = lane & 15, fq = lane >> 4;
    const int K = KC ? KC : S.K, nt = K / BK;
    int Rr[2], Cc[2]; unsigned voffA[2], voffB[2];
#pragma unroll
    for (int i = 0; i < 2; ++i) { stage_rc(tid * 16 + i * 8192, Rr[i], Cc[i]); const int Rb = Epi::PERM ? ((Rr[i] & ~31) + perm32(Rr[i] & 31)) : Rr[i];
        voffA[i] = (unsigned)(Rr[i] * K + Cc[i]) * 2u; voffB[i] = (unsigned)(Rb * K + Cc[i]) * 2u; }
    const size_t kstep = (size_t)(BK * 2);
    const size_t hstep = (size_t)HALF * K * 2;
    const unsigned ldsw = (unsigned)wid * 1024u;
    const int aoff = lds_byte(wr * 64 + fr, fq * 8), boff = lds_byte(wc * 32 + fr, fq * 8);
    unsigned gA[2][2] = {{0u, 0u}, {0u, 0u}}, gN[2][2] = {{0u, 0u}, {0u, 0u}};
#define PG_SA(b, h) (((b) * 2 + (h)) * HTB)
#define PG_SB(b, h) ((4 + (b) * 2 + (h)) * HTB)
#define PG_STAGE_B(bufoff, gbase) do { _Pragma("unroll") for (int _i = 0; _i < 2; ++_i) \
        __builtin_amdgcn_global_load_lds((const unsigned*)((const char*)(gbase) + voffB[_i]), (LAS unsigned*)(lds + (bufoff) + ldsw + _i * 8192), 16, 0, 0); } while (0)
#define PG_STAGE_A(bufoff, kptr, h, usenext) do { _Pragma("unroll") for (int _i = 0; _i < 2; ++_i) { \
        const char* _p; if constexpr (Sched::GATHER) _p = (const char*)(kptr) + ((usenext) ? gN[h][_i] : gA[h][_i]); else _p = (const char*)(kptr) + (h) * hstep + voffA[_i]; \
        __builtin_amdgcn_global_load_lds((const unsigned*)_p, (LAS unsigned*)(lds + (bufoff) + ldsw + _i * 8192), 16, 0, 0); } } while (0)
#define PG_LDA(dst, b, h) do { if constexpr (FP8) { _Pragma("unroll") for (int m = 0; m < 4; ++m) { const v4i_t lo_ = *(const LAS v4i_t*)(lds + PG_SA(b, h) + aoff + m * 2048), hi_ = *(const LAS v4i_t*)(lds + PG_SA(b, h) + aoff + m * 2048 + 1024); \
            dst##8[m] = __builtin_shufflevector(lo_, hi_, 0, 1, 2, 3, 4, 5, 6, 7); } } \
        else { _Pragma("unroll") for (int m = 0; m < 4; ++m) _Pragma("unroll") for (int k = 0; k < 2; ++k) dst[m][k] = *(const LAS bf16x8*)(lds + PG_SA(b, h) + aoff + m * 2048 + k * 1024); } } while (0)
#define PG_LDB(dst, b, h) do { if constexpr (FP8) { _Pragma("unroll") for (int n = 0; n < 2; ++n) { const v4i_t lo_ = *(const LAS v4i_t*)(lds + PG_SB(b, h) + boff + n * 2048), hi_ = *(const LAS v4i_t*)(lds + PG_SB(b, h) + boff + n * 2048 + 1024); \
            dst##8[n] = __builtin_shufflevector(lo_, hi_, 0, 1, 2, 3, 4, 5, 6, 7); } } \
        else { _Pragma("unroll") for (int n = 0; n < 2; ++n) _Pragma("unroll") for (int k = 0; k < 2; ++k) dst[n][k] = *(const LAS bf16x8*)(lds + PG_SB(b, h) + boff + n * 2048 + k * 1024); } } while (0)
#define PG_MMA(ai, bj, At, Bt) do { __builtin_amdgcn_s_setprio(1); _Pragma("unroll") for (int m = 0; m < 4; ++m) _Pragma("unroll") for (int n = 0; n < 2; ++n) { \
        if constexpr (FP8) { asm volatile("v_mfma_scale_f32_16x16x128_f8f6f4 %0, %1, %2, %0, %3, %4 op_sel_hi:[0,0,0]" : "+v"(acc[ai][bj][m][n]) : "v"(Bt##8[n]), "v"(At##8[m]), "v"(vsb), "v"(vsa)); } \
        else { _Pragma("unroll") for (int k = 0; k < 2; ++k) acc[ai][bj][m][n] = __builtin_amdgcn_mfma_f32_16x16x32_bf16(Bt[n][k], At[m][k], acc[ai][bj][m][n], 0, 0, 0); } } \
        __builtin_amdgcn_s_setprio(0); } while (0)
#define PG_WAIT_V(n) asm volatile("s_waitcnt vmcnt(" #n ")" ::: "memory")
#define PG_WAIT_L(n) asm volatile("s_waitcnt lgkmcnt(" #n ")" ::: "memory")
#define PG_BAR __builtin_amdgcn_s_barrier()
#define PG_SCHED __builtin_amdgcn_sched_barrier(0)
    Unit cur, nxt; int ui = 0;
    if (!S.next(0, cur)) return;
    f32x4 acc[2][2][4][2];
#pragma unroll
    for (int a = 0; a < 2; ++a)
#pragma unroll
        for (int b = 0; b < 2; ++b)
#pragma unroll
            for (int m = 0; m < 4; ++m)
#pragma unroll
                for (int n = 0; n < 2; ++n) acc[a][b][m][n] = (f32x4){0.f, 0.f, 0.f, 0.f};
    bf16x8 At[4][2], B0[2][2], B1[2][2]; v8i_t At8[4], B08[2], B18[2];
    const int vsa = S.sa, vsb = S.sb; (void)vsa; (void)vsb;
    const char* cA = S.a_base(cur); const char* cB = S.b_base(cur);
    if constexpr (Sched::GATHER) S.a_offs(cur, Rr, Cc, gA);
    PG_STAGE_B(PG_SB(0, 0), cB); PG_STAGE_B(PG_SB(0, 1), cB + hstep); PG_STAGE_A(PG_SA(0, 0), cA, 0, false); PG_STAGE_A(PG_SA(0, 1), cA, 1, false);
    if (wr == 1) PG_BAR;
    PG_WAIT_V(2); PG_BAR;
    PG_STAGE_B(PG_SB(1, 0), cB + kstep); PG_STAGE_A(PG_SA(1, 0), cA + kstep, 0, false); PG_STAGE_B(PG_SB(1, 1), cB + hstep + kstep);
    PG_WAIT_V(6); PG_BAR;
    for (;;) {
        const bool has_next = S.next(ui + 1, nxt);
        const char* nA = has_next ? S.a_base(nxt) : cA; const char* nB = has_next ? S.b_base(nxt) : cB;
        if constexpr (Sched::GATHER) { if (has_next) S.a_offs(nxt, Rr, Cc, gN); else { gN[0][0] = gA[0][0]; gN[0][1] = gA[0][1]; gN[1][0] = gA[1][0]; gN[1][1] = gA[1][1]; } }
        const int ntc = S.nt_of(cur, nt);
        for (int t = 0; t < ntc; t += 2) {
            const bool last = (t == ntc - 2);
            const char* a1 = cA + (size_t)(t + 1) * kstep;
            const char* a2 = last ? nA : cA + (size_t)(t + 2) * kstep; const char* b2 = last ? nB : cB + (size_t)(t + 2) * kstep;
            const char* a3 = a2 + kstep; const char* b3 = b2 + kstep;
            PG_LDB(B0, 0, 0); PG_LDB(B1, 0, 1); PG_SCHED; PG_LDA(At, 0, 0); PG_STAGE_A(PG_SA(1, 1), a1, 1, false);
            PG_WAIT_V(8); PG_WAIT_L(0); PG_BAR; PG_MMA(0, 0, At, B0); PG_MMA(0, 1, At, B1); PG_BAR; PG_SCHED;
            PG_LDA(At, 0, 1); PG_STAGE_B(PG_SB(0, 0), b2); PG_STAGE_B(PG_SB(0, 1), b2 + hstep); PG_STAGE_A(PG_SA(0, 0), a2, 0, last);
            PG_WAIT_V(8); PG_WAIT_L(0); PG_BAR; PG_MMA(1, 0, At, B0); PG_MMA(1, 1, At, B1); PG_BAR; PG_SCHED;
            PG_LDB(B0, 1, 0); PG_LDB(B1, 1, 1); PG_SCHED; PG_LDA(At, 1, 0); PG_STAGE_A(PG_SA(0, 1), a2, 1, last);
            PG_WAIT_V(8); PG_WAIT_L(0); PG_BAR; PG_MMA(0, 0, At, B0); PG_MMA(0, 1, At, B1); PG_BAR; PG_SCHED;
            PG_LDA(At, 1, 1); PG_STAGE_B(PG_SB(1, 0), b3); PG_STAGE_B(PG_SB(1, 1), b3 + hstep); PG_STAGE_A(PG_SA(1, 0), a3, 0, last);
            PG_WAIT_V(8); PG_WAIT_L(0); PG_BAR; PG_MMA(1, 0, At, B0); PG_MMA(1, 1, At, B1); PG_BAR; PG_SCHED;
        }
        if constexpr (ALIGN_EPI) { if (wr == 0) PG_BAR; }
        if constexpr (FP8) asm volatile("s_nop 15\n\ts_nop 15\n\ts_nop 15\n\ts_nop 15" ::: "memory");
        E(acc, cur, wr, wc, fr, fq);
        if (!has_next) break;
        if (!E.keep(cur)) {
#pragma unroll
            for (int a = 0; a < 2; ++a)
#pragma unroll
                for (int b = 0; b < 2; ++b)
#pragma unroll
                    for (int m = 0; m < 4; ++m)
#pragma unroll
                        for (int n = 0; n < 2; ++n) acc[a][b][m][n] = (f32x4){0.f, 0.f, 0.f, 0.f};
        }
        cur = nxt; cA = nA; cB = nB; ++ui;
        if constexpr (Sched::GATHER) { gA[0][0] = gN[0][0]; gA[0][1] = gN[0][1]; gA[1][0] = gN[1][0]; gA[1][1] = gN[1][1]; }
        if constexpr (ALIGN_EPI) { if (wr == 1) PG_BAR; }
    }
    PG_WAIT_V(0);
    if constexpr (!ALIGN_EPI) { if (wr == 0) PG_BAR; }
    PG_BAR;
#undef PG_SA
#undef PG_SB
#undef PG_STAGE_A
#undef PG_STAGE_B
#undef PG_LDA
#undef PG_LDB
#undef PG_MMA
#undef PG_WAIT_V
#undef PG_WAIT_L
#undef PG_BAR
#undef PG_SCHED
}
}

#define XB_TMO      128
#define XB_XCNT(j)  (256  + 64 * (j))
#define XB_XSUB(j)  (1280 + 64 * (j))
#define XB_XGEN(j)  (2304 + 64 * (j))
#define XB_TOP      3328
#define XB_TOPGEN   3392
#define XCD_BAR_WORDS 3456
#define XB_SPIN_CAP (1u << 18)
__device__ __forceinline__ unsigned xb_ld(unsigned* p)              { return __hip_atomic_load(p, __ATOMIC_RELAXED, __HIP_MEMORY_SCOPE_AGENT); }
__device__ __forceinline__ unsigned xb_add(unsigned* p, unsigned v) { return __hip_atomic_fetch_add(p, v, __ATOMIC_RELAXED, __HIP_MEMORY_SCOPE_AGENT); }
__device__ __forceinline__ unsigned xb_xcc_id() { return (unsigned)__builtin_amdgcn_s_getreg((3 << 11) | 20) & 0xFu; }
#define XB_SPIN(cond, bar) do { unsigned _sp = 0; while (cond) { __builtin_amdgcn_s_sleep(1); \
    if ((++_sp & 255u) == 0u) { if (xb_ld(&(bar)[XB_TMO])) break; if (_sp > XB_SPIN_CAP) { atomicAdd(&(bar)[XB_TMO], 1u); break; } } } } while (0)
struct XcdBarrier { unsigned* bar; unsigned x; volatile LAS unsigned* st; };
__device__ __forceinline__ XcdBarrier xcd_barrier_post(unsigned* bar, volatile LAS unsigned* st) {
    XcdBarrier b; b.bar = bar; b.x = xb_xcc_id(); b.st = st;
    if (threadIdx.x == 0) (void)xb_add(&bar[XB_XCNT(b.x)], 1u);
    return b;
}
__device__ __forceinline__ void xcd_barrier_complete(unsigned* bar, unsigned x, unsigned& nloc, unsigned& nx) {
    const unsigned G = gridDim.x * gridDim.y * gridDim.z;
    unsigned sum, cnt, mine, sp = 0u;
    for (;;) {
        sum = 0u; cnt = 0u; mine = 0u;
#pragma unroll
        for (unsigned j = 0; j < 16; ++j) { const unsigned c = xb_ld(&bar[XB_XCNT(j)]); sum += c; cnt += (c > 0u) ? 1u : 0u; mine = (j == x) ? c : mine; }
        if (sum == G) break;
        __builtin_amdgcn_s_sleep(1);
        if ((++sp & 255u) == 0u) { if (xb_ld(&bar[XB_TMO])) break; if (sp > XB_SPIN_CAP) { atomicAdd(&bar[XB_TMO], 1u); break; } }
    }
    nloc = mine > 0u ? mine : 1u; nx = cnt > 0u ? cnt : 1u;
}
__device__ __forceinline__ void xcd_barrier(const XcdBarrier& b) {
    asm volatile("s_waitcnt vmcnt(0)" ::: "memory");
    __syncthreads();
    if (threadIdx.x == 0) {
        unsigned* bar = b.bar;
        __builtin_amdgcn_s_waitcnt(0);
        unsigned nloc = b.st[0], nx = b.st[1];
        if (nloc == 0u) { xcd_barrier_complete(bar, b.x, nloc, nx); b.st[0] = nloc; b.st[1] = nx; }
        const unsigned old = xb_add(&bar[XB_XSUB(b.x)], 1u);
        const unsigned gen = old / nloc;
        if (old + 1u == (gen + 1u) * nloc) {
            __builtin_amdgcn_fence(__ATOMIC_RELEASE, "agent");
            asm volatile("s_waitcnt vmcnt(0)" ::: "memory");
            const unsigned og = xb_add(&bar[XB_TOP], 1u);
            const unsigned tg = og / nx;
            if (og + 1u == (tg + 1u) * nx) xb_add(&bar[XB_TOPGEN], 1u);
            else XB_SPIN(xb_ld(&bar[XB_TOPGEN]) == tg, bar);
            __builtin_amdgcn_fence(__ATOMIC_ACQUIRE, "agent");
            xb_add(&bar[XB_XGEN(b.x)], 1u);
            asm volatile("s_waitcnt vmcnt(0)" ::: "memory");
        } else {
            XB_SPIN(xb_ld(&bar[XB_XGEN(b.x)]) == gen, bar);
            __builtin_amdgcn_fence(__ATOMIC_ACQUIRE, "agent");
            asm volatile("s_waitcnt vmcnt(0)" ::: "memory");
        }
    }
    __syncthreads();
}

typedef const float* cfp_t; typedef const __attribute__((address_space(4))) cfp_t* in_table_t;
#define INP(i) ((const float*)(const GAS float*)F.in[i])
struct Frame {
    LAS unsigned char* lds;
    unsigned* ctl;
    int tid, lane, wave, vcu, G, bid;
    in_table_t in;
    float* out; unsigned char* ws;
};
enum { I_X = 0, I_C, I_CTX, I_CCTX, I_WMOD, I_BMOD, I_GPREMIX, I_GPOSTMIX, I_GPREFFN, I_GPOSTFFN, I_WIN, I_WLRF, I_BLRF, I_WLRB, I_BLRB, I_GGLA, I_SINK, I_WBRG, I_WBRA, I_WOUT,
       I_WFG, I_WFU, I_WFD, I_WROUTER, I_BROUTER, I_WEG, I_WEU, I_WED };

__device__ __forceinline__ void tr_item(const float* src  , int ldw, bf16* dst  , int K, LAS float* scr, int lane, bool zero) {
    if (zero) {
#pragma unroll
        for (int j = 0; j < 4; ++j) { const int n = (lane >> 3) + 8 * j; *(GAS u32x4*)(dst + (size_t)n * K + 8 * (lane & 7)) = (u32x4){0u, 0u, 0u, 0u}; }
        return;
    }
#pragma unroll
    for (int i = 0; i < 32; ++i) { const int kk = 2 * i + (lane >> 5); scr[kk * 33 + (lane & 31)] = __builtin_nontemporal_load(src + (size_t)kk * ldw + (lane & 31)); }
    LDS_WAIT(); asm volatile("" ::: "memory");
    const int c = lane & 7;
#pragma unroll
    for (int j = 0; j < 4; ++j) { const int n = (lane >> 3) + 8 * j; const LAS float* s = scr + (8 * c) * 33 + n;
        u32x4 o; o.x = cvt_pk_bf16(s[0 * 33], s[1 * 33]); o.y = cvt_pk_bf16(s[2 * 33], s[3 * 33]); o.z = cvt_pk_bf16(s[4 * 33], s[5 * 33]); o.w = cvt_pk_bf16(s[6 * 33], s[7 * 33]);
        *(GAS u32x4*)(dst + (size_t)n * K + 8 * c) = o; }
    LDS_WAIT(); asm volatile("" ::: "memory");
}
__device__ __forceinline__ void tr_plain(const float* W, int K, int N, bf16* WT, LAS float* scr, int item, int lane) {
    const int nblk = N / 32, kb = item / nblk, nb = item % nblk;
    tr_item(W + (size_t)(64 * kb) * N + 32 * nb, N, WT + (size_t)(32 * nb) * K + 64 * kb, K, scr, lane, false);
}
__device__ __forceinline__ void tr_win(const float* W, bf16* WT, LAS float* scr, int item, int lane) {
    const int nblk = NP / 32, kb = item / nblk, nb = item % nblk, n0 = 32 * nb;
    int ns; bool zero = false;
    if (n0 < 6144) ns = n0; else if (n0 < 12800) ns = n0 + 32; else if (n0 == 12800) ns = 6144; else { ns = 0; zero = true; }
    tr_item(W + (size_t)(64 * kb) * DIN + ns, DIN, WT + (size_t)n0 * D + 64 * kb, D, scr, lane, zero);
}
__device__ __forceinline__ void tr_gu(const float* Wg, const float* Wu, bf16* WT, LAS float* scr, int item, int lane) {
    const int nblk = NGU / 32, kb = item / nblk, nb = item % nblk, n0 = 32 * nb, tile = n0 >> 8, w = n0 & 255;
    const float* W = (w < 128) ? Wg : Wu; const int ns = tile * 128 + (w & 127);
    tr_item(W + (size_t)(64 * kb) * DFF + ns, DFF, WT + (size_t)n0 * D + 64 * kb, D, scr, lane, false);
}
__device__ __forceinline__ void tr_item8(const float* src, int ldw, unsigned char* dst  , int Kb, LAS float* scr, int lane, float scale) {
#pragma unroll
    for (int i = 0; i < 32; ++i) { const int kk = 2 * i + (lane >> 5); scr[kk * 33 + (lane & 31)] = __builtin_nontemporal_load(src + (size_t)kk * ldw + (lane & 31)); }
    LDS_WAIT(); asm volatile("" ::: "memory");
    const int c = lane & 3;
#pragma unroll
    for (int j = 0; j < 2; ++j) { const int n = (lane >> 2) + 16 * j; const LAS float* sp = scr + (16 * c) * 33 + n;
        u32x4 o; o.x = pk4_fp8(sp[0 * 33] * scale, sp[1 * 33] * scale, sp[2 * 33] * scale, sp[3 * 33] * scale); o.y = pk4_fp8(sp[4 * 33] * scale, sp[5 * 33] * scale, sp[6 * 33] * scale, sp[7 * 33] * scale);
        o.z = pk4_fp8(sp[8 * 33] * scale, sp[9 * 33] * scale, sp[10 * 33] * scale, sp[11 * 33] * scale); o.w = pk4_fp8(sp[12 * 33] * scale, sp[13 * 33] * scale, sp[14 * 33] * scale, sp[15 * 33] * scale);
        *(GAS u32x4*)(dst + (size_t)n * Kb + 16 * c) = o; }
    LDS_WAIT(); asm volatile("" ::: "memory");
}
__device__ __forceinline__ void tr_plain8(const float* W, int K, int N, unsigned char* WT, LAS float* scr, int item, int lane, float scale) {
    const int nblk = N / 32, kb = item / nblk, nb = item % nblk;
    tr_item8(W + (size_t)(64 * kb) * N + 32 * nb, N, WT + (size_t)(32 * nb) * K + 64 * kb, K, scr, lane, scale);
}
__device__ __forceinline__ void tr_gu8(const float* Wg, const float* Wu, unsigned char* WT, LAS float* scr, int item, int lane, float scale) {
    const int nblk = NGU / 32, kb = item / nblk, nb = item % nblk, n0 = 32 * nb, tile = n0 >> 8, w = n0 & 255;
    const float* W = (w < 128) ? Wg : Wu; const int ns = tile * 128 + (w & 127);
    tr_item8(W + (size_t)(64 * kb) * DFF + ns, DFF, WT + (size_t)n0 * D + 64 * kb, D, scr, lane, scale);
}
constexpr int IT_WIN = (D / 64) * (NP / 32), IT_SQ = (D / 64) * (D / 32), IT_GU = (D / 64) * (NGU / 32), IT_DN = (DFF / 64) * (D / 32);
constexpr int CV_A = 0, CV_B = CV_A + IT_WIN, CV_C = CV_B + 3 * IT_SQ, CV_D = CV_C + IT_GU + IT_DN, CV_E = CV_D + IT_WIN, CV_F = CV_E + 3 * IT_SQ, CV_END = CV_F + NE * (IT_GU + IT_DN);
constexpr int CVQ_MIX = 220;
constexpr int CV_MIX0 = CV_B, CV_MIX0_N = 192 * CVQ_MIX;
static_assert(CV_MIX0 + CV_MIX0_N >= CV_C && CV_MIX0 + CV_MIX0_N <= CV_F, "MIX(l0) covers B");
constexpr int CVQ_MIX1 = 300;
constexpr int Q1A = 320, Q1B = 385, N1A = 128;
constexpr int CV_MIX1 = CV_F, CV_MIX1_N = N1A * Q1A + (192 - N1A) * Q1B;
constexpr int CVX_MIX0 = 80;
constexpr int X0A = 95, X0B = 160, N0A = 160;
constexpr int CV_MIX0X = CV_MIX1 + CV_MIX1_N, CV_MIX0X_N = N0A * X0A + (192 - N0A) * X0B;
static_assert(CV_MIX0X + CV_MIX0X_N <= CV_END, "expert items");
constexpr int CVQ_G2 = 30;
constexpr int QG1 = 100, G1F0 = (MT / 256) * (NP / 256) - 6 * 256, G1F1 = (ML / 256) * (NP / 256) + 30 - 6 * 256;
static_assert(G1F0 > 0 && G1F0 < 256 && G1F1 > 0 && G1F1 < 256, "seven rounds");
constexpr int CV_G1L0 = CV_MIX0X + CV_MIX0X_N, CV_G1L0_N = (256 - G1F0) * QG1, CV_G1L1 = CV_G1L0 + CV_G1L0_N, CV_G1L1_N = (256 - G1F1) * QG1;
constexpr int CV_G2 = CV_G1L1 + CV_G1L1_N, CV_G2_N = 128 * CVQ_G2;
constexpr int QG3 = 20, QG4 = 55, QG5 = 25, G4F = (MT / 256) * (NGU / 256) - 5 * 256, G5F = 2 * (D / 256) * YP_S5;
static_assert(G4F > 0 && G4F < 256 && G5F > 0 && G5F < 256, "idle workgroups");
constexpr int CV_G3 = CV_G2 + CV_G2_N, CV_G3_N = 128 * QG3, CV_G4 = CV_G3 + CV_G3_N, CV_G4_N = (256 - G4F) * QG4, CV_G5 = CV_G4 + CV_G4_N, CV_G5_N = (256 - G5F) * QG5;
constexpr int CV_P0X = CV_MIX0 + CV_MIX0_N, CV_P0F = CV_G5 + CV_G5_N;
static_assert(CV_P0F <= CV_END, "conversion plan");

#define INPX(i) ((const float*)(const GAS float*)in[i])
__device__ __noinline__ void tr_dispatch_nl(in_table_t in, GAS unsigned char* wsg, int lane, int it, LAS float* scr) {
    unsigned char* ws = (unsigned char*)wsg; int r = it;
    if (r < CV_B) { tr_win(INPX(I_WIN), (bf16*)(ws + WS_WIN), scr, r, lane); return; }
    if (r < CV_C) { r -= CV_B; const int which = r / IT_SQ; const float* srcw = which == 0 ? INPX(I_WBRG) : (which == 1 ? INPX(I_WBRA) : INPX(I_WOUT)); const size_t wso = which == 0 ? WS_WBG : (which == 1 ? WS_WBA : WS_WO);
        tr_plain(srcw, D, D, (bf16*)(ws + wso), scr, r % IT_SQ, lane); return; }
#if DENSE_FP8 == 1
    if (r < CV_D) { r -= CV_C; if (r < IT_GU) tr_gu8(INPX(I_WFG), INPX(I_WFU), ws + WS_FGU, scr, r, lane, W8_SCALE); else tr_plain8(INPX(I_WFD), DFF, D, ws + WS_FDN, scr, r - IT_GU, lane, W8_SCALE); return; }
#elif DENSE_FP8 == 2
    if (r < CV_D) { r -= CV_C; if (r < IT_GU) tr_gu8(INPX(I_WFG), INPX(I_WFU), ws + WS_FGU, scr, r, lane, W8_SCALE); else tr_plain(INPX(I_WFD), DFF, D, (bf16*)(ws + WS_FDN), scr, r - IT_GU, lane); return; }
#else
    if (r < CV_D) { r -= CV_C; if (r < IT_GU) tr_gu(INPX(I_WFG), INPX(I_WFU), (bf16*)(ws + WS_FGU), scr, r, lane); else tr_plain(INPX(I_WFD), DFF, D, (bf16*)(ws + WS_FDN), scr, r - IT_GU, lane); return; }
#endif
    if (r < CV_E) { tr_win(INPX(I_WIN) + (size_t)D * DIN, (bf16*)(ws + WS_WIN + SZ_WIN), scr, r - CV_D, lane); return; }
    if (r < CV_F) { r -= CV_E; const int which = r / IT_SQ; const float* srcw = (which == 0 ? INPX(I_WBRG) : (which == 1 ? INPX(I_WBRA) : INPX(I_WOUT))) + (size_t)D * D; const size_t wso = (which == 0 ? WS_WBG : (which == 1 ? WS_WBA : WS_WO)) + SZ_WSQ;
        tr_plain(srcw, D, D, (bf16*)(ws + wso), scr, r % IT_SQ, lane); return; }
    { r -= CV_F; const int per = IT_GU + IT_DN, e = r / per, q = r % per;
#if MOE_FP8
        if (q < IT_GU) tr_gu8(INPX(I_WEG) + (size_t)e * D * DFF, INPX(I_WEU) + (size_t)e * D * DFF, ws + WS_EGU + e * (SZ_GU / 2), scr, q, lane, W8_SCALE);
        else tr_plain8(INPX(I_WED) + (size_t)e * DFF * D, DFF, D, ws + WS_EDN + e * (SZ_DN / 2), scr, q - IT_GU, lane, W8_SCALE); }
#else
        if (q < IT_GU) tr_gu(INPX(I_WEG) + (size_t)e * D * DFF, INPX(I_WEU) + (size_t)e * D * DFF, (bf16*)(ws + WS_EGU + e * SZ_GU), scr, q, lane);
        else tr_plain(INPX(I_WED) + (size_t)e * DFF * D, DFF, D, (bf16*)(ws + WS_EDN + e * SZ_DN), scr, q - IT_GU, lane); }
#endif
}
#undef INPX
__device__ __forceinline__ void tr_dispatch(Frame& F, int it, LAS float* scr) { tr_dispatch_nl(F.in, (GAS unsigned char*)F.ws, F.lane, it, scr); }
__device__ __forceinline__ void convert_range(Frame& F, int first, int n) {
    LAS float* scr = (LAS float*)(F.lds + F.wave * 16384);
    for (int i = F.wave; i < n; i += 8) tr_dispatch(F, first + i, scr);
}
__device__ __forceinline__ void p0_weights(Frame& F) {
    LAS float* scr = (LAS float*)(F.lds + F.wave * 16384);
    const int gw = F.vcu * 8 + F.wave, NGW = F.G * 8;
    if (F.G != 256) { for (int i = gw; i < CV_END; i += NGW) tr_dispatch(F, i, scr); return; }
    const int n1 = CV_B - CV_A, n2 = CV_F - CV_P0X, n3 = CV_END - CV_P0F;
    for (int i = gw; i < n1 + n2 + n3; i += NGW) tr_dispatch(F, i < n1 ? i : (i < n1 + n2 ? CV_P0X + (i - n1) : CV_P0F + (i - n1 - n2)), scr);
}
__device__ __forceinline__ void p0_mod(Frame& F) {
    LAS float* sc = (LAS float*)F.lds;
    LAS float* red = (LAS float*)(F.lds + 3 * D * 4);
    __syncthreads();
    for (int i = F.tid; i < 3 * D; i += 512) { const int r = i / D, k = i % D; const float v = r < 2 ? INP(I_C)[r * D + k] : INP(I_CCTX)[k]; sc[i] = siluf_(v); }
    __syncthreads();
    float* MOD = (float*)(F.ws + WS_MOD);
    const int c4 = F.lane & 7, kp = F.lane >> 3;
    for (int it = F.vcu; it < 2 * (6 * D / 32); it += F.G) {
        const int l = it / (6 * D / 32), n0 = (it % (6 * D / 32)) * 32;
        const float* W = INP(I_WMOD) + (size_t)l * D * 6 * D + n0 + 4 * c4;
        f32x4 a0 = (f32x4){0.f, 0.f, 0.f, 0.f}, a1 = a0, a2 = a0;
        const int kbase = F.wave * 256 + kp;
#pragma unroll 8
        for (int j = 0; j < 32; ++j) { const int k = kbase + 8 * j; const f32x4 w = __builtin_nontemporal_load((const f32x4*)(W + (size_t)k * 6 * D)); a0 = a0 + w * sc[k]; a1 = a1 + w * sc[D + k]; a2 = a2 + w * sc[2 * D + k]; }
        const int slot = F.wave * 8 + kp;
        *(LAS f32x4*)(red + (slot * 3 + 0) * 32 + 4 * c4) = a0; *(LAS f32x4*)(red + (slot * 3 + 1) * 32 + 4 * c4) = a1; *(LAS f32x4*)(red + (slot * 3 + 2) * 32 + 4 * c4) = a2;
        __syncthreads();
        if (F.tid < 96) { const int r = F.tid / 32, cc = F.tid % 32; float s = 0.f;
#pragma unroll 16
            for (int q = 0; q < 64; ++q) s += red[(q * 3 + r) * 32 + cc];
            MOD[((size_t)l * 3 + r) * 6 * D + n0 + cc] = s + INP(I_BMOD)[(size_t)l * 6 * D + n0 + cc]; }
        __syncthreads();
    }
}

struct Row { f32x4 v[8]; };
__device__ __forceinline__ void row_load(Row& r, const float* p, int lane) {
#pragma unroll
    for (int j = 0; j < 8; ++j) r.v[j] = *(const f32x4*)(p + 4 * lane + 256 * j);
}
__device__ __forceinline__ void row_load_nt(Row& r, const float* p, int lane) {
#pragma unroll
    for (int j = 0; j < 8; ++j) r.v[j] = __builtin_nontemporal_load((const f32x4*)(p + 4 * lane + 256 * j));
}
__device__ __forceinline__ void row_load_bf16(Row& r, const bf16* p, int lane) {
#pragma unroll
    for (int j = 0; j < 8; ++j) { const u32x2 w = *(const u32x2*)(p + 4 * lane + 256 * j); r.v[j] = (f32x4){bflo(w.x), bfhi(w.x), bflo(w.y), bfhi(w.y)}; }
}
struct RowH { u32x2 v[8]; };
__device__ __forceinline__ void rowh_load(RowH& r, const bf16* p, int lane) {
#pragma unroll
    for (int j = 0; j < 8; ++j) r.v[j] = *(const u32x2*)(p + 4 * lane + 256 * j);
}
__device__ __forceinline__ void rowh_cvt(Row& o, const RowH& r) {
#pragma unroll
    for (int j = 0; j < 8; ++j) o.v[j] = (f32x4){bflo(r.v[j].x), bfhi(r.v[j].x), bflo(r.v[j].y), bfhi(r.v[j].y)};
}
__device__ __forceinline__ void row_touch(Row& r) { asm volatile("" : "+v"(r.v[0]), "+v"(r.v[1]), "+v"(r.v[2]), "+v"(r.v[3]), "+v"(r.v[4]), "+v"(r.v[5]), "+v"(r.v[6]), "+v"(r.v[7])); }
__device__ __forceinline__ void rowh_touch(RowH& r) { asm volatile("" : "+v"(r.v[0]), "+v"(r.v[1]), "+v"(r.v[2]), "+v"(r.v[3]), "+v"(r.v[4]), "+v"(r.v[5]), "+v"(r.v[6]), "+v"(r.v[7])); }
template <int S> __device__ __forceinline__ void row_sum_slices(Row& o, const float* p, size_t stride, int lane) {
    row_load_nt(o, p, lane);
#pragma unroll
    for (int s0 = 1; s0 < S; s0 += 2) { Row t[2];
#pragma unroll
        for (int q = 0; q < 2; ++q) if (s0 + q < S) row_load_nt(t[q], p + (size_t)(s0 + q) * stride, lane);
#pragma unroll
        for (int q = 0; q < 2; ++q) if (s0 + q < S) {
#pragma unroll
            for (int j = 0; j < 8; ++j) o.v[j] = o.v[j] + t[q].v[j]; } }
}
__device__ __forceinline__ float row_ss(const Row& r) {
    float s = 0.f;
#pragma unroll
    for (int j = 0; j < 8; ++j) s += (r.v[j][0] * r.v[j][0] + r.v[j][1] * r.v[j][1]) + (r.v[j][2] * r.v[j][2] + r.v[j][3] * r.v[j][3]);
    return wave_sum(s);
}
__device__ __forceinline__ int mod_row(int r) { return r < ML ? r / SEQ : 2; }
__device__ __forceinline__ void prenorm_store(const Row& x, Row& h, const float* g, const float* sc, const float* sh, bf16* hx, int lane, bool store = true) {
    const float rs = 1.0f / sqrtf(row_ss(x) * (1.0f / D) + RMS_EPS);
#pragma unroll
    for (int j = 0; j < 8; ++j) { const int o = 4 * lane + 256 * j; const f32x4 gg = *(const f32x4*)(g + o), s1 = *(const f32x4*)(sc + o), s0 = *(const f32x4*)(sh + o);
        h.v[j] = x.v[j] * rs * gg * (s1 + 1.0f) + s0;
        if (store) { u32x2 w; w.x = cvt_pk_bf16(h.v[j][0], h.v[j][1]); w.y = cvt_pk_bf16(h.v[j][2], h.v[j][3]); *(u32x2*)(hx + o) = w; } }
}
__device__ __forceinline__ const float* x_in_row(Frame& F, int r) { return r < ML ? INP(I_X) + (size_t)r * D : INP(I_CTX) + (size_t)(r - ML) * D; }

#define LV(i) ((const LAS float*)(F.lds) + (size_t)(i) * D)
__device__ __forceinline__ void stage_vec(Frame& F, int slot, const float* src) {
    LAS float* dst = (LAS float*)(F.lds) + (size_t)slot * D;
    *(LAS f32x4*)(dst + 4 * F.tid) = *(const f32x4*)(src + 4 * F.tid);
}
__device__ __forceinline__ void prenorm_store_l(const Row& x, Row& h, const LAS float* g, const LAS float* sc, const LAS float* sh, bf16* hx, int lane, bool store = true) {
    const float rs = 1.0f / sqrtf(row_ss(x) * (1.0f / D) + RMS_EPS);
#pragma unroll
    for (int j = 0; j < 8; ++j) { const int o = 4 * lane + 256 * j; const f32x4 gg = *(const LAS f32x4*)(g + o), s1 = *(const LAS f32x4*)(sc + o), s0 = *(const LAS f32x4*)(sh + o);
        h.v[j] = x.v[j] * rs * gg * (s1 + 1.0f) + s0;
        if (store) { u32x2 w; w.x = cvt_pk_bf16(h.v[j][0], h.v[j][1]); w.y = cvt_pk_bf16(h.v[j][2], h.v[j][3]); *(u32x2*)(hx + o) = w; } }
}
__device__ __forceinline__ void t1_phase(Frame& F) {
    const int gw = F.vcu * 8 + F.wave, NGW = F.G * 8;
    const float* MOD = (const float*)(F.ws + WS_MOD); bf16* HX = (bf16*)(F.ws + WS_HX);
    Row xn; if (gw < MT) row_load(xn, x_in_row(F, gw), F.lane);
    stage_vec(F, 0, INP(I_GPREMIX));
#pragma unroll
    for (int m = 0; m < 3; ++m) { stage_vec(F, 1 + 2 * m, MOD + (size_t)m * 6 * D + D); stage_vec(F, 2 + 2 * m, MOD + (size_t)m * 6 * D); }
    __syncthreads();
    for (int r = gw; r < MT; r += NGW) { Row x, h; row_touch(xn); x = xn; if (r + NGW < MT) row_load(xn, x_in_row(F, r + NGW), F.lane);
        const int m = mod_row(r);
        prenorm_store_l(x, h, LV(0), LV(1 + 2 * m), LV(2 + 2 * m), HX + (size_t)r * D, F.lane); }
}
__device__ __forceinline__ void t3_phase(Frame& F, int l) {
    const int gw = F.wave * F.G + F.vcu, NGW = F.G * 8, rows = (l == 0) ? MT : ML;
    const float* MODL = (const float*)(F.ws + WS_MOD) + (size_t)l * 3 * 6 * D; bf16* HX = (bf16*)(F.ws + WS_HX); float* XS = (float*)(F.ws + WS_XS); const bf16* Y = (const bf16*)(F.ws + WS_Y);
    const float* gpost = INP(I_GPOSTMIX) + l * D; const float* gpre = INP(I_GPREFFN) + l * D;
    volatile LAS unsigned* lcnt = (volatile LAS unsigned*)(F.lds + MISC_OFF + 64); volatile LAS unsigned* lbase = lcnt + 8; LAS int* rinfo = (LAS int*)(F.lds + 131072 + F.wave * 1024);
    Row xn; RowH yn;
#define ROWMAP(i) (l == 0 ? ((i) < MC ? ML + (i) : (i) - MC) : (i))
    if (gw < rows) { const int g0 = ROWMAP(gw); row_load(xn, l == 0 ? x_in_row(F, g0) : XS + (size_t)g0 * D, F.lane); rowh_load(yn, Y + (size_t)g0 * D, F.lane); }
    stage_vec(F, 0, gpost); stage_vec(F, 1, gpre);
#pragma unroll
    for (int m = 0; m < 3; ++m) if (l == 0 || m < 2) { stage_vec(F, 2 + 3 * m, MODL + (size_t)m * 6 * D + 2 * D); stage_vec(F, 3 + 3 * m, MODL + (size_t)m * 6 * D + 4 * D); stage_vec(F, 4 + 3 * m, MODL + (size_t)m * 6 * D + 3 * D); }
    if (l == 1) { if (F.tid < 16) lcnt[F.tid] = 0u;
        const float* wr = INP(I_WROUTER); LAS float* wt = (LAS float*)(F.lds) + (size_t)8 * D;
#pragma unroll
        for (int q = 0; q < 8; ++q) { const int i4 = (F.tid + 512 * q) * 4; const f32x4 v = *(const f32x4*)(wr + i4); const int d = i4 >> 3, e0 = i4 & 7;
            wt[(e0 + 0) * D + d] = v[0]; wt[(e0 + 1) * D + d] = v[1]; wt[(e0 + 2) * D + d] = v[2]; wt[(e0 + 3) * D + d] = v[3]; } }
    __syncthreads();
    int krow = 0;
    for (int ix = gw; ix < rows; ix += NGW, ++krow) { const int r = ROWMAP(ix);
        Row x, y, h; RowH yh;
        row_touch(xn); rowh_touch(yn); x = xn; yh = yn;
        if (ix + NGW < rows) { const int rn = ROWMAP(ix + NGW); row_load(xn, l == 0 ? x_in_row(F, rn) : XS + (size_t)rn * D, F.lane); rowh_load(yn, Y + (size_t)rn * D, F.lane); }
        if (CTX_SPLIT && l == 0 && r >= ML) row_sum_slices<YP_S3>(y, (const float*)(F.ws + WS_YP) + (size_t)(r - ML) * D, (size_t)MC * D, F.lane);
        else rowh_cvt(y, yh);
        const int m = mod_row(r);
        const float rs = 1.0f / sqrtf(row_ss(y) * (1.0f / D) + RMS_EPS);
#pragma unroll
        for (int j = 0; j < 8; ++j) { const int o = 4 * F.lane + 256 * j; const f32x4 gg = *(const LAS f32x4*)(LV(0) + o), gt = *(const LAS f32x4*)(LV(2 + 3 * m) + o);
            x.v[j] = x.v[j] + gt * (y.v[j] * rs * gg); *(f32x4*)(XS + (size_t)r * D + o) = x.v[j]; }
        prenorm_store_l(x, h, LV(1), LV(3 + 3 * m), LV(4 + 3 * m), HX + (size_t)r * D, F.lane, !(MOE_FP8 && l == 1) && !(DENSE_FP8 && l == 0));
#if MOE_FP8
        if (l == 1 || DENSE_FP8) {
            unsigned char* h8 = F.ws + WS_HX8 + (size_t)r * D;
#pragma unroll
            for (int j = 0; j < 8; ++j) *(unsigned*)(h8 + 4 * F.lane + 256 * j) = pk4_fp8(h.v[j][0] * X8_SCALE, h.v[j][1] * X8_SCALE, h.v[j][2] * X8_SCALE, h.v[j][3] * X8_SCALE);
        }
#endif
        if (l == 1) {
            float lg[NE];
#pragma unroll
            for (int e = 0; e < NE; ++e) { float a_ = 0.f;
#pragma unroll
                for (int j = 0; j < 8; ++j) { const f32x4 w4 = *(const LAS f32x4*)(LV(8 + e) + 4 * F.lane + 256 * j); a_ += (h.v[j][0] * w4[0] + h.v[j][1] * w4[1]) + (h.v[j][2] * w4[2] + h.v[j][3] * w4[3]); }
                lg[e] = a_; }
#pragma unroll
            for (int e = 0; e < NE; ++e) lg[e] = wave_sum(lg[e]) + INP(I_BROUTER)[e];
            int e1 = 0; float v1 = lg[0];
#pragma unroll
            for (int e = 1; e < NE; ++e) if (lg[e] > v1) { v1 = lg[e]; e1 = e; }
            int e2 = -1; float v2 = -INFINITY;
#pragma unroll
            for (int e = 0; e < NE; ++e) if (e != e1 && lg[e] > v2) { v2 = lg[e]; e2 = e; }
            if (F.lane == 0) {
                const float w1 = 1.0f / (1.0f + __expf(v2 - v1)), w2 = 1.0f - w1;
                int* ti = (int*)(F.ws + WS_TINFO) + (size_t)r * 8;
                const int s1 = (int)__hip_atomic_fetch_add((LAS unsigned*)lcnt + e1, 1u, __ATOMIC_RELAXED, __HIP_MEMORY_SCOPE_WORKGROUP), s2 = (int)__hip_atomic_fetch_add((LAS unsigned*)lcnt + e2, 1u, __ATOMIC_RELAXED, __HIP_MEMORY_SCOPE_WORKGROUP);
                if (krow < 64) { rinfo[krow * 4 + 0] = e1; rinfo[krow * 4 + 1] = s1; rinfo[krow * 4 + 2] = e2; rinfo[krow * 4 + 3] = s2; }
                ti[0] = e1; ti[2] = e2; ti[4] = (int)__float_as_uint(w1); ti[5] = (int)__float_as_uint(w2);
            }
        }
    }
    if (l == 1) {
        __syncthreads();
        if (F.tid < NE) lbase[F.tid] = atomicAdd(F.ctl + CW_CNT + F.tid, lcnt[F.tid]);
        __syncthreads();
        if (F.lane == 0) { int* list = (int*)(F.ws + WS_LIST); int k = 0;
            for (int r = gw; r < rows; r += NGW, ++k) { if (k >= 64) break;
                const int e1 = rinfo[k * 4 + 0], s1 = (int)lbase[e1] + rinfo[k * 4 + 1], e2 = rinfo[k * 4 + 2], s2 = (int)lbase[e2] + rinfo[k * 4 + 3];
                int* ti = (int*)(F.ws + WS_TINFO) + (size_t)r * 8;
                list[e1 * MOE_CAP + s1] = r; list[e2 * MOE_CAP + s2] = r; ti[1] = s1; ti[3] = s2; } }
    }
}
__device__ __forceinline__ void t5_phase(Frame& F, int l) {
    const int gw = F.wave * F.G + F.vcu, NGW = F.G * 8, rows = (l == 0) ? MT : ML;
    const float* MODL = (const float*)(F.ws + WS_MOD) + (size_t)l * 3 * 6 * D; bf16* HX = (bf16*)(F.ws + WS_HX); float* XS = (float*)(F.ws + WS_XS);
    const float* gpost = INP(I_GPOSTFFN) + l * D;
    float chk_scale = 1.0f;
#if MIXCHECK
    { const float* acc = (const float*)(F.ctl + CW_CHK); const float tol = MIXCHECK_TOL; bool badg = false, bada = false;
      for (int q = 0; q < 2; ++q) { if (!(acc[4 * q + 0] <= tol * acc[4 * q + 1])) badg = true; if (!(acc[4 * q + 2] <= tol * acc[4 * q + 3])) bada = true; }
      chk_scale = 1.0f + (badg ? 2.0f : 0.f) + (bada ? 1.0f : 0.f); }
#endif
    int pb[NE + 1]; pb[0] = 0;
    if (l == 1) {
#pragma unroll
        for (int e = 0; e < NE; ++e) { int v = __builtin_amdgcn_readfirstlane((int)F.ctl[CW_CNT + e]); v = v > MOE_CAP ? MOE_CAP : v; pb[e + 1] = pb[e] + ((v + 255) >> 8); }
    }
    Row xn; RowH fa_n, fb_n; int tin[6] = {0, 0, 0, 0, 0, 0}, tin2[6] = {0, 0, 0, 0, 0, 0};
    const bf16* YMb = (const bf16*)(F.ws + WS_LAF); const int* TI = (const int*)(F.ws + WS_TINFO);
#define T5_YM_ADDR(ti, which) (YMb + (size_t)(({ int p_ = 0; _Pragma("unroll") for (int e = 0; e < NE; ++e) if (e == (ti)[2 * (which)]) p_ = pb[e]; p_; }) * 256 + (ti)[2 * (which) + 1]) * D)
    if (gw < rows) { const int g0 = ROWMAP(gw); row_load(xn, XS + (size_t)g0 * D, F.lane);
        if (l == 0) rowh_load(fa_n, (const bf16*)(F.ws + WS_Y) + (size_t)g0 * D, F.lane);
        else {
#pragma unroll
            for (int q = 0; q < 6; ++q) tin[q] = TI[(size_t)gw * 8 + q];
            if (gw + NGW < rows) {
#pragma unroll
                for (int q = 0; q < 6; ++q) tin2[q] = TI[(size_t)(gw + NGW) * 8 + q]; }
            rowh_load(fa_n, T5_YM_ADDR(tin, 0), F.lane); rowh_load(fb_n, T5_YM_ADDR(tin, 1), F.lane); } }
    stage_vec(F, 0, gpost);
#pragma unroll
    for (int m = 0; m < 3; ++m) { stage_vec(F, 1 + m, MODL + (size_t)m * 6 * D + 5 * D);
        if (l == 0) { stage_vec(F, 5 + 2 * m, MODL + (size_t)(3 + m) * 6 * D + D); stage_vec(F, 6 + 2 * m, MODL + (size_t)(3 + m) * 6 * D); } }
    if (l == 0) stage_vec(F, 4, INP(I_GPREMIX) + D);
    __syncthreads();
    for (int ix = gw; ix < rows; ix += NGW) { const int r = ROWMAP(ix);
        Row x, f, h; RowH fa, fb; int tic[6];
        row_touch(xn); rowh_touch(fa_n); if (l == 1) { rowh_touch(fb_n); asm volatile("" : "+v"(tin2[0]), "+v"(tin2[1]), "+v"(tin2[2]), "+v"(tin2[3]), "+v"(tin2[4]), "+v"(tin2[5])); }
        x = xn; fa = fa_n; fb = fb_n;
#pragma unroll
        for (int q = 0; q < 6; ++q) tic[q] = tin[q];
        if (ix + NGW < rows) { const int rn = ROWMAP(ix + NGW);
            if (l == 1) {
#pragma unroll
                for (int q = 0; q < 6; ++q) tin[q] = tin2[q];
                if (rn + NGW < rows) {
#pragma unroll
                    for (int q = 0; q < 6; ++q) tin2[q] = TI[(size_t)(rn + NGW) * 8 + q]; } }
            row_load(xn, XS + (size_t)rn * D, F.lane);
            if (l == 0) rowh_load(fa_n, (const bf16*)(F.ws + WS_Y) + (size_t)rn * D, F.lane);
            else { rowh_load(fa_n, T5_YM_ADDR(tin, 0), F.lane); rowh_load(fb_n, T5_YM_ADDR(tin, 1), F.lane); } }
        if (CTX_SPLIT && DENSE_FP8 != 1 && l == 0 && r >= ML) row_sum_slices<YP_S5>(f, (const float*)(F.ws + WS_YP) + (size_t)(r - ML) * D, (size_t)MC * D, F.lane);
        else if (l == 0) rowh_cvt(f, fa);
        else { const float w1 = __uint_as_float((unsigned)tic[4]), w2 = __uint_as_float((unsigned)tic[5]); Row a, b; rowh_cvt(a, fa); rowh_cvt(b, fb);
#pragma unroll
            for (int j = 0; j < 8; ++j) f.v[j] = a.v[j] * w1 + b.v[j] * w2; }
        const int m = mod_row(r);
        const float rs = 1.0f / sqrtf(row_ss(f) * (1.0f / D) + RMS_EPS);
#pragma unroll
        for (int j = 0; j < 8; ++j) { const int o = 4 * F.lane + 256 * j; const f32x4 gg = *(const LAS f32x4*)(LV(0) + o), gt = *(const LAS f32x4*)(LV(1 + m) + o);
            x.v[j] = x.v[j] + gt * (f.v[j] * rs * gg);
            if (l == 0) *(f32x4*)(XS + (size_t)r * D + o) = x.v[j]; else __builtin_nontemporal_store(x.v[j] * chk_scale, (f32x4*)(F.out + (size_t)r * D + o)); }
        if (l == 0) prenorm_store_l(x, h, LV(4), LV(5 + 2 * m), LV(6 + 2 * m), HX + (size_t)r * D, F.lane);
    }
#undef T5_YM_ADDR
#undef ROWMAP
}

__device__ __forceinline__ void prep_phase(Frame& F, int l) {
    const bf16* P = (const bf16*)(F.ws + WS_P);
    const size_t gt = (size_t)F.vcu * 512 + F.tid, NT = (size_t)F.G * 512;
    {
        float* LAF = (float*)(F.ws + WS_LAF); float* LAB = (float*)(F.ws + WS_LAB);
        const float* wf = INP(I_WLRF) + (size_t)l * 16 * 1024; const float* wb = INP(I_WLRB) + (size_t)l * 16 * 1024; const float* bfv = INP(I_BLRF) + l * 1024; const float* bbv = INP(I_BLRB) + l * 1024;
        for (size_t idx = gt; idx < (size_t)MT * 1024; idx += NT) { const int r = (int)(idx >> 10), d = (int)(idx & 1023);
            const u32x4* lr = (const u32x4*)((const bf16*)(F.ws + WS_LRB + (size_t)l * SZ_LRB) + (size_t)r * 256); const u32x4 a0 = lr[0], a1 = lr[1], b0 = lr[2], b1 = lr[3];
            const unsigned fa[8] = {a0.x, a0.y, a0.z, a0.w, a1.x, a1.y, a1.z, a1.w}, fb[8] = {b0.x, b0.y, b0.z, b0.w, b1.x, b1.y, b1.z, b1.w};
            float zf = bfv[d], zb = bbv[d];
#pragma unroll
            for (int j = 0; j < 8; ++j) { zf += bflo(fa[j]) * wf[(2 * j) * 1024 + d] + bfhi(fa[j]) * wf[(2 * j + 1) * 1024 + d]; zb += bflo(fb[j]) * wb[(2 * j) * 1024 + d] + bfhi(fb[j]) * wb[(2 * j + 1) * 1024 + d]; }
            LAF[idx] = logsigf_(zf) * (1.0f / 16.0f); LAB[idx] = logsigf_(zb) * (1.0f / 16.0f); }
    }
    {
        bf16* QR = (bf16*)(F.ws + WS_QR); bf16* KR = (bf16*)(F.ws + WS_KR);
        for (size_t idx = gt; idx < (size_t)MT * 1152; idx += NT) { const int r = (int)(idx / 1152), p = (int)(idx % 1152);
            const bool isq = p < 1024; const int hp = isq ? p : p - 1024, head = hp >> 5, pp = hp & 31, half = pp >> 4, i = pp & 15, d0 = half * 32 + i, d1 = d0 + 16;
            const bf16* src = P + (size_t)r * NP + (isq ? OAQ : OAK) + head * 64; float x0 = bf2f(src[d0]), x1 = bf2f(src[d1]);
            float o0 = x0, o1 = x1;
            if (r < ML) { const int t = r % SEQ; const float pos = (float)(half == 0 ? (t >> 6) : (t & 63)); const float inv = exp2f(-(float)i * (13.287712379549449f / 16.0f));
                float sn, cs; sincosf(pos * inv, &sn, &cs); o0 = x0 * cs - x1 * sn; o1 = x1 * cs + x0 * sn; }
            if (isq) { o0 *= 0.18033688011112042f; o1 *= 0.18033688011112042f; QR[(size_t)r * D + head * 64 + d0] = f2bf(o0); QR[(size_t)r * D + head * 64 + d1] = f2bf(o1); }
            else { KR[(size_t)r * 256 + head * 64 + d0] = f2bf(o0); KR[(size_t)r * 256 + head * 64 + d1] = f2bf(o1); } }
    }
}

__device__ __forceinline__ int gla_row(int b, int dir, int s) { if (s < CTXL) { const int p = dir ? CTXL - 1 - s : s; return ML + b * CTXL + p; } const int q = s - CTXL; const int p = dir ? SEQ - 1 - q : q; return b * SEQ + p; }
__device__ __forceinline__ void mix_simple_gla(Frame& F, int wg, size_t ws_of, size_t ws_ob) {
    const bf16* P = (const bf16*)(F.ws + WS_P);
    const int seq = wg >> 2, dvb = wg & 3, b = seq >> 3, h = (seq >> 1) & 3, dir = seq & 1;
    const float* LA = (const float*)(F.ws + (dir ? WS_LAB : WS_LAF)); float* O = (float*)(F.ws + (dir ? ws_ob : ws_of));
    LAS float* sa = (LAS float*)F.lds; LAS float* sq = sa + 32 * 256; LAS float* sk = sq + 32 * 256; LAS float* sv = sk + 32 * 256;
    const int qd = F.tid & 3, jl = F.tid >> 2;
    float S[64];
#pragma unroll
    for (int i = 0; i < 64; ++i) S[i] = 0.f;
    for (int c0 = 0; c0 < CTXL + SEQ; c0 += 32) {
        __syncthreads();
        for (int idx = F.tid; idx < 32 * 256; idx += 512) { const int st = idx >> 8, dk = idx & 255; const int row = gla_row(b, dir, c0 + st);
            sa[idx] = __expf(LA[(size_t)row * 1024 + h * 256 + dk]); sq[idx] = bf2f(P[(size_t)row * NP + OQ + h * 256 + dk]) * 0.0625f; sk[idx] = bf2f(P[(size_t)row * NP + OKK + h * 256 + dk]); }
        for (int idx = F.tid; idx < 32 * 128; idx += 512) { const int st = idx >> 7, j = idx & 127; const int row = gla_row(b, dir, c0 + st); sv[idx] = bf2f(P[(size_t)row * NP + OV + h * 512 + dvb * 128 + j]); }
        __syncthreads();
        for (int st = 0; st < 32; ++st) {
            const float v = sv[st * 128 + jl]; float o = 0.f;
            const LAS f32x4* pa = (const LAS f32x4*)(sa + st * 256 + qd * 64); const LAS f32x4* pq = (const LAS f32x4*)(sq + st * 256 + qd * 64); const LAS f32x4* pk = (const LAS f32x4*)(sk + st * 256 + qd * 64);
#pragma unroll
            for (int i4 = 0; i4 < 16; ++i4) { const f32x4 a = pa[i4], q = pq[i4], k = pk[i4];
#pragma unroll
                for (int e = 0; e < 4; ++e) { const float s = a[e] * S[i4 * 4 + e] + k[e] * v; S[i4 * 4 + e] = s; o += q[e] * s; } }
            o += __shfl_xor(o, 1); o += __shfl_xor(o, 2);
            if (qd == 0) ((bf16*)O)[(size_t)gla_row(b, dir, c0 + st) * D + h * 512 + dvb * 128 + jl] = f2bf(o);
        }
    }
}
__device__ __forceinline__ void mix_simple_attn(Frame& F, int l, int wg, int nwg, size_t ws_ax) {
    const bf16* P = (const bf16*)(F.ws + WS_P); const bf16* QR = (const bf16*)(F.ws + WS_QR); const bf16* KR = (const bf16*)(F.ws + WS_KR); bf16* AX = (bf16*)(F.ws + ws_ax);
    const int rows = (l == 0) ? MT : ML;
    for (size_t idx = (size_t)wg * 512 + F.tid; idx < (size_t)rows * AHQ; idx += (size_t)nwg * 512) {
        const int r = (int)(idx >> 5), hq = (int)(idx & 31), kvh = hq >> 3;
        float q[64], o[64];
        { const u32x4* qp = (const u32x4*)(QR + (size_t)r * D + hq * 64);
#pragma unroll
            for (int j = 0; j < 8; ++j) { const u32x4 w = qp[j]; q[8 * j] = bflo(w.x); q[8 * j + 1] = bfhi(w.x); q[8 * j + 2] = bflo(w.y); q[8 * j + 3] = bfhi(w.y); q[8 * j + 4] = bflo(w.z); q[8 * j + 5] = bfhi(w.z); q[8 * j + 6] = bflo(w.w); q[8 * j + 7] = bfhi(w.w); } }
#pragma unroll
        for (int d = 0; d < 64; ++d) o[d] = 0.f;
        float m = INP(I_SINK)[l * AHQ + hq] * 1.4426950408889634f, lsum = 1.0f;
        int b, k0 = 0, k1 = 0;
        if (r < ML) { b = r / SEQ; const int t = r % SEQ; k0 = t - AWIN < 0 ? 0 : t - AWIN; k1 = t + AWIN > SEQ - 1 ? SEQ - 1 : t + AWIN; k1 += 1; } else b = (r - ML) / CTXL;
        const int nloc = k1 - k0, ntot = nloc + CTXL;
        for (int kk = 0; kk < ntot; ++kk) {
            const int kr = kk < nloc ? b * SEQ + k0 + kk : ML + b * CTXL + (kk - nloc);
            const u32x4* kp = (const u32x4*)(KR + (size_t)kr * 256 + kvh * 64); float s = 0.f;
#pragma unroll
            for (int j = 0; j < 8; ++j) { const u32x4 w = kp[j]; s += q[8 * j] * bflo(w.x) + q[8 * j + 1] * bfhi(w.x) + q[8 * j + 2] * bflo(w.y) + q[8 * j + 3] * bfhi(w.y) + q[8 * j + 4] * bflo(w.z) + q[8 * j + 5] * bfhi(w.z) + q[8 * j + 6] * bflo(w.w) + q[8 * j + 7] * bfhi(w.w); }
            float p;
            if (s > m) { const float sc = __builtin_amdgcn_exp2f(m - s); lsum *= sc;
#pragma unroll
                for (int d = 0; d < 64; ++d) o[d] *= sc;
                m = s; p = 1.0f; } else p = __builtin_amdgcn_exp2f(s - m);
            lsum += p;
            const u32x4* vp = (const u32x4*)(P + (size_t)kr * NP + OAV + kvh * 64);
#pragma unroll
            for (int j = 0; j < 8; ++j) { const u32x4 w = vp[j]; o[8 * j] += p * bflo(w.x); o[8 * j + 1] += p * bfhi(w.x); o[8 * j + 2] += p * bflo(w.y); o[8 * j + 3] += p * bfhi(w.y); o[8 * j + 4] += p * bflo(w.z); o[8 * j + 5] += p * bfhi(w.z); o[8 * j + 6] += p * bflo(w.w); o[8 * j + 7] += p * bfhi(w.w); }
        }
        const float il = 1.0f / lsum; u32x4* op = (u32x4*)(AX + (size_t)r * D + hq * 64);
#pragma unroll
        for (int j = 0; j < 8; ++j) { u32x4 w; w.x = cvt_pk_bf16(o[8 * j] * il, o[8 * j + 1] * il); w.y = cvt_pk_bf16(o[8 * j + 2] * il, o[8 * j + 3] * il); w.z = cvt_pk_bf16(o[8 * j + 4] * il, o[8 * j + 5] * il); w.w = cvt_pk_bf16(o[8 * j + 6] * il, o[8 * j + 7] * il); op[j] = w; }
    }
}
__device__ __forceinline__ void ro_phase(Frame& F, int l) {
    const int gw = F.vcu * 8 + F.wave, NGW = F.G * 8, rows = (l == 0) ? MT : ML;
    const bf16* P = (const bf16*)(F.ws + WS_P); const bf16* OF = (const bf16*)(F.ws + WS_OF); const bf16* OB = (const bf16*)(F.ws + WS_OB); bf16* GX = (bf16*)(F.ws + WS_GX);
    const float* gg = INP(I_GGLA) + l * GDV;
    const f32x4 gla0 = *(const f32x4*)(gg + 4 * F.lane), gla1 = *(const f32x4*)(gg + 4 * F.lane + 256);
    RowH an, bn, gn;
    if (gw < rows) { rowh_load(an, OF + (size_t)gw * D, F.lane); rowh_load(bn, OB + (size_t)gw * D, F.lane); rowh_load(gn, P + (size_t)gw * NP + ORG, F.lane); }
    for (int r = gw; r < rows; r += NGW) {
        Row a, b; RowH ah, bh, gh; rowh_touch(an); rowh_touch(bn); rowh_touch(gn); ah = an; bh = bn; gh = gn;
        if (r + NGW < rows) { const int rn = r + NGW; rowh_load(an, OF + (size_t)rn * D, F.lane); rowh_load(bn, OB + (size_t)rn * D, F.lane); rowh_load(gn, P + (size_t)rn * NP + ORG, F.lane); }
        rowh_cvt(a, ah); rowh_cvt(b, bh);
#pragma unroll
        for (int j = 0; j < 8; ++j) a.v[j] = a.v[j] + b.v[j];
#pragma unroll
        for (int hh = 0; hh < 4; ++hh) {
            float s = 0.f;
#pragma unroll
            for (int j = 2 * hh; j < 2 * hh + 2; ++j) s += (a.v[j][0] * a.v[j][0] + a.v[j][1] * a.v[j][1]) + (a.v[j][2] * a.v[j][2] + a.v[j][3] * a.v[j][3]);
            const float rs = 1.0f / sqrtf(wave_sum(s) * (1.0f / GDV) + RMS_EPS);
#pragma unroll
            for (int j = 2 * hh; j < 2 * hh + 2; ++j) { const int o = 4 * F.lane + 256 * j; const f32x4 g4 = (j & 1) ? gla1 : gla0;
                const u32x2 rw = gh.v[j]; const float r0 = bflo(rw.x), r1 = bfhi(rw.x), r2 = bflo(rw.y), r3 = bfhi(rw.y);
                u32x2 w; w.x = cvt_pk_bf16(a.v[j][0] * rs * g4[0] * siluf_(r0), a.v[j][1] * rs * g4[1] * siluf_(r1)); w.y = cvt_pk_bf16(a.v[j][2] * rs * g4[2] * siluf_(r2), a.v[j][3] * rs * g4[3] * siluf_(r3));
                *(u32x2*)(GX + (size_t)r * D + o) = w; }
        }
    }
}

__device__ __forceinline__ int swzQ(int row, int bytecol) { return row * 512 + ((((bytecol >> 4) ^ (row & 15)) << 4) | (bytecol & 15)); }
__device__ __forceinline__ int swz64(int row, int bytecol) { return row * 128 + ((((bytecol >> 4) ^ ((row >> 1) & 7)) << 4) | (bytecol & 15)); }
__device__ __forceinline__ void glds16(const void* gsrc, LAS unsigned char* dst_uniform) { __builtin_amdgcn_global_load_lds((const unsigned*)gsrc, (LAS unsigned*)dst_uniform, 16, 0, 0); }
typedef short s16x4 __attribute__((ext_vector_type(4)));
__device__ __forceinline__ bf16x8 cat8(s16x4 a, s16x4 b) { return (bf16x8){a[0], a[1], a[2], a[3], b[0], b[1], b[2], b[3]}; }
typedef __bf16 bf16x2_t __attribute__((ext_vector_type(2)));
__device__ __forceinline__ unsigned cvt_pk_bf16_b(float lo, float hi) { const f32x2 v = {lo, hi}; const bf16x2_t b = __builtin_convertvector(v, bf16x2_t); return __builtin_bit_cast(unsigned, b); }
__device__ __forceinline__ bf16x8 pack8b(const f32x4& a, const f32x4& b) { u32x4 w; w.x = cvt_pk_bf16_b(a[0], a[1]); w.y = cvt_pk_bf16_b(a[2], a[3]); w.z = cvt_pk_bf16_b(b[0], b[1]); w.w = cvt_pk_bf16_b(b[2], b[3]); return __builtin_bit_cast(bf16x8, w); }
__device__ __forceinline__ bf16x8 pack8(const f32x4& a, const f32x4& b) { u32x4 w; w.x = cvt_pk_bf16(a[0], a[1]); w.y = cvt_pk_bf16(a[2], a[3]); w.z = cvt_pk_bf16(b[0], b[1]); w.w = cvt_pk_bf16(b[2], b[3]);
    return __builtin_bit_cast(bf16x8, w); }
__device__ __forceinline__ int gla_item_row0(int it) { const int c = it % 68, bh = it / 68, b = bh >> 2; return c < 4 ? ML + b * CTXL + 64 * c : b * SEQ + 64 * (c - 4); }

typedef unsigned u32x8 __attribute__((ext_vector_type(8)));
#define CAS __attribute__((address_space(4)))
__device__ __forceinline__ void gla_prep_item(Frame& F, int l, int it, int dm) {
    const bf16* P = (const bf16*)(F.ws + WS_P);
    const int bh = it / 68, h = bh & 3, r0 = gla_item_row0(it);
    LAS unsigned char* Qs = F.lds; LAS unsigned char* Ks = F.lds + 65536;
    const int tid = F.tid, d = tid & 255, dir = __builtin_amdgcn_readfirstlane(tid >> 8);
    __syncthreads();
#pragma unroll
    for (int m = 0; m < 4; ++m) { const int ci = tid + 512 * m, row = ci >> 5, c = ci & 31, off = row * 512 + ((c ^ (row & 15)) << 4);
        const u32x4 qv = *(const u32x4*)(P + (size_t)(r0 + row) * NP + OQ + h * 256 + 8 * c), kv = *(const u32x4*)(P + (size_t)(r0 + row) * NP + OKK + h * 256 + 8 * c);
        *(LAS u32x4*)(Qs + off) = qv; *(LAS u32x4*)(Qs + 32768 + off) = qv; *(LAS u32x4*)(Ks + off) = kv; *(LAS u32x4*)(Ks + 32768 + off) = kv; }
    const float* wl = (dir ? INP(I_WLRB) : INP(I_WLRF)) + (size_t)l * 16 * 1024 + h * 256 + d;
    float w[16];
#pragma unroll
    for (int j = 0; j < 16; ++j) w[j] = wl[j * 1024];
    const float bias = (dir ? INP(I_BLRB) : INP(I_BLRF))[l * 1024 + h * 256 + d];
    bf16* QIN = (bf16*)(F.ws + WS_QIN + dir * SZ_QIN);
    const CAS unsigned* lrp = (const CAS unsigned*)(const GAS unsigned*)((const bf16*)(F.ws + WS_LRB + (size_t)l * SZ_LRB) + (size_t)r0 * 256 + dir * 16);
    const int qoff = dir * 32768 + ((d * 2) & 15), cblk = d >> 3;
    const bool act = (dm >> dir) & 1;
    __syncthreads();
    if (act) {
    float bsum = 0.f;
#define LR_LOAD(dst, s0_) _Pragma("unroll") for (int u = 0; u < 4; ++u) { const int i_ = dir ? 63 - ((s0_) + u) : (s0_) + u; dst[u] = *(const CAS u32x8*)(lrq + (size_t)i_ * 128); }
    const CAS unsigned* lrq = lrp;
    u32x8 cur[4]; LR_LOAD(cur, 0)
#pragma unroll 2
    for (int s0 = 0; s0 < 64; s0 += 4) {
        u32x8 nxt[4];
        asm volatile("" : "+s"(cur[0]), "+s"(cur[1]), "+s"(cur[2]), "+s"(cur[3]), "+s"(lrq));
        { const int sn = (s0 + 4) & 63; LR_LOAD(nxt, sn) }
        float e[4], ie[4]; int off[4];
#pragma unroll
        for (int u = 0; u < 4; ++u) {
            const int i = dir ? 63 - (s0 + u) : s0 + u;
            const u32x8 lv = cur[u];
            float z0 = bias, z1 = 0.f;
#pragma unroll
            for (int j = 0; j < 8; ++j) { z0 += bflo(lv[j]) * w[2 * j]; z1 += bfhi(lv[j]) * w[2 * j + 1]; }
            const float z = z0 + z1;
            bsum += fminf(z, 0.f) * (1.4426950408889634f / 16.0f) - __builtin_amdgcn_logf(1.0f + __builtin_amdgcn_exp2f(-1.4426950408889634f * fabsf(z))) * (1.0f / 16.0f);
            e[u] = __builtin_amdgcn_exp2f(bsum - 4.0f); ie[u] = __builtin_amdgcn_exp2f(-bsum);
            off[u] = qoff + i * 512 + ((cblk ^ (i & 15)) << 4);
        }
        unsigned short qr[4], kr[4];
#pragma unroll
        for (int u = 0; u < 4; ++u) { qr[u] = *(const LAS unsigned short*)(Qs + off[u]); kr[u] = *(const LAS unsigned short*)(Ks + off[u]); }
#pragma unroll
        for (int u = 0; u < 4; ++u) { const int i = dir ? 63 - (s0 + u) : s0 + u;
            const bf16 qb = f2bf(__builtin_bit_cast(float, (unsigned)qr[u] << 16) * e[u]); const bf16 kb = f2bf(__builtin_bit_cast(float, (unsigned)kr[u] << 16) * ie[u]);
            *(LAS bf16*)(Qs + off[u]) = qb; *(LAS bf16*)(Ks + off[u]) = kb;
            QIN[(size_t)(r0 + i) * 1024 + h * 256 + d] = qb; }
#pragma unroll
        for (int u = 0; u < 4; ++u) cur[u] = nxt[u];
    }
#undef LR_LOAD
    {
        const float eb = __builtin_amdgcn_exp2f(bsum);
        ((float*)(F.ws + WS_DEC + dir * SZ_DEC))[(size_t)it * 256 + d] = eb;
        u32x4* kt = (u32x4*)((bf16*)(F.ws + WS_KTO + dir * SZ_KTO) + ((size_t)it * 256 + d) * 64);
#pragma unroll
        for (int t8 = 0; t8 < 8; ++t8) { float v[8];
#pragma unroll
            for (int j = 0; j < 8; ++j) v[j] = bf2f(*(const LAS bf16*)(Ks + dir * 32768 + swzQ(t8 * 8 + j, d * 2))) * eb;
            u32x4 wv; wv.x = cvt_pk_bf16(v[0], v[1]); wv.y = cvt_pk_bf16(v[2], v[3]); wv.z = cvt_pk_bf16(v[4], v[5]); wv.w = cvt_pk_bf16(v[6], v[7]); kt[t8] = wv; }
    }
    }
    u32x4 vreg[8];
#pragma unroll
    for (int m = 0; m < 8; ++m) { const int ci = tid + 512 * m, row = ci >> 6, c = ci & 63; vreg[m] = (dm & 1) ? *(const u32x4*)(P + (size_t)(r0 + row) * NP + OV + h * 512 + 8 * c) : (u32x4){0u, 0u, 0u, 0u}; }
    __syncthreads();
    {
        const int wv = F.wave, dw = wv >> 2, itile = wv & 3, r = F.lane & 15, g = F.lane >> 4;
        if ((dm >> dw) & 1) {
        bf16x8 af[8];
#pragma unroll
        for (int kk = 0; kk < 8; ++kk) af[kk] = *(const LAS bf16x8*)(Qs + dw * 32768 + swzQ(16 * itile + r, (32 * kk + 8 * g) * 2));
        bf16* AO = (bf16*)(F.ws + WS_AIN + dw * SZ_AIN) + (size_t)it * 4096;
#pragma unroll
        for (int jt = 0; jt < 4; ++jt) {
            f32x4 acc = (f32x4){0.f, 0.f, 0.f, 0.f};
            const bool live = dw == 0 ? (jt <= itile) : (jt >= itile);
            if (live) {
#pragma unroll
                for (int kk = 0; kk < 8; ++kk) { const bf16x8 bq = *(const LAS bf16x8*)(Ks + dw * 32768 + swzQ(16 * jt + r, (32 * kk + 8 * g) * 2)); acc = __builtin_amdgcn_mfma_f32_16x16x32_bf16(af[kk], bq, acc, 0, 0, 0); }
            }
#pragma unroll
            for (int q = 0; q < 4; ++q) { const int i = 16 * itile + 4 * g + q, j = 16 * jt + r; const bool keep = dw == 0 ? (j <= i) : (j >= i); AO[i * 64 + j] = f2bf(keep ? acc[q] : 0.f); }
        }
        }
    }
    if (!(dm & 1)) return;
    __syncthreads();
#pragma unroll
    for (int m = 0; m < 8; ++m) { const int ci = tid + 512 * m; *(LAS u32x4*)(Qs + ci * 16) = vreg[m]; }
    __syncthreads();
    {
        const int dv = tid;
        u32x4* vt = (u32x4*)((bf16*)(F.ws + WS_VT) + ((size_t)it * 512 + dv) * 64);
#pragma unroll
        for (int t8 = 0; t8 < 8; ++t8) { unsigned wd[4];
#pragma unroll
            for (int p = 0; p < 4; ++p) { const unsigned lo = *(const LAS unsigned short*)(Qs + (8 * t8 + 2 * p) * 1024 + 2 * dv), hi = *(const LAS unsigned short*)(Qs + (8 * t8 + 2 * p + 1) * 1024 + 2 * dv); wd[p] = lo | (hi << 16); }
            u32x4 wv; wv.x = wd[0]; wv.y = wd[1]; wv.z = wd[2]; wv.w = wd[3]; vt[t8] = wv; }
    }
}
__device__ __forceinline__ void prep_fast_phase(Frame& F, int l, int parts) {
    const int nex = NIT - 2 * F.G;
    if (parts & 1) { for (int it = F.vcu; it < 2 * F.G; it += F.G) gla_prep_item(F, l, it, 3);
        if (F.vcu < 2 * nex) gla_prep_item(F, l, 2 * F.G + (F.vcu >> 1), 1 << (F.vcu & 1)); }
    const bf16* P = (const bf16*)(F.ws + WS_P);
    const size_t gt = (size_t)F.vcu * 512 + F.tid, NT = (size_t)F.G * 512;
    if (parts & 2) {
        bf16* QR = (bf16*)(F.ws + WS_QR); bf16* KR = (bf16*)(F.ws + WS_KR);
        LAS float* tcs = (LAS float*)(F.lds + 131072); LAS float* tsn = tcs + 1024;
        for (int idx = F.tid; idx < 1024; idx += 512) { const float ang = (float)(idx >> 4) * __builtin_amdgcn_exp2f(-(float)(idx & 15) * (13.287712379549449f / 16.0f)) * 0.15915494309189535f;
            tcs[idx] = __builtin_amdgcn_cosf(ang); tsn[idx] = __builtin_amdgcn_sinf(ang); }
        __syncthreads();
        const int nfull = 2 * nex, nwv = (F.G - nfull) * 8, tpw = (MT * 144 + nwv - 1) / nwv;
        const int wv_ = (F.vcu - nfull) * 8 + F.wave, tbeg = wv_ * tpw, tend = (F.vcu < nfull) ? 0 : min(MT * 144, tbeg + tpw);
#pragma unroll 3
        for (int t_ = (F.vcu < nfull ? MT * 144 : tbeg) + F.lane; t_ < tend; t_ += 64) { const int r = t_ / 144, p = t_ % 144;
                const bool isq = p < 128; const int hp = isq ? p : p - 128, head = hp >> 2, half = (hp >> 1) & 1, sub = hp & 1, d0 = half * 32 + sub * 8;
                const bf16* src = P + (size_t)r * NP + (isq ? OAQ : OAK) + head * 64 + d0;
                const u32x4 a = *(const u32x4*)src, bq = *(const u32x4*)(src + 16);
                float x0[8] = {bflo(a.x), bfhi(a.x), bflo(a.y), bfhi(a.y), bflo(a.z), bfhi(a.z), bflo(a.w), bfhi(a.w)}, x1[8] = {bflo(bq.x), bfhi(bq.x), bflo(bq.y), bfhi(bq.y), bflo(bq.z), bfhi(bq.z), bflo(bq.w), bfhi(bq.w)};
                float o0[8], o1[8];
                const float sc = isq ? 0.18033688011112042f : 1.0f;
                if (r < ML) { const int t = r % SEQ, pos = half == 0 ? (t >> 6) : (t & 63);
                    const LAS f32x4* pc = (const LAS f32x4*)(tcs + pos * 16 + sub * 8); const LAS f32x4* ps = (const LAS f32x4*)(tsn + pos * 16 + sub * 8);
                    const f32x4 c0 = pc[0], c1 = pc[1], s0 = ps[0], s1 = ps[1];
#pragma unroll
                    for (int j = 0; j < 8; ++j) { const float cs = j < 4 ? c0[j & 3] : c1[j & 3], sn = j < 4 ? s0[j & 3] : s1[j & 3]; o0[j] = (x0[j] * cs - x1[j] * sn) * sc; o1[j] = (x1[j] * cs + x0[j] * sn) * sc; } }
                else {
#pragma unroll
                    for (int j = 0; j < 8; ++j) { o0[j] = x0[j] * sc; o1[j] = x1[j] * sc; } }
                bf16* dst = (isq ? QR + (size_t)r * D : KR + (size_t)r * 256) + head * 64 + d0;
                u32x4 w0, w1; w0.x = cvt_pk_bf16(o0[0], o0[1]); w0.y = cvt_pk_bf16(o0[2], o0[3]); w0.z = cvt_pk_bf16(o0[4], o0[5]); w0.w = cvt_pk_bf16(o0[6], o0[7]);
                w1.x = cvt_pk_bf16(o1[0], o1[1]); w1.y = cvt_pk_bf16(o1[2], o1[3]); w1.z = cvt_pk_bf16(o1[4], o1[5]); w1.w = cvt_pk_bf16(o1[6], o1[7]);
                *(u32x4*)dst = w0; *(u32x4*)(dst + 16) = w1; }
    }
    if (parts & 4) {   bf16* VAT = (bf16*)(F.ws + WS_VAT);
        LAS unsigned char* Ts = F.lds;
        for (int ch = F.G - 1 - F.vcu; ch < MT / 64; ch += F.G) {
            u32x4 vr[4];
#pragma unroll
            for (int m = 0; m < 4; ++m) { const int ci = F.tid + 512 * m, row = ci >> 5, c = ci & 31; vr[m] = *(const u32x4*)(P + (size_t)(ch * 64 + row) * NP + OAV + 8 * c); }
            __syncthreads();
#pragma unroll
            for (int m = 0; m < 4; ++m) { const int ci = F.tid + 512 * m; *(LAS u32x4*)(Ts + ci * 16) = vr[m]; }
            __syncthreads();
            const int kd = F.tid & 255, hf = F.tid >> 8;
            u32x4* vt = (u32x4*)(VAT + ((size_t)ch * 256 + kd) * 64) + hf * 4;
#pragma unroll
            for (int t8 = 0; t8 < 4; ++t8) { unsigned wd[4];
#pragma unroll
                for (int p = 0; p < 4; ++p) { const int tk = hf * 32 + 8 * t8 + 2 * p; const unsigned lo = *(const LAS unsigned short*)(Ts + tk * 512 + 2 * kd), hi = *(const LAS unsigned short*)(Ts + (tk + 1) * 512 + 2 * kd); wd[p] = lo | (hi << 16); }
                u32x4 wv; wv.x = wd[0]; wv.y = wd[1]; wv.z = wd[2]; wv.w = wd[3]; vt[t8] = wv; }
        }
    }
}

constexpr int SC_STAGE = 73728, SC_Q = 0, SC_KT = 32768, SC_A = 65536, SC_DEC = 147712;
constexpr int SC_FLAGS = MISC_OFF + 64;
__device__ __forceinline__ void sc_wait4(const volatile LAS unsigned* w4, unsigned need) {
    for (unsigned spins = 0; spins < (1u << 22); ++spins) {
        const unsigned a = w4[0], b = w4[1], c = w4[2], d = w4[3];
        const unsigned m = min(min(a, b), min(c, d));
        if (__builtin_amdgcn_readfirstlane(m) >= need) return;
        __builtin_amdgcn_s_sleep(1);
    }
}
template <int VAR> __device__ __forceinline__ void gla_scan(Frame& F, int wg) {
    const int seq = wg >> 2, dvb = wg & 3, b = seq >> 3, h = (seq >> 1) & 3, dir = seq & 1;
    const int w = F.wave, lane = F.lane, r = lane & 15, g = lane >> 4;
    const unsigned char* QIN = F.ws + WS_QIN + dir * SZ_QIN; const unsigned char* KTO = F.ws + WS_KTO + dir * SZ_KTO; const unsigned char* AIN = F.ws + WS_AIN + dir * SZ_AIN;
    const unsigned char* DEC = F.ws + WS_DEC + dir * SZ_DEC; const bf16* VT = (const bf16*)(F.ws + WS_VT);
    bf16* O = (bf16*)(F.ws + (dir ? WS_OB : WS_OF));
    const int itb = (b * 4 + h) * 68;
    LAS unsigned char* lds = F.lds;
    volatile LAS unsigned* flags = (volatile LAS unsigned*)(lds + SC_FLAGS);
    __syncthreads();
    if (F.tid < 16) flags[F.tid] = 0u;
    __syncthreads();
#define SC_CHUNK(n) (dir == 0 ? (n) : ((n) < 4 ? 3 - (n) : 71 - (n)))
    if (w >= 4) {
        const int hl = w - 4;
        for (int m = 0; m < 68; ++m) {
            const int it_ = itb + SC_CHUNK(m), r0_ = gla_item_row0(it_); LAS unsigned char* st_ = lds + (m & 1) * SC_STAGE;
            if (m >= 2) sc_wait4(flags + 8, (unsigned)(m - 1));
            if (VAR != 2) {
#pragma unroll
                for (int qi = 0; qi < 8; ++qi) { const int q_ = 8 * hl + qi, row_ = 2 * q_ + (lane >> 5), cc_ = (lane & 31) ^ (row_ & 15);
                    glds16(QIN + (size_t)(r0_ + row_) * 2048 + h * 512 + cc_ * 16, st_ + SC_Q + q_ * 1024); }
#pragma unroll
                for (int qi = 0; qi < 2; ++qi) { const int q_ = 2 * hl + qi, row_ = 8 * q_ + (lane >> 3), cc_ = (lane & 7) ^ ((row_ >> 1) & 7);
                    glds16(AIN + (size_t)it_ * 8192 + row_ * 128 + cc_ * 16, st_ + SC_A + q_ * 1024); }
            }
            if (m >= 1) { asm volatile("s_waitcnt vmcnt(10)" ::: "memory"); if (lane == 0) flags[4 + hl] = (unsigned)m; }
            if (m >= 2) sc_wait4(flags + 12, (unsigned)(m - 1));
            if (VAR != 2) {
#pragma unroll
                for (int qi = 0; qi < 8; ++qi) { const int q_ = 8 * hl + qi, row_ = 8 * q_ + (lane >> 3), cc_ = (lane & 7) ^ ((row_ >> 1) & 7);
                    glds16(KTO + (size_t)it_ * 32768 + row_ * 128 + cc_ * 16, st_ + SC_KT + q_ * 1024); }
                __builtin_amdgcn_global_load_lds((const unsigned*)(DEC + (size_t)it_ * 1024 + hl * 256 + lane * 4), (LAS unsigned*)(lds + SC_DEC + (m & 1) * 1024 + hl * 256), 4, 0, 0);
            }
            asm volatile("s_waitcnt vmcnt(9)" ::: "memory"); if (lane == 0) flags[hl] = (unsigned)(m + 1);
        }
        asm volatile("s_waitcnt vmcnt(0)" ::: "memory"); if (lane == 0) flags[4 + hl] = 68u;
    } else {
        const int c = w;
        f32x4 S[16][2];
#pragma unroll
        for (int t = 0; t < 16; ++t) { S[t][0] = (f32x4){0.f, 0.f, 0.f, 0.f}; S[t][1] = (f32x4){0.f, 0.f, 0.f, 0.f}; }
        bf16x8 vt[2][2];
        int k64off[2];
        const int qoff0 = r * 512 + ((((g >> 1) ^ r) & 15) << 4) + 8 * (g & 1);
#pragma unroll
        for (int ks = 0; ks < 2; ++ks) k64off[ks] = r * 128 + (((4 * ks + g) ^ ((r >> 1) & 7)) << 4);
#define SC_LOADVT(n) do { const int it_ = itb + SC_CHUNK(n); _Pragma("unroll") for (int ks = 0; ks < 2; ++ks) _Pragma("unroll") for (int nt = 0; nt < 2; ++nt) \
            vt[ks][nt] = *(const bf16x8*)(VT + ((size_t)it_ * 512 + dvb * 128 + 32 * c + 16 * nt + r) * 64 + 32 * ks + 8 * g); } while (0)
        SC_LOADVT(0);
        for (int n = 0; n < 68; ++n) {
            const LAS unsigned char* st = lds + (n & 1) * SC_STAGE; const LAS unsigned char* dec = lds + SC_DEC + (n & 1) * 1024 + 16 * g;
            const int row0 = gla_item_row0(itb + SC_CHUNK(n));
            const LAS unsigned char* kp0 = st + SC_KT + k64off[0]; const LAS unsigned char* kp1 = st + SC_KT + k64off[1];
            const LAS unsigned char* ap0 = st + SC_A + k64off[0]; const LAS unsigned char* ap1 = st + SC_A + k64off[1];
            sc_wait4(flags + 0, (unsigned)(n + 1));
            asm volatile("" ::: "memory");
#pragma unroll
            for (int mh = 0; mh < 2; ++mh) {
                f32x4 o[2][2];
#pragma unroll
                for (int mt = 0; mt < 2; ++mt) { o[mt][0] = (f32x4){0.f, 0.f, 0.f, 0.f}; o[mt][1] = (f32x4){0.f, 0.f, 0.f, 0.f}; }
                if (VAR != 1) {
                s16x4 qa[3][2][2];
#define SC_LOADQ(buf, ks_) do { _Pragma("unroll") for (int mt = 0; mt < 2; ++mt) { \
                    qa[buf][mt][0] = *(const LAS s16x4*)(st + SC_Q + (qoff0 ^ ((4 * ((ks_) & 3)) << 4)) + ((ks_) >> 2) * 256 + (2 * mh + mt) * 8192); \
                    qa[buf][mt][1] = *(const LAS s16x4*)(st + SC_Q + (qoff0 ^ ((4 * ((ks_) & 3) + 2) << 4)) + ((ks_) >> 2) * 256 + (2 * mh + mt) * 8192); } } while (0)
                SC_LOADQ(0, 0); SC_LOADQ(1, 1); __builtin_amdgcn_sched_barrier(0);
#pragma unroll
                for (int ks = 0; ks < 8; ++ks) {
                    if (ks < 6) SC_LOADQ((ks + 2) % 3, ks + 2);
                    __builtin_amdgcn_sched_barrier(0);
                    const bf16x8 sb0 = pack8(S[2 * ks][0], S[2 * ks + 1][0]), sb1 = pack8(S[2 * ks][1], S[2 * ks + 1][1]);
#pragma unroll
                    for (int mt = 0; mt < 2; ++mt) { const bf16x8 a_ = cat8(qa[ks % 3][mt][0], qa[ks % 3][mt][1]);
                        o[mt][0] = __builtin_amdgcn_mfma_f32_16x16x32_bf16(a_, sb0, o[mt][0], 0, 0, 0); o[mt][1] = __builtin_amdgcn_mfma_f32_16x16x32_bf16(a_, sb1, o[mt][1], 0, 0, 0); }
                    __builtin_amdgcn_sched_barrier(0);
                }
#undef SC_LOADQ
#pragma unroll
                for (int ks = 0; ks < 2; ++ks) { bf16x8 aa[2];
#pragma unroll
                    for (int mt = 0; mt < 2; ++mt) aa[mt] = *(const LAS bf16x8*)((ks ? ap1 : ap0) + (2 * mh + mt) * 2048);
                    __builtin_amdgcn_sched_barrier(0);
#pragma unroll
                    for (int mt = 0; mt < 2; ++mt) { o[mt][0] = __builtin_amdgcn_mfma_f32_16x16x32_bf16(aa[mt], vt[ks][0], o[mt][0], 0, 0, 0); o[mt][1] = __builtin_amdgcn_mfma_f32_16x16x32_bf16(aa[mt], vt[ks][1], o[mt][1], 0, 0, 0); }
                    __builtin_amdgcn_sched_barrier(0); }
                }
                if (mh == 1) { asm volatile("s_waitcnt lgkmcnt(0)" ::: "memory"); if (lane == 0) flags[8 + c] = (unsigned)(n + 1); }
                { int lo_ = (4 * g) * D + r; asm volatile("" : "+v"(lo_));
                  bf16* ob = O + (size_t)(row0 + 32 * mh) * D + h * 512 + dvb * 128 + 32 * c + lo_;
#pragma unroll
                  for (int mt = 0; mt < 2; ++mt)
#pragma unroll
                    for (int q = 0; q < 4; ++q) { ob[(16 * mt + q) * D] = f2bf(o[mt][0][q]); ob[(16 * mt + q) * D + 16] = f2bf(o[mt][1][q]); } }
            }
            sc_wait4(flags + 4, (unsigned)(n + 1));
            asm volatile("" ::: "memory");
            if (VAR != 1) {
            bf16x8 ka[3][2]; f32x4 dcv[3][2];
#define SC_LOADK(buf, bi) do { _Pragma("unroll") for (int t4 = 0; t4 < 2; ++t4) { const int ks_ = (bi) >> 3, t_ = 2 * ((bi) & 7) + t4; \
                ka[buf][t4] = *(const LAS bf16x8*)((ks_ ? kp1 : kp0) + t_ * 2048); \
                if ((bi) < 8) dcv[buf][t4] = *(const LAS f32x4*)(dec + t_ * 64); } } while (0)
            SC_LOADK(0, 0); SC_LOADK(1, 1); __builtin_amdgcn_sched_barrier(0);
#pragma unroll
            for (int bi = 0; bi < 16; ++bi) {
                if (bi < 14) SC_LOADK((bi + 2) % 3, bi + 2);
                __builtin_amdgcn_sched_barrier(0);
#pragma unroll
                for (int t4 = 0; t4 < 2; ++t4) { const int ks = bi >> 3, t = 2 * (bi & 7) + t4;
                    if (bi < 8) { S[t][0] = S[t][0] * dcv[bi % 3][t4]; S[t][1] = S[t][1] * dcv[bi % 3][t4]; }
                    S[t][0] = __builtin_amdgcn_mfma_f32_16x16x32_bf16(ka[bi % 3][t4], vt[ks][0], S[t][0], 0, 0, 0); S[t][1] = __builtin_amdgcn_mfma_f32_16x16x32_bf16(ka[bi % 3][t4], vt[ks][1], S[t][1], 0, 0, 0); }
                __builtin_amdgcn_sched_barrier(0);
            }
#undef SC_LOADK
            }
            asm volatile("s_waitcnt lgkmcnt(0)" ::: "memory");
            if (lane == 0) flags[12 + c] = (unsigned)(n + 1);
            if (n + 1 < 68) SC_LOADVT(n + 1);
        }
#undef SC_LOADVT
    }
    asm volatile("s_waitcnt vmcnt(0) lgkmcnt(0)" ::: "memory");
    __syncthreads();
#undef SC_CHUNK
}

__device__ __forceinline__ float xg_max(float x) {
    auto a = __builtin_amdgcn_permlane16_swap(__float_as_uint(x), __float_as_uint(x), false, false); x = fmaxf(__uint_as_float(a[0]), __uint_as_float(a[1]));
    auto b = __builtin_amdgcn_permlane32_swap(__float_as_uint(x), __float_as_uint(x), false, false); return fmaxf(__uint_as_float(b[0]), __uint_as_float(b[1]));
}
__device__ __forceinline__ float xg_sum(float x) {
    auto a = __builtin_amdgcn_permlane16_swap(__float_as_uint(x), __float_as_uint(x), false, false); x = __uint_as_float(a[0]) + __uint_as_float(a[1]);
    auto b = __builtin_amdgcn_permlane32_swap(__float_as_uint(x), __float_as_uint(x), false, false); return __uint_as_float(b[0]) + __uint_as_float(b[1]);
}
template <int AVAR> __device__ __forceinline__ void attn_unit(Frame& F, int l, int u, size_t ws_ax) {
    const bf16* QR = (const bf16*)(F.ws + WS_QR); const unsigned char* KR = F.ws + WS_KR; const unsigned char* VAT = F.ws + WS_VAT; bf16* AX = (bf16*)(F.ws + ws_ax);
    int b, kvh, qb, qrow0; bool lat;
    if (u < 512) { lat = true; b = u >> 8; kvh = (u >> 6) & 3; qb = u & 63; qrow0 = b * SEQ + 64 * qb; } else { const int v = u - 512; lat = false; b = v >> 4; kvh = (v >> 2) & 3; qb = v & 3; qrow0 = ML + b * CTXL + 64 * qb; }
    const int w = F.wave, lane = F.lane, r = lane & 15, g = lane >> 4, hq = kvh * 8 + w;
    LAS unsigned char* lds = F.lds;
    asm volatile("s_waitcnt lgkmcnt(0)\n\ts_barrier" ::: "memory");
    for (int idx = w; idx < 144; idx += 8) { const int j = idx >> 4, kind = (idx >> 3) & 1, q = idx & 7;
        int krow;
        if (j < 5) { const int t0 = 64 * qb - 128 + 64 * j; krow = (lat && t0 >= 0 && t0 < SEQ) ? b * SEQ + t0 : -1; } else krow = ML + b * CTXL + 64 * (j - 5);
        if (krow < 0 || AVAR == 1) continue;
        const int row = 8 * q + (lane >> 3), cc = (lane & 7) ^ ((row >> 1) & 7);
        if (kind == 0) glds16(KR + (size_t)(krow + row) * 512 + kvh * 128 + cc * 16, lds + j * 8192 + q * 1024);
        else glds16(VAT + ((size_t)(krow >> 6) * 4 + kvh) * 8192 + row * 128 + cc * 16, lds + 73728 + j * 8192 + q * 1024);
    }
    bf16x8 qf[4][2];
#pragma unroll
    for (int qt = 0; qt < 4; ++qt)
#pragma unroll
        for (int ks = 0; ks < 2; ++ks) qf[qt][ks] = *(const bf16x8*)(QR + (size_t)(qrow0 + 16 * qt + r) * D + hq * 64 + 32 * ks + 8 * g);
    int k64off[2], v64off[2][2];
#pragma unroll
    for (int ks = 0; ks < 2; ++ks) { k64off[ks] = r * 128 + (((4 * ks + g) ^ ((r >> 1) & 7)) << 4);
#pragma unroll
        for (int hs = 0; hs < 2; ++hs) v64off[ks][hs] = r * 128 + (((4 * ks + 2 * hs + (g >> 1)) ^ ((r >> 1) & 7)) << 4) + 8 * (g & 1); }
    const float sink = INP(I_SINK)[l * AHQ + hq] * 1.4426950408889634f;
    float mrow[4]; f32x4 lacc[4]; f32x4 O[4][4];
    const bf16x8 ones8 = (bf16x8){0x3F80, 0x3F80, 0x3F80, 0x3F80, 0x3F80, 0x3F80, 0x3F80, 0x3F80};
#pragma unroll
    for (int qt = 0; qt < 4; ++qt) { mrow[qt] = sink; lacc[qt] = (f32x4){1.f, 1.f, 1.f, 1.f};
#pragma unroll
        for (int dt = 0; dt < 4; ++dt) O[dt][qt] = (f32x4){0.f, 0.f, 0.f, 0.f}; }
    asm volatile("s_waitcnt vmcnt(0)\n\ts_barrier" ::: "memory");
    for (int j = 0; j < 9; ++j) {
        if (j < 5) { const int t0 = 64 * qb - 128 + 64 * j; if (!(lat && t0 >= 0 && t0 < SEQ)) continue; }
        const LAS unsigned char* Kt = lds + j * 8192; const LAS unsigned char* Vt = lds + 73728 + j * 8192;
        f32x4 Sc[4][4];
#pragma unroll
        for (int kk = 0; kk < 4; ++kk)
#pragma unroll
            for (int qt = 0; qt < 4; ++qt) Sc[kk][qt] = (f32x4){0.f, 0.f, 0.f, 0.f};
        { bf16x8 kaf[2][4];
#pragma unroll
            for (int kk = 0; kk < 4; ++kk) kaf[0][kk] = *(const LAS bf16x8*)(Kt + k64off[0] + kk * 2048);
        __builtin_amdgcn_sched_barrier(0);
#pragma unroll
        for (int ks = 0; ks < 2; ++ks) {
            if (ks == 0) {
#pragma unroll
                for (int kk = 0; kk < 4; ++kk) kaf[1][kk] = *(const LAS bf16x8*)(Kt + k64off[1] + kk * 2048);
            }
            __builtin_amdgcn_sched_barrier(0);
#pragma unroll
            for (int kk = 0; kk < 4; ++kk)
#pragma unroll
                for (int qt = 0; qt < 4; ++qt) { if (AVAR == 3) Sc[kk][qt][0] += __builtin_bit_cast(f32x4, kaf[ks][kk])[0]; else Sc[kk][qt] = __builtin_amdgcn_mfma_f32_16x16x32_bf16(kaf[ks][kk], qf[qt][ks], Sc[kk][qt], 0, 0, 0); }
            __builtin_amdgcn_sched_barrier(0); } }
        if (j == 0 || j == 4) {
#pragma unroll
            for (int kk = 0; kk < 4; ++kk)
#pragma unroll
                for (int qt = 0; qt < 4; ++qt)
#pragma unroll
                    for (int q = 0; q < 4; ++q) { const int ki = 16 * kk + 4 * g + q, qi = 16 * qt + r; const bool ok = (j == 0) ? (ki >= qi) : (ki <= qi); if (!ok) Sc[kk][qt][q] = -1e30f; }
        }
        bf16x8 pf[2][4];
        if (AVAR == 2) {
#pragma unroll
            for (int qt = 0; qt < 4; ++qt) { pf[0][qt] = pack8b(Sc[0][qt], Sc[1][qt]); pf[1][qt] = pack8b(Sc[2][qt], Sc[3][qt]); }
        } else {
            float mx[4]; bool grow = false;
#pragma unroll
            for (int qt = 0; qt < 4; ++qt) { float v = -1e30f;
#pragma unroll
                for (int kk = 0; kk < 4; ++kk) v = fmaxf(v, fmaxf(fmaxf(Sc[kk][qt][0], Sc[kk][qt][1]), fmaxf(Sc[kk][qt][2], Sc[kk][qt][3])));
                mx[qt] = xg_max(v); grow |= (mx[qt] > mrow[qt] + 8.0f); }
            if (__any(grow)) {
#pragma unroll
                for (int qt = 0; qt < 4; ++qt) { const float mn = fmaxf(mrow[qt], mx[qt]), sc = __builtin_amdgcn_exp2f(mrow[qt] - mn); mrow[qt] = mn; lacc[qt] = lacc[qt] * sc;
#pragma unroll
                    for (int dt = 0; dt < 4; ++dt) O[dt][qt] = O[dt][qt] * sc; }
            }
#pragma unroll
            for (int qt = 0; qt < 4; ++qt) { const float mn = mrow[qt];
#pragma unroll
                for (int kk = 0; kk < 4; ++kk)
#pragma unroll
                    for (int q = 0; q < 4; ++q) Sc[kk][qt][q] = __builtin_amdgcn_exp2f(Sc[kk][qt][q] - mn);
                pf[0][qt] = pack8b(Sc[0][qt], Sc[1][qt]); pf[1][qt] = pack8b(Sc[2][qt], Sc[3][qt]); }
        }
#pragma unroll
        for (int ks = 0; ks < 2; ++ks)
#pragma unroll
            for (int qt = 0; qt < 4; ++qt) lacc[qt] = __builtin_amdgcn_mfma_f32_16x16x32_bf16(ones8, pf[ks][qt], lacc[qt], 0, 0, 0);
        s16x4 vaf[2][4][2];
#pragma unroll
        for (int dt = 0; dt < 4; ++dt) { vaf[0][dt][0] = *(const LAS s16x4*)(Vt + v64off[0][0] + dt * 2048); vaf[0][dt][1] = *(const LAS s16x4*)(Vt + v64off[0][1] + dt * 2048); }
        __builtin_amdgcn_sched_barrier(0);
#pragma unroll
        for (int ks = 0; ks < 2; ++ks) {
            if (ks == 0) {
#pragma unroll
                for (int dt = 0; dt < 4; ++dt) { vaf[1][dt][0] = *(const LAS s16x4*)(Vt + v64off[1][0] + dt * 2048); vaf[1][dt][1] = *(const LAS s16x4*)(Vt + v64off[1][1] + dt * 2048); }
            }
            __builtin_amdgcn_sched_barrier(0);
#pragma unroll
            for (int dt = 0; dt < 4; ++dt)
#pragma unroll
                for (int qt = 0; qt < 4; ++qt) { if (AVAR == 3) O[dt][qt][0] += __builtin_bit_cast(f32x4, pf[ks][qt])[0] + (float)vaf[ks][dt][0][0]; else O[dt][qt] = __builtin_amdgcn_mfma_f32_16x16x32_bf16(cat8(vaf[ks][dt][0], vaf[ks][dt][1]), pf[ks][qt], O[dt][qt], 0, 0, 0); }
            __builtin_amdgcn_sched_barrier(0); }
    }
    { int lo_ = r * D + 4 * g; asm volatile("" : "+v"(lo_));
      bf16* ab = AX + (size_t)qrow0 * D + hq * 64 + lo_;
#pragma unroll
      for (int qt = 0; qt < 4; ++qt) { const float il = 1.0f / lacc[qt][0];
#pragma unroll
        for (int dt = 0; dt < 4; ++dt) { u32x2 wv; wv.x = cvt_pk_bf16(O[dt][qt][0] * il, O[dt][qt][1] * il); wv.y = cvt_pk_bf16(O[dt][qt][2] * il, O[dt][qt][3] * il);
            *(u32x2*)(ab + (size_t)(16 * qt) * D + 16 * dt) = wv; } } }
}
__device__ __forceinline__ void mix_fast_phase(Frame& F, int l, size_t ws_ax, int parts) {
    if (F.bid < 64) { if (parts & 1) { if (parts & 16) gla_scan<1>(F, F.bid); else if (parts & 32) gla_scan<2>(F, F.bid); else gla_scan<0>(F, F.bid); } return; }
    const int nu = (l == 0) ? 544 : 512;
    if (parts & 2) { if (parts & 64) { for (int u = F.bid - 64; u < nu; u += F.G - 64) attn_unit<1>(F, l, u, ws_ax); }
                     else if (parts & 128) { for (int u = F.bid - 64; u < nu; u += F.G - 64) attn_unit<2>(F, l, u, ws_ax); }
                     else if (parts & 256) { for (int u = F.bid - 64; u < nu; u += F.G - 64) attn_unit<3>(F, l, u, ws_ax); }
                     else { for (int u = F.bid - 64; u < nu; u += F.G - 64) attn_unit<0>(F, l, u, ws_ax); } }
    asm volatile("s_waitcnt vmcnt(0) lgkmcnt(0)\n\ts_barrier" ::: "memory");
    if ((parts & 3) == 3 && F.G == 256) { const int k = F.bid - 64;
        if (l == 0) { convert_range(F, CV_MIX0 + k * CVQ_MIX, CVQ_MIX); convert_range(F, CV_MIX0X + (k < N0A ? k * X0A : N0A * X0A + (k - N0A) * X0B), k < N0A ? X0A : X0B); }
        else convert_range(F, CV_MIX1 + (k < N1A ? k * Q1A : N1A * Q1A + (k - N1A) * Q1B), k < N1A ? Q1A : Q1B); }
}
#if MIXCHECK
__device__ __forceinline__ void mixcheck_phase(Frame& F, int l) {
    const size_t gt = (size_t)F.vcu * 512 + F.tid, NT = (size_t)F.G * 512; const size_t n = (size_t)((l == 0) ? MT : ML) * D;
    const bf16* OFa = (const bf16*)(F.ws + WS_OF); const bf16* OBa = (const bf16*)(F.ws + WS_OB);
    const bf16* OF2 = (const bf16*)(F.ws + WS_OF2); const bf16* OB2 = (const bf16*)(F.ws + WS_OB2);
    const bf16* AXa = (const bf16*)(F.ws + WS_AX); const bf16* AX2 = (const bf16*)(F.ws + WS_AX2);
    float dg = 0.f, ng = 0.f, da = 0.f, na = 0.f;
    for (size_t i = gt; i < n; i += NT) { const float a = bf2f(OFa[i]) + bf2f(OBa[i]), b = bf2f(OF2[i]) + bf2f(OB2[i]); dg += (a - b) * (a - b); ng += b * b; const float c = bf2f(AXa[i]), e = bf2f(AX2[i]); da += (c - e) * (c - e); na += e * e; }
    dg = wave_sum(dg); ng = wave_sum(ng); da = wave_sum(da); na = wave_sum(na);
    if (F.lane == 0) { float* acc = (float*)(F.ctl + CW_CHK) + 4 * l; atomicAdd(acc + 0, dg); atomicAdd(acc + 1, ng); atomicAdd(acc + 2, da); atomicAdd(acc + 3, na); }
}
#endif

constexpr int NPH = 22;
struct Args { const float* in[28]; float* out; unsigned char* ws; int ph_lo, ph_hi; };
__device__ __forceinline__ void make_frame(Frame& F, const Args& args, unsigned char* lds_raw) {
    int tid = threadIdx.x; asm volatile("" : "+v"(tid));
    int G = gridDim.x, bx = blockIdx.x; asm volatile("" : "+s"(G), "+s"(bx));
    GAS unsigned char* ws = (GAS unsigned char*)args.ws; asm volatile("" : "+s"(ws));
    F.lds = (LAS unsigned char*)lds_raw;
    F.tid = tid; F.lane = tid & 63; F.wave = __builtin_amdgcn_readfirstlane(tid >> 6);
    F.G = G; F.bid = bx; F.vcu = (G % 8 == 0) ? (bx % 8) * (G / 8) + bx / 8 : bx;
    const __attribute__((address_space(4))) void* ka = (const __attribute__((address_space(4))) void*)__builtin_amdgcn_kernarg_segment_ptr(); asm volatile("" : "+s"(ka));
    F.in = (in_table_t)ka; F.out = args.out; F.ws = (unsigned char*)ws; F.ctl = (unsigned*)(F.ws + WS_CTL);
}
__global__ void __launch_bounds__(512, 2) fwd_kernel(Args args) {
    extern __shared__ __attribute__((aligned(16))) unsigned char lds_raw[];
    volatile LAS unsigned* MISC = (volatile LAS unsigned*)((LAS unsigned char*)lds_raw + MISC_OFF);
    if (threadIdx.x < 32) MISC[threadIdx.x] = 0u;
    __syncthreads();
    XcdBarrier bar; bar.bar = (unsigned*)(args.ws + WS_CTL) + CW_BAR; bar.x = 0; bar.st = MISC + 8;
    const int lo = args.ph_lo, hi = args.ph_hi;
    if (hi - lo > 1) bar = xcd_barrier_post((unsigned*)(args.ws + WS_CTL) + CW_BAR, MISC + 8);
#ifndef PHMASK
#define PHMASK 0xFFFFFFFFu
#endif
#define IN(k) (((PHMASK >> (k)) & 1u) && lo <= (k) && (k) < hi)
#define SEAM(k) do { if (lo <= (k) && (k) + 1 < hi) xcd_barrier(bar); } while (0)
#define REP(k) for (int rep_ = 0; rep_ < (((PROBE_MASK >> (k)) & 1u) ? 2 : 1); ++rep_)
#define REPBAR(k) do { if (((PROBE_MASK >> (k)) & 1u) && rep_ == 0) xcd_barrier(bar); } while (0)
#define PHASE_BEGIN Frame F; make_frame(F, args, lds_raw); unsigned char* ws = F.ws; int l = l_; asm volatile("" : "+s"(l)); (void)ws; (void)l;

    { const int l_ = 0; REP(0) { if (IN(0)) { PHASE_BEGIN p0_weights(F); p0_mod(F); } REPBAR(0); } SEAM(0); }
    { const int l_ = 0; REP(1) { if (IN(1)) { PHASE_BEGIN t1_phase(F); } REPBAR(1); } SEAM(1); }
    for (int l_ = 0; l_ < 2; ++l_) {
        const int pb = 2 + 10 * l_;
        REP(pb + 0) { if (IN(pb + 0)) { PHASE_BEGIN
            pg::SchedDense S; S.init(ws + WS_HX, ws + WS_WIN + l * SZ_WIN, l == 0 ? MT : ML, NP, D, F.G, F.bid, l == 0 ? 0 : 30);
            pg::EpiBf16 E{(bf16*)(ws + WS_P), NP, 0, (bf16*)(ws + WS_LRB + (size_t)l * SZ_LRB), OLR / 256};
            if (((PROBE_MASK >> (pb + 0)) & 1u) && rep_ == 0) E.skip = PROBE_PARTS;
            pg::gemm_phase<pg::EpiBf16, pg::SchedDense, true>(F.lds, F.tid, S, E);
            if (QG1 > 0 && F.G == 256 && F.bid >= (l == 0 ? G1F0 : G1F1)) { asm volatile("s_waitcnt vmcnt(0) lgkmcnt(0)\n\ts_barrier" ::: "memory");
                convert_range(F, l == 0 ? CV_G1L0 + (F.bid - G1F0) * QG1 : CV_G1L1 + (F.bid - G1F1) * QG1, QG1); }
        } REPBAR(pb + 0); } SEAM(pb + 0);
#if MIXCHECK
        REP(pb + 1) { if (IN(pb + 1)) { PHASE_BEGIN prep_phase(F, l); __syncthreads(); prep_fast_phase(F, l, 7); } REPBAR(pb + 1); } SEAM(pb + 1);
        REP(pb + 2) { if (IN(pb + 2)) { PHASE_BEGIN if (F.bid < 64) mix_simple_gla(F, F.bid, WS_OF2, WS_OB2); else mix_simple_attn(F, l, F.bid - 64, F.G - 64, WS_AX2);
            __syncthreads(); mix_fast_phase(F, l, WS_AX, 3); } REPBAR(pb + 2); } SEAM(pb + 2);
#elif FAST_MIX
        REP(pb + 1) { if (IN(pb + 1)) { PHASE_BEGIN if (rep_ == 0) prep_fast_phase(F, l, 7); else prep_fast_phase(F, l, PROBE_PARTS); } REPBAR(pb + 1); } SEAM(pb + 1);
        REP(pb + 2) { if (IN(pb + 2)) { PHASE_BEGIN if (((PROBE_MASK >> (pb + 2)) & 1u) && rep_ == 0) mix_fast_phase(F, l, WS_AX, PROBE_PARTS); else mix_fast_phase(F, l, WS_AX, 3); } REPBAR(pb + 2); } SEAM(pb + 2);
#else
        REP(pb + 1) { if (IN(pb + 1)) { PHASE_BEGIN prep_phase(F, l); } REPBAR(pb + 1); } SEAM(pb + 1);
        REP(pb + 2) { if (IN(pb + 2)) { PHASE_BEGIN if (F.bid < 64) mix_simple_gla(F, F.bid, WS_OF, WS_OB); else mix_simple_attn(F, l, F.bid - 64, F.G - 64, WS_AX); } REPBAR(pb + 2); } SEAM(pb + 2);
#endif
#if MIXCHECK
        REP(pb + 3) { if (IN(pb + 3)) { PHASE_BEGIN mixcheck_phase(F, l); ro_phase(F, l); } REPBAR(pb + 3); } SEAM(pb + 3);
#else
        REP(pb + 3) { if (IN(pb + 3)) { PHASE_BEGIN ro_phase(F, l); } REPBAR(pb + 3); } SEAM(pb + 3);
#endif
        REP(pb + 4) { if (IN(pb + 4)) { PHASE_BEGIN
            if (CTX_SPLIT && l == 0) {
                pg::SchedBranchSplit S; S.init(ws + WS_GX, ws + WS_AX, ws + WS_WBG, ws + WS_WBA, D, D, F.G, F.bid, YP_S2);
                pg::EpiBranch E{(const bf16*)(ws + WS_P), (bf16*)(ws + WS_O1), D, (float*)(ws + WS_YP2), YP_S2};
                pg::gemm_phase<pg::EpiBranch, pg::SchedBranchSplit, true>(F.lds, F.tid, S, E);
            } else {
            pg::SchedBranch S; S.init(ws + WS_GX, ws + WS_AX, ws + WS_WBG + l * SZ_WSQ, ws + WS_WBA + l * SZ_WSQ, l == 0 ? MT : ML, D, D, F.G, F.bid);
            pg::EpiBranch E{(const bf16*)(ws + WS_P), (bf16*)(ws + WS_O1), D};
            pg::gemm_phase<pg::EpiBranch, pg::SchedBranch, true>(F.lds, F.tid, S, E);
            }
            if (CTX_SPLIT && CVQ_G2 > 0 && l == 0 && F.G == 256 && F.bid >= 128) { asm volatile("s_waitcnt vmcnt(0) lgkmcnt(0)\n\ts_barrier" ::: "memory"); convert_range(F, CV_G2 + (F.bid - 128) * CVQ_G2, CVQ_G2); }
        } REPBAR(pb + 4); } SEAM(pb + 4);
        REP(pb + 5) { if (IN(pb + 5)) { PHASE_BEGIN
            if (CTX_SPLIT && l == 0) {
                {
                    const float* yp2 = (const float*)(ws + WS_YP2); bf16* O1 = (bf16*)(ws + WS_O1) + (size_t)ML * D;
                    for (int i8 = F.bid * 512 + F.tid; i8 < MC * D / 8; i8 += F.G * 512) { f32x4 a0 = *(const f32x4*)(yp2 + (size_t)i8 * 8), a1 = *(const f32x4*)(yp2 + (size_t)i8 * 8 + 4);
#pragma unroll
                        for (int q = 1; q < 2 * YP_S2; ++q) { a0 = a0 + *(const f32x4*)(yp2 + (size_t)q * MC * D + (size_t)i8 * 8); a1 = a1 + *(const f32x4*)(yp2 + (size_t)q * MC * D + (size_t)i8 * 8 + 4); }
                        u32x4 w; w.x = cvt_pk_bf16(a0[0], a0[1]); w.y = cvt_pk_bf16(a0[2], a0[3]); w.z = cvt_pk_bf16(a1[0], a1[1]); w.w = cvt_pk_bf16(a1[2], a1[3]); *(u32x4*)(O1 + (size_t)i8 * 8) = w; }
                    asm volatile("s_waitcnt vmcnt(0)" ::: "memory"); __syncthreads();
                    if (F.tid == 0) { __builtin_amdgcn_fence(__ATOMIC_RELEASE, "agent"); asm volatile("s_waitcnt vmcnt(0)" ::: "memory"); (void)xb_add(F.ctl + CW_G2RED, 1u); }
                }
                pg::SchedCtxSplit S; S.init(ws + WS_O1, ws + WS_WO, D, D, F.G, F.bid, YP_S3); S.flag = F.ctl + CW_G2RED;
                pg::EpiBf16Ctx E{(bf16*)(ws + WS_Y), (float*)(ws + WS_YP), D};
                pg::gemm_phase<pg::EpiBf16Ctx, pg::SchedCtxSplit, true>(F.lds, F.tid, S, E);
                if (QG3 > 0 && F.G == 256 && F.bid >= 128) { asm volatile("s_waitcnt vmcnt(0) lgkmcnt(0)\n\ts_barrier" ::: "memory"); convert_range(F, CV_G3 + (F.bid - 128) * QG3, QG3); }
            } else {
            pg::SchedDense S; S.init(ws + WS_O1, ws + WS_WO + l * SZ_WSQ, l == 0 ? MT : ML, D, D, F.G, F.bid, 0);
            pg::EpiBf16 E{(bf16*)(ws + WS_Y), D};
            pg::gemm_phase<pg::EpiBf16, pg::SchedDense, true>(F.lds, F.tid, S, E);
            }
        } REPBAR(pb + 5); } SEAM(pb + 5);
        REP(pb + 6) { if (IN(pb + 6)) { PHASE_BEGIN t3_phase(F, l); } REPBAR(pb + 6); } SEAM(pb + 6);
        if (l_ == 0) {
            REP(pb + 7) { if (IN(pb + 7)) { PHASE_BEGIN
#if DENSE_FP8 == 1
                pg::SchedDense S; S.init(ws + WS_HX8, ws + WS_FGU, MT, NGU, D / 2, F.G, F.bid, 0); S.sa = X8_E; S.sb = W8_E;
                pg::EpiSwiGLU8 E{ws + WS_P, DFF, H8_SCALE};
                pg::gemm_phase<pg::EpiSwiGLU8, pg::SchedDense, true, true, D / 2>(F.lds, F.tid, S, E);
#elif DENSE_FP8 == 2
                pg::SchedDense S; S.init(ws + WS_HX8, ws + WS_FGU, MT, NGU, D / 2, F.G, F.bid, 0); S.sa = X8_E; S.sb = W8_E;
                pg::EpiSwiGLU E{(bf16*)(ws + WS_P), DFF};
                pg::gemm_phase<pg::EpiSwiGLU, pg::SchedDense, true, true, D / 2>(F.lds, F.tid, S, E);
                if (QG4 > 0 && F.G == 256 && F.bid >= G4F) { asm volatile("s_waitcnt vmcnt(0) lgkmcnt(0)\n\ts_barrier" ::: "memory"); convert_range(F, CV_G4 + (F.bid - G4F) * QG4, QG4); }
#else
                pg::SchedDense S; S.init(ws + WS_HX, ws + WS_FGU, MT, NGU, D, F.G, F.bid, 0);
                pg::EpiSwiGLU E{(bf16*)(ws + WS_P), DFF};
                pg::gemm_phase<pg::EpiSwiGLU, pg::SchedDense, true>(F.lds, F.tid, S, E);
#endif
            } REPBAR(pb + 7); } SEAM(pb + 7);
            REP(pb + 8) { if (IN(pb + 8)) { PHASE_BEGIN
#if DENSE_FP8 == 1
                pg::SchedDense S; S.init(ws + WS_P, ws + WS_FDN, MT, D, DFF / 2, F.G, F.bid, 0); S.sa = H8_E; S.sb = W8_E;
                pg::EpiBf16 E{(bf16*)(ws + WS_Y), D};
                pg::gemm_phase<pg::EpiBf16, pg::SchedDense, true, true, DFF / 2>(F.lds, F.tid, S, E);
#else
#if CTX_SPLIT
                pg::SchedCtxSplit S; S.init(ws + WS_P, ws + WS_FDN, D, DFF, F.G, F.bid, YP_S5);
                pg::EpiBf16Ctx E{(bf16*)(ws + WS_Y), (float*)(ws + WS_YP), D};
                pg::gemm_phase<pg::EpiBf16Ctx, pg::SchedCtxSplit, true>(F.lds, F.tid, S, E);
                if (QG5 > 0 && F.G == 256 && F.bid >= G5F) { asm volatile("s_waitcnt vmcnt(0) lgkmcnt(0)\n\ts_barrier" ::: "memory"); convert_range(F, CV_G5 + (F.bid - G5F) * QG5, QG5); }
#else
                pg::SchedDense S; S.init(ws + WS_P, ws + WS_FDN, MT, D, DFF, F.G, F.bid, 0);
                pg::EpiBf16 E{(bf16*)(ws + WS_Y), D};
                pg::gemm_phase<pg::EpiBf16, pg::SchedDense, true>(F.lds, F.tid, S, E);
#endif
#endif
            } REPBAR(pb + 8); } SEAM(pb + 8);
        } else {
            REP(pb + 7) { if (IN(pb + 7)) { PHASE_BEGIN
#if MOE_FP8
                pg::SchedMoe<true> S; S.init(ws + WS_HX8, ws + WS_EGU, SZ_GU / 2, F.ctl + CW_CNT, (const int*)(ws + WS_LIST), NGU, D / 2, F.G, F.bid); S.sa = X8_E; S.sb = W8_E;
                pg::EpiSwiGLU8 E{ws + WS_P, DFF, H8_SCALE};
                pg::gemm_phase<pg::EpiSwiGLU8, pg::SchedMoe<true>, true, true, D / 2>(F.lds, F.tid, S, E);
#else
                pg::SchedMoe<true> S; S.init(ws + WS_HX, ws + WS_EGU, SZ_GU, F.ctl + CW_CNT, (const int*)(ws + WS_LIST), NGU, D, F.G, F.bid);
                pg::EpiSwiGLU E{(bf16*)(ws + WS_P), DFF};
                pg::gemm_phase<pg::EpiSwiGLU, pg::SchedMoe<true>, true>(F.lds, F.tid, S, E);
#endif
            } REPBAR(pb + 7); } SEAM(pb + 7);
            REP(pb + 8) { if (IN(pb + 8)) { PHASE_BEGIN
#if MOE_FP8
                pg::SchedMoe<false> S; S.init(ws + WS_P, ws + WS_EDN, SZ_DN / 2, F.ctl + CW_CNT, (const int*)(ws + WS_LIST), D, DFF / 2, F.G, F.bid); S.sa = H8_E; S.sb = W8_E;
                pg::EpiBf16 E{(bf16*)(ws + WS_LAF), D};
                pg::gemm_phase<pg::EpiBf16, pg::SchedMoe<false>, true, true, DFF / 2>(F.lds, F.tid, S, E);
#else
                pg::SchedMoe<false> S; S.init(ws + WS_P, ws + WS_EDN, SZ_DN, F.ctl + CW_CNT, (const int*)(ws + WS_LIST), D, DFF, F.G, F.bid);
                pg::EpiBf16 E{(bf16*)(ws + WS_LAF), D};
                pg::gemm_phase<pg::EpiBf16, pg::SchedMoe<false>, true>(F.lds, F.tid, S, E);
#endif
            } REPBAR(pb + 8); } SEAM(pb + 8);
        }
        REP(pb + 9) { if (IN(pb + 9)) { PHASE_BEGIN t5_phase(F, l); } REPBAR(pb + 9); } SEAM(pb + 9);
    }
#undef IN
#undef SEAM
}

extern "C" void kernel_launch(void* const* d_in, const int* in_sizes, int n_in, void* d_out, int out_size, void* d_ws, size_t ws_size, hipStream_t stream) {
    static int grid = 0;
    if (grid == 0) {
        if (n_in != 28 || in_sizes[0] != ML * D || out_size != ML * D || ws_size < WS_END) { fprintf(stderr, "kernel_launch: unexpected problem (n_in %d, in0 %d, out %d, ws %zu < %zu); nothing launched\n", n_in, n_in > 0 ? in_sizes[0] : -1, out_size, ws_size, (size_t)WS_END); grid = -1; return; }
        int dev = 0, cus = 0, per_cu = 0;
        if (hipGetDevice(&dev) != hipSuccess || hipDeviceGetAttribute(&cus, hipDeviceAttributeMultiprocessorCount, dev) != hipSuccess) { grid = -1; return; }
        if (hipFuncSetAttribute((const void*)fwd_kernel, hipFuncAttributeMaxDynamicSharedMemorySize, LDS_BYTES) != hipSuccess) { fprintf(stderr, "kernel_launch: hipFuncSetAttribute failed\n"); grid = -1; return; }
        if (hipOccupancyMaxActiveBlocksPerMultiprocessor(&per_cu, (const void*)fwd_kernel, 512, LDS_BYTES) != hipSuccess || per_cu < 1) fprintf(stderr, "kernel_launch: occupancy query reports %d\n", per_cu);
        (void)hipGetLastError();
        grid = cus;
    }
    if (grid < 0) return;
    if (hipMemsetAsync((char*)d_ws + WS_CTL, 0, CTL_ZERO_BYTES, stream) != hipSuccess) return;
    Args a{};
    for (int i = 0; i < 28; ++i) a.in[i] = (const float*)d_in[i];
    a.out = (float*)d_out; a.ws = (unsigned char*)d_ws;
#if MK_N_LAUNCHES == 1
    a.ph_lo = 0; a.ph_hi = NPH;
    hipLaunchKernelGGL(fwd_kernel, dim3(grid), dim3(512), LDS_BYTES, stream, a);
#else
    for (int p = 0; p < NPH; ++p) { a.ph_lo = p; a.ph_hi = p + 1; hipLaunchKernelGGL(fwd_kernel, dim3(grid), dim3(512), LDS_BYTES, stream, a); }
#endif
}
```
